# Optimizing an MI355X kernel written in HIP

```python
import math
import jax, jax.numpy as jnp
from jax import lax
import numpy as np

D_MODEL = 1024
BATCH = 8
SEQ = 4096
DEPTH = 2

GRID_W = 64
CTX_LEN = 256
N_MIXERS = 2
N_LRU_LAYERS = (DEPTH + N_MIXERS - 1) // N_MIXERS
N_ATTN_LAYERS = DEPTH // N_MIXERS
D_RNN = D_MODEL
N_LRU_BLOCKS = 8
LRU_BLOCK = D_RNN // N_LRU_BLOCKS
CONV_W = 4
LRU_C = 8.0
HEAD_DIM = 64
N_HEADS = D_MODEL // HEAD_DIM
N_KV_HEADS = 4
KV_GROUP = N_HEADS // N_KV_HEADS
ROPE_THETA = 10000.0
Q_BLOCK = 128
N_EXPERTS = 16
N_EXPERT_GROUPS = 4
EXPERTS_PER_GROUP = N_EXPERTS // N_EXPERT_GROUPS
TOP_K = 2
EXPERT_FF = 512
N_MOD = 6
EPS = 1e-6

kernel_name = "hybrid_rglru_gqa_grouped_moe_dit"


def rms_norm(x, w):
    xf = x.astype(jnp.float32)
    y = xf * lax.rsqrt(jnp.mean(xf * xf, axis=-1, keepdims=True) + EPS)
    return (y * w.astype(jnp.float32)).astype(x.dtype)


def adaln(cond, w, b):
    m = jax.nn.silu(cond) @ w + b
    m = m.reshape((-1, 1, N_MOD * D_MODEL))
    return jnp.split(m, N_MOD, axis=-1)


def modulate(x, g, shift, scale):
    return rms_norm(x, g) * (1 + scale) + shift


def dwconv_centred(u, w, b):
    left = CONV_W // 2
    right = CONV_W - 1 - left
    L = u.shape[1]
    up = jnp.pad(u, ((0, 0), (left, right), (0, 0)))
    out = b
    for k in range(CONV_W):
        out = out + up[:, k:k + L] * w[k]
    return out


def rglru_coeffs(u, wa, ba, wx, bx, lam):
    B_, L, C = u.shape
    ub = u.reshape(B_, L, N_LRU_BLOCKS, LRU_BLOCK)
    r = jax.nn.sigmoid((jnp.einsum("blnd,nde->blne", ub, wa).reshape(B_, L, C) + ba).astype(jnp.float32))
    ig = jax.nn.sigmoid((jnp.einsum("blnd,nde->blne", ub, wx).reshape(B_, L, C) + bx).astype(jnp.float32))
    log_a = -LRU_C * r * jax.nn.softplus(-lam.astype(jnp.float32))
    a = jnp.exp(log_a)
    bterm = jnp.sqrt(-jnp.expm1(2.0 * log_a)) * (ig * u.astype(jnp.float32))
    return a, bterm


def linear_scan(a, b, h0, reverse):
    if h0 is not None:
        if reverse:
            b = b.at[:, -1].add(a[:, -1] * h0)
        else:
            b = b.at[:, 0].add(a[:, 0] * h0)

    def combine(e1, e2):
        a1, b1 = e1
        a2, b2 = e2
        return a1 * a2, a2 * b1 + b2

    _, h = lax.associative_scan(combine, (a, b), reverse=reverse, axis=1)
    return h


def rglru_mixer(hx, hc, in_w, conv_w, conv_b, ga_w, ga_b, gx_w, gx_b, lam, out_w, ctx_out):
    w_gate, w_in = in_w[:, :D_RNN], in_w[:, D_RNN:]
    gx_, ux = jnp.split(hx @ in_w, 2, axis=-1)
    uc = hc @ w_in
    ux = dwconv_centred(ux, conv_w, conv_b)
    uc = dwconv_centred(uc, conv_w, conv_b)
    yx = 0.0
    yc = 0.0
    for d in range(2):
        rev = d == 1
        a_c, b_c = rglru_coeffs(uc, ga_w[d], ga_b[d], gx_w[d], gx_b[d], lam[d])
        h_c = linear_scan(a_c, b_c, None, rev)
        h0 = h_c[:, 0] if rev else h_c[:, -1]
        a_x, b_x = rglru_coeffs(ux, ga_w[d], ga_b[d], gx_w[d], gx_b[d], lam[d])
        h_x = linear_scan(a_x, b_x, h0, rev)
        yx = yx + h_x
        if ctx_out:
            yc = yc + h_c
    out_x = (jax.nn.gelu(gx_) * yx.astype(hx.dtype)) @ out_w
    out_c = None
    if ctx_out:
        out_c = (jax.nn.gelu(hc @ w_gate) * yc.astype(hc.dtype)) @ out_w
    return out_x, out_c


def rope_1d(t, pos):
    half = t.shape[-1] // 2
    inv = ROPE_THETA ** (-jnp.arange(half, dtype=jnp.float32) / half)
    ang = pos.astype(jnp.float32)[:, None] * inv
    cos = jnp.cos(ang)[None, :, None, :]
    sin = jnp.sin(ang)[None, :, None, :]
    tf = t.astype(jnp.float32)
    t1, t2 = tf[..., :half], tf[..., half:]
    return jnp.concatenate([t1 * cos - t2 * sin, t2 * cos + t1 * sin], axis=-1).astype(t.dtype)


def rope_2d(t):
    L = t.shape[1]
    rows = L // GRID_W
    pos_r = jnp.repeat(jnp.arange(rows, dtype=jnp.int32), GRID_W)
    pos_c = jnp.tile(jnp.arange(GRID_W, dtype=jnp.int32), rows)
    half = HEAD_DIM // 2
    return jnp.concatenate([rope_1d(t[..., :half], pos_r), rope_1d(t[..., half:], pos_c)], axis=-1)


def attention_mixer(hx, hc, qkv_w, qn_w, kn_w, o_w, ctx_out):
    B_, L, _ = hx.shape
    C = hc.shape[1]
    q_cols = N_HEADS * HEAD_DIM
    kv_cols = N_KV_HEADS * HEAD_DIM
    scale = 1.0 / math.sqrt(HEAD_DIM)

    qx, kx, vx = jnp.split(hx @ qkv_w, [q_cols, q_cols + kv_cols], axis=-1)
    qx = rope_2d(rms_norm(qx.reshape(B_, L, N_HEADS, HEAD_DIM), qn_w))
    kx = rope_2d(rms_norm(kx.reshape(B_, L, N_KV_HEADS, HEAD_DIM), kn_w))
    vx = vx.reshape(B_, L, N_KV_HEADS, HEAD_DIM)

    if ctx_out:
        qc, kc, vc = jnp.split(hc @ qkv_w, [q_cols, q_cols + kv_cols], axis=-1)
    else:
        kc, vc = jnp.split(hc @ qkv_w[:, q_cols:], [kv_cols], axis=-1)
    kc = rms_norm(kc.reshape(B_, C, N_KV_HEADS, HEAD_DIM), kn_w)
    vc = vc.reshape(B_, C, N_KV_HEADS, HEAD_DIM)

    def attend(q, k, v):
        s = jnp.einsum("bqkgd,bskd->bkgqs", q, k).astype(jnp.float32) * scale
        p = jax.nn.softmax(s, axis=-1).astype(v.dtype)
        return jnp.einsum("bkgqs,bskd->bqkgd", p, v)

    k_all = jnp.concatenate([kc, kx], axis=1)
    v_all = jnp.concatenate([vc, vx], axis=1)
    n_blk = L // Q_BLOCK
    qb = qx.reshape(B_, n_blk, Q_BLOCK, N_KV_HEADS, KV_GROUP, HEAD_DIM).swapaxes(0, 1)
    ob = lax.map(lambda q: attend(q, k_all, v_all), qb)
    out_x = ob.swapaxes(0, 1).reshape(B_, L, q_cols) @ o_w

    out_c = None
    if ctx_out:
        qc = rms_norm(qc.reshape(B_, C, N_HEADS, HEAD_DIM), qn_w).reshape(B_, C, N_KV_HEADS, KV_GROUP, HEAD_DIM)
        out_c = attend(qc, kc, vc).reshape(B_, C, q_cols) @ o_w
    return out_x, out_c


def grouped_moe(h, router_w, router_b, w1, w3, w2):
    logits = (h @ router_w).astype(jnp.float32) + router_b.astype(jnp.float32)
    probs = jax.nn.softmax(logits, axis=-1)
    pg = probs.reshape(probs.shape[:-1] + (N_EXPERT_GROUPS, EXPERTS_PER_GROUP))
    group_score = lax.top_k(pg, TOP_K)[0].sum(-1)
    sel = jnp.argmax(group_score, axis=-1)
    in_group = (sel[..., None] == jnp.arange(N_EXPERT_GROUPS))[..., None]
    masked = jnp.where(in_group, pg, -1.0).reshape(probs.shape)
    top_w, top_i = lax.top_k(masked, TOP_K)
    top_w = top_w / jnp.sum(top_w, axis=-1, keepdims=True)
    gates = jnp.sum(jax.nn.one_hot(top_i, N_EXPERTS, dtype=jnp.float32) * top_w[..., None], axis=-2).astype(h.dtype)
    y = jnp.zeros_like(h)
    for e in range(N_EXPERTS):
        y = y + gates[..., e:e + 1] * ((jax.nn.silu(h @ w1[e]) * (h @ w3[e])) @ w2[e])
    return y


def setup_inputs(seed: int = 0) -> dict:
    key = jax.random.key(seed)
    ks = jax.random.split(key, 28)
    f32 = jnp.float32

    def nrm(k, shape, fan_in):
        return jax.random.normal(k, shape, f32) * fan_in ** -0.5

    def gain(k, shape):
        return 1.0 + 0.05 * jax.random.normal(k, shape, f32)

    def small(k, shape, s=0.02):
        return s * jax.random.normal(k, shape, f32)

    p_a = jax.random.uniform(ks[14], (N_LRU_LAYERS, 2, D_RNN), f32, minval=0.9, maxval=0.999) ** (1.0 / LRU_C)
    lam = jnp.log(p_a) - jnp.log1p(-p_a)
    return {
        "x": jax.random.normal(ks[0], (BATCH, SEQ, D_MODEL), f32),
        "c": jax.random.normal(ks[1], (BATCH, D_MODEL), f32),
        "ctx": jax.random.normal(ks[2], (BATCH, CTX_LEN, D_MODEL), f32),
        "c_ctx": jax.random.normal(ks[3], (D_MODEL,), f32),
        "ada_w": nrm(ks[4], (DEPTH, D_MODEL, N_MOD * D_MODEL), D_MODEL),
        "ada_b": small(ks[5], (DEPTH, N_MOD * D_MODEL)),
        "norm_mix_w": gain(ks[6], (DEPTH, D_MODEL)),
        "norm_ffn_w": gain(ks[7], (DEPTH, D_MODEL)),
        "lru_in_w": nrm(ks[8], (N_LRU_LAYERS, D_MODEL, 2 * D_RNN), D_MODEL),
        "lru_conv_w": nrm(ks[9], (N_LRU_LAYERS, CONV_W, D_RNN), CONV_W),
        "lru_conv_b": small(ks[10], (N_LRU_LAYERS, D_RNN)),
        "lru_gate_a_w": nrm(ks[11], (N_LRU_LAYERS, 2, N_LRU_BLOCKS, LRU_BLOCK, LRU_BLOCK), LRU_BLOCK),
        "lru_gate_a_b": small(ks[12], (N_LRU_LAYERS, 2, D_RNN)),
        "lru_gate_x_w": nrm(ks[13], (N_LRU_LAYERS, 2, N_LRU_BLOCKS, LRU_BLOCK, LRU_BLOCK), LRU_BLOCK),
        "lru_gate_x_b": small(ks[15], (N_LRU_LAYERS, 2, D_RNN)),
        "lru_lambda": lam,
        "lru_out_w": nrm(ks[16], (N_LRU_LAYERS, D_RNN, D_MODEL), D_RNN),
        "attn_qkv_w": nrm(ks[17], (N_ATTN_LAYERS, D_MODEL, (N_HEADS + 2 * N_KV_HEADS) * HEAD_DIM), D_MODEL),
        "attn_q_norm_w": gain(ks[18], (N_ATTN_LAYERS, HEAD_DIM)),
        "attn_k_norm_w": gain(ks[19], (N_ATTN_LAYERS, HEAD_DIM)),
        "attn_o_w": nrm(ks[20], (N_ATTN_LAYERS, N_HEADS * HEAD_DIM, D_MODEL), N_HEADS * HEAD_DIM),
        "router_w": nrm(ks[21], (D_MODEL, N_EXPERTS), D_MODEL),
        "router_b": small(ks[22], (N_EXPERTS,), 0.01),
        "moe_w1": nrm(ks[23], (DEPTH, N_EXPERTS, D_MODEL, EXPERT_FF), D_MODEL),
        "moe_w3": nrm(ks[24], (DEPTH, N_EXPERTS, D_MODEL, EXPERT_FF), D_MODEL),
        "moe_w2": nrm(ks[25], (DEPTH, N_EXPERTS, EXPERT_FF, D_MODEL), EXPERT_FF),
    }


def reference(x, c, ctx, c_ctx, ada_w, ada_b, norm_mix_w, norm_ffn_w,
              lru_in_w, lru_conv_w, lru_conv_b, lru_gate_a_w, lru_gate_a_b, lru_gate_x_w, lru_gate_x_b,
              lru_lambda, lru_out_w, attn_qkv_w, attn_q_norm_w, attn_k_norm_w, attn_o_w,
              router_w, router_b, moe_w1, moe_w3, moe_w2):
    C = ctx.shape[1]
    for i in range(DEPTH):
        ctx_out = i < DEPTH - 1
        j = i // N_MIXERS
        sh_m, sc_m, g_m, sh_f, sc_f, g_f = adaln(c, ada_w[i], ada_b[i])
        csh_m, csc_m, cg_m, csh_f, csc_f, cg_f = adaln(c_ctx, ada_w[i], ada_b[i])

        hx = modulate(x, norm_mix_w[i], sh_m, sc_m)
        hc = modulate(ctx, norm_mix_w[i], csh_m, csc_m)
        if i % N_MIXERS == 0:
            dx, dc = rglru_mixer(hx, hc, lru_in_w[j], lru_conv_w[j], lru_conv_b[j],
                                 lru_gate_a_w[j], lru_gate_a_b[j], lru_gate_x_w[j], lru_gate_x_b[j],
                                 lru_lambda[j], lru_out_w[j], ctx_out)
        else:
            dx, dc = attention_mixer(hx, hc, attn_qkv_w[j], attn_q_norm_w[j], attn_k_norm_w[j],
                                     attn_o_w[j], ctx_out)
        x = x + g_m * dx
        if ctx_out:
            ctx = ctx + cg_m * dc

        hx = modulate(x, norm_ffn_w[i], sh_f, sc_f)
        if ctx_out:
            hc = modulate(ctx, norm_ffn_w[i], csh_f, csc_f)
            y = grouped_moe(jnp.concatenate([hc, hx], axis=1), router_w, router_b,
                            moe_w1[i], moe_w3[i], moe_w2[i])
            ctx = ctx + cg_f * y[:, :C]
            x = x + g_f * y[:, C:]
        else:
            x = x + g_f * grouped_moe(hx, router_w, router_b, moe_w1[i], moe_w3[i], moe_w2[i])
    return x
```

```cpp
#include <hip/hip_runtime.h>
#include <cstdio>
#include <cstdint>

constexpr int BATCH = 8, SEQ = 4096, D = 1024, CTXL = 256;
constexpr int ML = BATCH * SEQ;
constexpr int MC = BATCH * CTXL;
constexpr int MT = ML + MC;
constexpr int KVL = CTXL + SEQ;
constexpr int NE = 16, FF = 512;
constexpr int NQ = 136;
constexpr float EPS = 1e-6f;
constexpr int NWAVES = 8;

constexpr size_t MiB = 1u << 20;
constexpr size_t WS_CTL = 0, CTL_ZERO_BYTES = 1 * MiB;
constexpr size_t WS_MOD = 1 * MiB;
constexpr size_t WS_ROPE = 1 * MiB + 512 * 1024;
constexpr size_t WS_ROUTE = 2 * MiB;
constexpr size_t WS_RIDX = 3 * MiB;
constexpr size_t WS_W_IN = 8 * MiB, WS_W_G = 12 * MiB, WS_W_OUT = 13 * MiB, WS_W_QKV = 15 * MiB, WS_W_O = 18 * MiB;
constexpr size_t WS_W13 = 20 * MiB, WS_W2 = 84 * MiB;
constexpr size_t WS_CTX = 116 * MiB;
constexpr size_t WS_XN = 124 * MiB;
constexpr size_t WS_G = 192 * MiB;
constexpr size_t WS_LA0 = 260 * MiB, WS_BB0 = 328 * MiB, WS_LA1 = 396 * MiB;
constexpr size_t WS_ACT = 192 * MiB;
constexpr size_t WS_Y = 264 * MiB;
constexpr size_t WS_Q = 192 * MiB, WS_K = 256 * MiB, WS_V = 273 * MiB;
constexpr size_t WS_O = 290 * MiB;
constexpr size_t WS_XB = 396 * MiB;
constexpr size_t WS_END = 464 * MiB;
constexpr size_t DO_U = 0, DO_SUMM = 68 * MiB, DO_CARRY = 88 * MiB;
constexpr int CW_TMO = 0, CW_CODE = 1, CW_CNT = 64  , CW_BAR = 4096, CW_TILE = 65536  ;

constexpr int RING_OFF = 0, RING_BYTES = 131072;
constexpr int LDSCTL_OFF = RING_BYTES, MISC_OFF = LDSCTL_OFF + 320;
constexpr int TAB_OFF = RING_BYTES + 1024, TAB_UNITS = 6;
constexpr int LDS_BYTES = 147456;
static_assert(TAB_OFF + 2 * TAB_UNITS * 1024 <= LDS_BYTES, "LDS map");

#define GAS __attribute__((address_space(1)))
#define LAS __attribute__((address_space(3)))
typedef unsigned short bf16;
typedef unsigned v4u __attribute__((ext_vector_type(4)));
typedef unsigned v2u __attribute__((ext_vector_type(2)));
typedef float f32x4 __attribute__((ext_vector_type(4)));
typedef float f32x2 __attribute__((ext_vector_type(2)));
typedef short bf16x8 __attribute__((ext_vector_type(8)));
typedef GAS unsigned gu32;
#define RLX_AGENT __ATOMIC_RELAXED, __HIP_MEMORY_SCOPE_AGENT
#define LDS_WAIT() asm volatile("s_waitcnt lgkmcnt(0)" ::: "memory")
#define VM_WAIT() asm volatile("s_waitcnt vmcnt(0)" ::: "memory")
__device__ __forceinline__ unsigned f2bf(float f) { unsigned u = __builtin_bit_cast(unsigned, f); return (u + 0x7fffu + ((u >> 16) & 1u)) >> 16; }
__device__ __forceinline__ unsigned pk2(float lo, float hi) { return f2bf(lo) | (f2bf(hi) << 16); }
__device__ __forceinline__ float bflo(unsigned w) { return __builtin_bit_cast(float, w << 16); }
__device__ __forceinline__ float bfhi(unsigned w) { return __builtin_bit_cast(float, w & 0xffff0000u); }
__device__ __forceinline__ float fast_exp2(float x) { return __builtin_amdgcn_exp2f(x); }
__device__ __forceinline__ float fast_rcp(float x) { return __builtin_amdgcn_rcpf(x); }
__device__ __forceinline__ float sigmoid_f(float x) { return fast_rcp(1.0f + fast_exp2(-1.4426950408889634f * x)); }

#define XB_TMO      128
#define XB_XCNT(j)  (256  + 64 * (j))
#define XB_XSUB(j)  (1280 + 64 * (j))
#define XB_XGEN(j)  (2304 + 64 * (j))
#define XB_TOP      3328
#define XB_TOPGEN   3392
#define XCD_BAR_WORDS 3456
#define XB_SPIN_CAP (1u << 18)

__device__ __forceinline__ unsigned xb_ld(unsigned* p)              { return __hip_atomic_load(p, __ATOMIC_RELAXED, __HIP_MEMORY_SCOPE_AGENT); }
__device__ __forceinline__ unsigned xb_add(unsigned* p, unsigned v) { return __hip_atomic_fetch_add(p, v, __ATOMIC_RELAXED, __HIP_MEMORY_SCOPE_AGENT); }
__device__ __forceinline__ unsigned xb_xcc_id() { return (unsigned)__builtin_amdgcn_s_getreg((3 << 11) | 20) & 0xFu; }
#define XB_SPIN(cond, bar) do { unsigned _sp = 0; while (cond) { __builtin_amdgcn_s_sleep(1); \
    if ((++_sp & 255u) == 0u) { if (xb_ld(&(bar)[XB_TMO])) break; if (_sp > XB_SPIN_CAP) { atomicAdd(&(bar)[XB_TMO], 1u); break; } } } } while (0)

struct XcdBarrier { unsigned* bar; unsigned x; volatile LAS unsigned* st; };

__device__ __forceinline__ XcdBarrier xcd_barrier_post(unsigned* bar, volatile LAS unsigned* st) {
    XcdBarrier b; b.bar = bar; b.x = xb_xcc_id(); b.st = st;
    if (threadIdx.x == 0) (void)xb_add(&bar[XB_XCNT(b.x)], 1u);
    return b;
}
__device__ __forceinline__ void xcd_barrier_complete(unsigned* bar, unsigned x, unsigned& nloc, unsigned& nx) {
    const unsigned G = gridDim.x * gridDim.y * gridDim.z;
    unsigned sum, cnt, mine, sp = 0u;
    for (;;) {
        sum = 0u; cnt = 0u; mine = 0u;
#pragma unroll
        for (unsigned j = 0; j < 16; ++j) { const unsigned c = xb_ld(&bar[XB_XCNT(j)]); sum += c; cnt += (c > 0u) ? 1u : 0u; mine = (j == x) ? c : mine; }
        if (sum == G) break;
        __builtin_amdgcn_s_sleep(1);
        if ((++sp & 255u) == 0u) { if (xb_ld(&bar[XB_TMO])) break; if (sp > XB_SPIN_CAP) { atomicAdd(&bar[XB_TMO], 1u); break; } }
    }
    nloc = mine > 0u ? mine : 1u; nx = cnt > 0u ? cnt : 1u;
}
__device__ __forceinline__ void xcd_barrier(const XcdBarrier& b) {
    asm volatile("s_waitcnt vmcnt(0)" ::: "memory");
    __syncthreads();
    if (threadIdx.x == 0) {
        unsigned* bar = b.bar;
        __builtin_amdgcn_s_waitcnt(0);
        unsigned nloc = b.st[0], nx = b.st[1];
        if (nloc == 0u) { xcd_barrier_complete(bar, b.x, nloc, nx); b.st[0] = nloc; b.st[1] = nx; }
        const unsigned old = xb_add(&bar[XB_XSUB(b.x)], 1u);
        const unsigned gen = old / nloc;
        if (old + 1u == (gen + 1u) * nloc) {
            __builtin_amdgcn_fence(__ATOMIC_RELEASE, "agent");
            asm volatile("s_waitcnt vmcnt(0)" ::: "memory");
            const unsigned og = xb_add(&bar[XB_TOP], 1u);
            const unsigned tg = og / nx;
            if (og + 1u == (tg + 1u) * nx) xb_add(&bar[XB_TOPGEN], 1u);
            else XB_SPIN(xb_ld(&bar[XB_TOPGEN]) == tg, bar);
            __builtin_amdgcn_fence(__ATOMIC_ACQUIRE, "agent");
            xb_add(&bar[XB_XGEN(b.x)], 1u);
            asm volatile("s_waitcnt vmcnt(0)" ::: "memory");
        } else {
            XB_SPIN(xb_ld(&bar[XB_XGEN(b.x)]) == gen, bar);
            __builtin_amdgcn_fence(__ATOMIC_ACQUIRE, "agent");
            asm volatile("s_waitcnt vmcnt(0)" ::: "memory");
        }
    }
    __syncthreads();
}
namespace pg8 {
#define PG8_LAS __attribute__((address_space(3)))
typedef unsigned short bf16_t;
typedef short bf16x8 __attribute__((ext_vector_type(8)));
typedef float f32x4 __attribute__((ext_vector_type(4)));
typedef unsigned u32x4 __attribute__((ext_vector_type(4)));
constexpr int BM = 256, BK = 64, HALF = 128, HTB = HALF * BK * 2, STAGE_BYTES = 8 * HTB, NXCD = 8, WGM = 8;

__host__ __device__ __forceinline__ int lds_byte(int r, int c) { const int st = (r >> 4) * 2 + (c >> 5), rr = r & 15, cc = c & 31, ob = rr * 64 + cc * 2; return st * 1024 + (ob ^ (((ob >> 9) & 1) << 5)); }
__host__ __device__ __forceinline__ void stage_rc(int b, int& R, int& C) { const int st = b / 1024, sb = b % 1024, swz = sb ^ (((sb >> 9) & 1) << 5); R = (st >> 1) * 16 + swz / 64; C = (st & 1) * 32 + (swz % 64) / 2; }
__host__ __device__ __forceinline__ int perm32(int rho) { const int n = rho >> 4, i = rho & 15; return 8 * (i >> 2) + 4 * n + (i & 3); }

struct Unit { int pm, pn; int arow, acol, brow; int x0, x1, x2, ord; int brow2, ksplit; };
struct Gemm { const void* A; const void* Bt; int lda, ldb, K; unsigned* hcnt = nullptr; unsigned hneed = 8u; };
typedef int v8i32 __attribute__((ext_vector_type(8)));
struct Frag2 { bf16x8 v[2]; __device__ __forceinline__ bf16x8& operator[](int i) { return v[i]; } __device__ __forceinline__ const bf16x8& operator[](int i) const { return v[i]; } };

__device__ __forceinline__ void tile_of(int L, int nM, int nN, int& pm, int& pn) {
    const int nwg = nM * nN; int wgid = L;
    { const int q = nwg / NXCD, r = nwg % NXCD, xcd = wgid % NXCD, off = wgid / NXCD; wgid = (xcd < r ? xcd * (q + 1) : r * (q + 1) + (xcd - r) * q) + off; }
    const int nig = WGM * nN, gid = wgid / nig, fm = gid * WGM, gsz = (nM - fm) < WGM ? (nM - fm) : WGM;
    pm = fm + ((wgid % nig) % gsz); pn = (wgid % nig) / gsz;
}

__device__ __forceinline__ unsigned cvt_pk_bf16(float lo, float hi) { unsigned r; asm volatile("v_cvt_pk_bf16_f32 %0, %1, %2" : "=v"(r) : "v"(lo), "v"(hi)); return r; }

constexpr unsigned HO_SPIN_CAP = 1u << 22;
__device__ __forceinline__ void ho_publish(unsigned* hcnt, int tile) { (void)__hip_atomic_fetch_add(hcnt + tile * 16, 1u, __ATOMIC_RELAXED, __HIP_MEMORY_SCOPE_AGENT); }
__device__ __forceinline__ void ho_acquire(unsigned* hcnt, int tile, unsigned need) {
    unsigned sp = 0; unsigned* htmo = hcnt - 16;
    while ((unsigned)__builtin_amdgcn_readfirstlane((int)__hip_atomic_load(hcnt + tile * 16, __ATOMIC_RELAXED, __HIP_MEMORY_SCOPE_AGENT)) < need) {
        __builtin_amdgcn_s_sleep(1);
        if ((++sp & 255u) == 0u) { if (__builtin_amdgcn_readfirstlane((int)__hip_atomic_load(htmo, __ATOMIC_RELAXED, __HIP_MEMORY_SCOPE_AGENT))) break;
            if (sp > HO_SPIN_CAP) { (void)__hip_atomic_fetch_add(htmo, 1u, __ATOMIC_RELAXED, __HIP_MEMORY_SCOPE_AGENT); break; } } }
    __builtin_amdgcn_fence(__ATOMIC_ACQUIRE, "agent");
    asm volatile("s_waitcnt vmcnt(0)" ::: "memory");
}
template <class Epi, class Sched, bool GATHER, int ES = 2, int HO = 0>
__device__ __forceinline__ void gemm_phase(PG8_LAS unsigned char* lds, const Gemm g, const Sched& S, const Epi& E, const PG8_LAS int* tab) {
    const int tid = threadIdx.x, wid = __builtin_amdgcn_readfirstlane(tid >> 6), lane = tid & 63, wr = wid >> 2, wc = wid & 3, fr = lane & 15, fq = lane >> 4;
    const int K = g.K, nt = K * ES / (BK * 2), lda = g.lda * ES, ldb = g.ldb * ES;
    unsigned voffA[2], voffB[2]; int Rst[2], Cst[2];
#pragma unroll
    for (int i = 0; i < 2; ++i) { int R, C; stage_rc(tid * 16 + i * 8192, R, C); const int Rb = Epi::PERM ? ((R & ~31) + perm32(R & 31)) : R;
        voffA[i] = (unsigned)(R * lda + C * 2); voffB[i] = (unsigned)(Rb * ldb + C * 2); Rst[i] = R; Cst[i] = C * 2; }
    const size_t kstep = (size_t)(BK * 2);
    const size_t hstepA = GATHER ? (size_t)0 : (size_t)HALF * lda, hstepB = (size_t)HALF * ldb;
    const unsigned ldsw = (unsigned)wid * 1024u;
    const int aoff = lds_byte(wr * 64 + fr, fq * 8), boff = lds_byte(wc * 32 + fr, fq * 8);
#define PG8_SA(b, h) (((b) * 2 + (h)) * HTB)
#define PG8_SB(b, h) ((4 + (b) * 2 + (h)) * HTB)
#define PG8_STAGE(bufoff, gbase, voff) do { _Pragma("unroll") for (int _i = 0; _i < 2; ++_i) \
        __builtin_amdgcn_global_load_lds((const unsigned*)((const char*)(gbase) + (voff)[_i]), (PG8_LAS unsigned*)(lds + (bufoff) + ldsw + _i * 8192), 16, 0, 0); } while (0)
#define PG8_LDA(dst, b, h) do { _Pragma("unroll") for (int m = 0; m < 4; ++m) _Pragma("unroll") for (int k = 0; k < 2; ++k) dst[m][k] = *(const PG8_LAS bf16x8*)(lds + PG8_SA(b, h) + aoff + m * 2048 + k * 1024); } while (0)
#define PG8_LDB(dst, b, h) do { _Pragma("unroll") for (int n = 0; n < 2; ++n) _Pragma("unroll") for (int k = 0; k < 2; ++k) dst[n][k] = *(const PG8_LAS bf16x8*)(lds + PG8_SB(b, h) + boff + n * 2048 + k * 1024); } while (0)
#define PG8_MMA(ai, bj, At, Bt) do { __builtin_amdgcn_s_setprio(1); \
        if constexpr (ES == 2) { _Pragma("unroll") for (int m = 0; m < 4; ++m) _Pragma("unroll") for (int n = 0; n < 2; ++n) _Pragma("unroll") for (int k = 0; k < 2; ++k) \
            acc[ai][bj][m][n] = __builtin_amdgcn_mfma_f32_16x16x32_bf16(Bt[n][k], At[m][k], acc[ai][bj][m][n], 0, 0, 0); } \
        else { asm volatile("s_nop 1"); _Pragma("unroll") for (int m = 0; m < 4; ++m) _Pragma("unroll") for (int n = 0; n < 2; ++n) \
            asm volatile("v_mfma_f32_16x16x128_f8f6f4 %0, %1, %2, %0" : "+v"(acc[ai][bj][m][n]) : "v"(__builtin_bit_cast(v8i32, Bt[n])), "v"(__builtin_bit_cast(v8i32, At[m]))); } \
        __builtin_amdgcn_s_setprio(0); } while (0)
#define PG8_WAIT_V(n) asm volatile("s_waitcnt vmcnt(" #n ")" ::: "memory")
#define PG8_WAIT_L(n) asm volatile("s_waitcnt lgkmcnt(" #n ")" ::: "memory")
#define PG8_BAR __builtin_amdgcn_s_barrier()
#define PG8_SCHED __builtin_amdgcn_sched_barrier(0)
#define PG8_GLOAD(dst, ui_) do { _Pragma("unroll") for (int _h = 0; _h < 2; ++_h) _Pragma("unroll") for (int _i = 0; _i < 2; ++_i) \
        dst[_h][_i] = (unsigned)tab[(ui_) * 256 + _h * 128 + Rst[_i]] * (unsigned)lda + (unsigned)Cst[_i]; } while (0)
    const int sc8 = 0x7f7f7f7f;
    (void)sc8;
    Unit cur, nxt; int ui = 0;
    if (!S.next(0, cur)) return;
    f32x4 acc[2][2][4][2];
#pragma unroll
    for (int a = 0; a < 2; ++a)
#pragma unroll
        for (int b = 0; b < 2; ++b)
#pragma unroll
            for (int m = 0; m < 4; ++m)
#pragma unroll
                for (int n = 0; n < 2; ++n) acc[a][b][m][n] = (f32x4){0.f, 0.f, 0.f, 0.f};
    Frag2 At[4], B0[2], B1[2];
    unsigned gcur[2][2], gnxt[2][2];
    if constexpr (GATHER) { PG8_GLOAD(gcur, 0); } else {
#pragma unroll
        for (int h = 0; h < 2; ++h)
#pragma unroll
            for (int i = 0; i < 2; ++i) { gcur[h][i] = voffA[i]; gnxt[h][i] = voffA[i]; } }
    const char* cA = (const char*)g.A + (size_t)(GATHER ? 0 : cur.arow) * lda + (size_t)cur.acol * ES; const char* cB = (const char*)g.Bt + (size_t)cur.brow * ldb;
    const char* cB2 = cur.ksplit ? (const char*)g.Bt + (size_t)cur.brow2 * ldb - (size_t)cur.ksplit * kstep : cB; int ksp = cur.ksplit ? cur.ksplit : (1 << 30);
    int pend = -1;
    if constexpr (HO == 2) { if (wid == 0) ho_acquire(g.hcnt, cur.pm, g.hneed); __syncthreads(); }
    PG8_STAGE(PG8_SB(0, 0), cB, voffB); PG8_STAGE(PG8_SB(0, 1), cB + hstepB, voffB); PG8_STAGE(PG8_SA(0, 0), cA, gcur[0]); PG8_STAGE(PG8_SA(0, 1), cA + hstepA, gcur[1]);
    if (wr == 1) PG8_BAR;
    PG8_WAIT_V(2); PG8_BAR;
    PG8_STAGE(PG8_SB(1, 0), cB + kstep, voffB); PG8_STAGE(PG8_SA(1, 0), cA + kstep, gcur[0]); PG8_STAGE(PG8_SB(1, 1), cB + hstepB + kstep, voffB);
    PG8_WAIT_V(6); PG8_BAR;
    for (;;) {
        const bool has_next = S.next(ui + 1, nxt);
        if constexpr (HO == 2) { if (has_next && wid == 0) ho_acquire(g.hcnt, nxt.pm, g.hneed); }
        const char* nA = has_next ? (const char*)g.A + (size_t)(GATHER ? 0 : nxt.arow) * lda + (size_t)nxt.acol * ES : cA; const char* nB = has_next ? (const char*)g.Bt + (size_t)nxt.brow * ldb : cB;
        if constexpr (GATHER) { if (has_next) { PG8_GLOAD(gnxt, ui + 1); } else {
#pragma unroll
            for (int h = 0; h < 2; ++h)
#pragma unroll
                for (int i = 0; i < 2; ++i) gnxt[h][i] = gcur[h][i]; } }
#pragma nounroll
        for (int t = 0; t < nt; t += 2) {
            const bool last = (t == nt - 2);
            const char* a1 = cA + (size_t)(t + 1) * kstep;
            const char* a2 = last ? nA : cA + (size_t)(t + 2) * kstep; const char* b2 = last ? nB : (t + 2 >= ksp ? cB2 : cB) + (size_t)(t + 2) * kstep;
            const char* a3 = a2 + kstep; const char* b3 = b2 + kstep;
            unsigned s0[2], s1[2];
#pragma unroll
            for (int i = 0; i < 2; ++i) { s0[i] = (GATHER && last) ? gnxt[0][i] : gcur[0][i]; s1[i] = (GATHER && last) ? gnxt[1][i] : gcur[1][i]; }
            PG8_LDB(B0, 0, 0); PG8_LDB(B1, 0, 1); PG8_SCHED; PG8_LDA(At, 0, 0); PG8_STAGE(PG8_SA(1, 1), a1 + hstepA, gcur[1]);
            PG8_WAIT_V(8); PG8_WAIT_L(0); PG8_BAR; PG8_MMA(0, 0, At, B0); PG8_MMA(0, 1, At, B1); PG8_BAR; PG8_SCHED;
            PG8_LDA(At, 0, 1); PG8_STAGE(PG8_SB(0, 0), b2, voffB); PG8_STAGE(PG8_SB(0, 1), b2 + hstepB, voffB); PG8_STAGE(PG8_SA(0, 0), a2, s0);
            PG8_WAIT_V(8); PG8_WAIT_L(0); PG8_BAR; PG8_MMA(1, 0, At, B0); PG8_MMA(1, 1, At, B1); PG8_BAR; PG8_SCHED;
            PG8_LDB(B0, 1, 0); PG8_LDB(B1, 1, 1); PG8_SCHED; PG8_LDA(At, 1, 0); PG8_STAGE(PG8_SA(0, 1), a2 + hstepA, s1);
            PG8_WAIT_V(8); PG8_WAIT_L(0); PG8_BAR; PG8_MMA(0, 0, At, B0); PG8_MMA(0, 1, At, B1); PG8_BAR; PG8_SCHED;
            PG8_LDA(At, 1, 1); PG8_STAGE(PG8_SB(1, 0), b3, voffB); PG8_STAGE(PG8_SB(1, 1), b3 + hstepB, voffB); PG8_STAGE(PG8_SA(1, 0), a3, s0);
            PG8_WAIT_V(8); PG8_WAIT_L(0); PG8_BAR; PG8_MMA(1, 0, At, B0); PG8_MMA(1, 1, At, B1); PG8_BAR; PG8_SCHED;
        }
        if (wr == 0) PG8_BAR;
        if constexpr (HO == 1) { if (pend >= 0 && tid == 0) ho_publish(g.hcnt, pend); }
        if constexpr (ES == 1) asm volatile("s_nop 15\n\ts_nop 15" ::: "memory");
        E(acc, cur, wr, wc, fr, fq);
        if constexpr (HO == 1) pend = cur.pm;
        if (!has_next) break;
#pragma unroll
        for (int a = 0; a < 2; ++a)
#pragma unroll
            for (int b = 0; b < 2; ++b)
#pragma unroll
                for (int m = 0; m < 4; ++m)
#pragma unroll
                    for (int n = 0; n < 2; ++n) acc[a][b][m][n] = (f32x4){0.f, 0.f, 0.f, 0.f};
        cur = nxt; cA = nA; cB = nB; ++ui;
        cB2 = cur.ksplit ? (const char*)g.Bt + (size_t)cur.brow2 * ldb - (size_t)cur.ksplit * kstep : cB; ksp = cur.ksplit ? cur.ksplit : (1 << 30);
        if constexpr (GATHER) {
#pragma unroll
            for (int h = 0; h < 2; ++h)
#pragma unroll
                for (int i = 0; i < 2; ++i) gcur[h][i] = gnxt[h][i]; }
        if (wr == 1) PG8_BAR;
    }
    PG8_WAIT_V(0);
    PG8_BAR;
    if constexpr (HO == 1) { if (pend >= 0 && tid == 0) ho_publish(g.hcnt, pend); }
#undef PG8_SA
#undef PG8_SB
#undef PG8_STAGE
#undef PG8_LDA
#undef PG8_LDB
#undef PG8_MMA
#undef PG8_WAIT_V
#undef PG8_WAIT_L
#undef PG8_BAR
#undef PG8_SCHED
#undef PG8_GLOAD
}
}
namespace attn8 {
using f32x16 = __attribute__((ext_vector_type(16))) float;
using f32x4 = __attribute__((ext_vector_type(4))) float;
using u32x4 = __attribute__((ext_vector_type(4))) unsigned;
using v8i32 = __attribute__((ext_vector_type(8))) int;
constexpr int NHEAD = 16, SEQ = 4096, KVSEQ = 4352, DMQ = 1024, DMK = 256, NT = KVSEQ / 64;
constexpr float QS = 2.0f * 1.4426950408889634f, KS = 0.5f, VS = 8.0f, PS = 16.0f, OS = 4.0f;
constexpr float CS = 0.125f * 1.4426950408889634f / (QS * KS);
constexpr int THRL = 4;
constexpr int SLOTB = 4096, LDS_BYTES = 16 * SLOTB + 8 * 256 + 8 * 4096;
__host__ __device__ __forceinline__ int crow(int r, int hi) { return (r & 3) + 8 * (r >> 2) + 4 * hi; }
__host__ __device__ __forceinline__ int vpos(int kk) { return 32 * ((kk >> 2) & 1) + (kk & 3) + 4 * ((kk >> 3) & 3) + 16 * (kk >> 5); }
__device__ __forceinline__ void glds16(const void* gsrc, unsigned lds_dst) { unsigned keep;
    asm volatile("s_mov_b32 %0, m0\n\ts_mov_b32 m0, %2\n\ts_nop 0\n\tglobal_load_lds_dwordx4 %1, off\n\ts_mov_b32 m0, %0" : "=&s"(keep) : "v"(gsrc), "s"(lds_dst) : "memory"); }
#define A8_WAIT_BAR(N) asm volatile("s_waitcnt vmcnt(" #N ") lgkmcnt(0)\n\ts_barrier" ::: "memory")
__device__ __forceinline__ unsigned pk4(float a, float b, float c, float d) { unsigned w = 0u; w = (unsigned)__builtin_amdgcn_cvt_pk_fp8_f32(a, b, (int)w, false); w = (unsigned)__builtin_amdgcn_cvt_pk_fp8_f32(c, d, (int)w, true); return w; }
typedef __attribute__((address_space(3))) const unsigned char* lds_cptr;

__device__ __forceinline__ float max3f(float a, float b, float c) { float r; asm("v_max3_f32 %0, %1, %2, %3" : "=v"(r) : "v"(a), "v"(b), "v"(c)); return r; }
__device__ __forceinline__ unsigned pk4a(float a, float b, float c, float d) { unsigned w; asm("v_cvt_pk_fp8_f32 %0, %1, %2\n\tv_cvt_pk_fp8_f32 %0, %3, %4 op_sel:[0,0,1]" : "=&v"(w) : "v"(a), "v"(b), "v"(c), "v"(d)); return w; }
constexpr int NSLOTV = 4;
constexpr int LDS2_K = 0, LDS2_V = 8 * SLOTB, LDS2_WS = LDS2_V + 8 * SLOTB, LDS2_OST = LDS2_WS + 8 * 256, LDS2_BYTES = LDS2_OST + 8 * 4096;
__device__ __forceinline__ void attn_unit(int b, int h, int qb, bool first, bool has_next, int nb, int nh, const unsigned char* Q8, const unsigned char* K8, const unsigned char* Vt8, unsigned char* O8, char* shm) {
    const int tid = threadIdx.x, lane = tid & 63, r32 = lane & 31, hi = lane >> 5; const int wid = __builtin_amdgcn_readfirstlane(tid >> 6);
    const int kvh = h >> 2, q0 = qb * 256;
    const unsigned lds0 = (unsigned)(uintptr_t)shm;
    float* wsf = (float*)(shm + LDS2_WS) + wid * 64;
    const unsigned char* qp = Q8 + (size_t)((size_t)b * SEQ + q0 + wid * 32 + r32) * DMQ + h * 64 + 32 * hi;
    const u32x4 qa = __builtin_nontemporal_load((const u32x4*)qp), qb4 = __builtin_nontemporal_load((const u32x4*)(qp + 16));
    const v8i32 q8 = {(int)qa.x, (int)qa.y, (int)qa.z, (int)qa.w, (int)qb4.x, (int)qb4.y, (int)qb4.z, (int)qb4.w};
    const int w4 = wid & 3, drow = w4 * 16 + (lane >> 2), dc = (lane & 3) ^ ((drow >> 2) & 3);
    const bool isk = wid < 4;
    const unsigned char* dsrc = isk ? K8 + ((size_t)b * KVSEQ + drow) * DMK + kvh * 64 + dc * 16 : Vt8 + ((size_t)(b * 4 + kvh) * 64 + drow) * KVSEQ + dc * 16;
    const size_t dstep = isk ? (size_t)64 * DMK : (size_t)64;
    const unsigned ddst = lds0 + (isk ? LDS2_K : LDS2_V) + w4 * 1024;
#define A8_DMA(t, slot) glds16(dsrc + (size_t)(t) * dstep, (unsigned)__builtin_amdgcn_readfirstlane(ddst + (slot)))
    if (first) { A8_DMA(0, 0); A8_DMA(1, SLOTB); A8_DMA(2, 2 * SLOTB); if (isk) { A8_DMA(3, 3 * SLOTB); A8_DMA(4, 4 * SLOTB); } }
    const int sw = (r32 >> 2) & 3, fo0 = r32 * 64 + (((2 * hi) ^ sw) << 4), fo1 = r32 * 64 + (((2 * hi + 1) ^ sw) << 4);
    const lds_cptr kb = (lds_cptr)shm + LDS2_K, vb = (lds_cptr)shm + LDS2_V;
    typedef const __attribute__((address_space(3))) u32x4* lds_v4;
#define A8_FRAG(dst, base, off) do { const u32x4 a_ = *(lds_v4)((base) + (off) + fo0), b_ = *(lds_v4)((base) + (off) + fo1); \
        dst = (v8i32){(int)a_.x, (int)a_.y, (int)a_.z, (int)a_.w, (int)b_.x, (int)b_.y, (int)b_.z, (int)b_.w}; } while (0)
    constexpr float LP = 4.0f, DB = 55.66f, DTH = 8.0f * (LP + (float)THRL) + DB;
    float mhat = 0.f; f32x16 o0 = f32x16{}, o1 = f32x16{}; f32x4 ls4 = f32x4{};
    f32x16 cb; { const float c_ = 8.0f * LP + DB;
#pragma unroll
      for (int r = 0; r < 16; ++r) cb[r] = c_; }
    constexpr int sc1 = 0, scq = 0;
    const int selv = (((lane >> 4) & 1) == ((lane & 15) >> 3)) ? 0x38383838 : 0; const v8i32 sel = {selv, selv, selv, selv, selv, selv, selv, selv};
    const int qs0 = 4 * (lane >> 4) + 16 * ((lane & 15) >> 3);
    A8_WAIT_BAR(0);
    f32x16 c0, c1;
    { v8i32 kf0, kf1; A8_FRAG(kf0, kb, 0); A8_FRAG(kf1, kb, 2048);
      c0 = __builtin_amdgcn_mfma_scale_f32_32x32x64_f8f6f4(kf0, q8, cb, 0, 0, 0, scq, 0, sc1);
      c1 = __builtin_amdgcn_mfma_scale_f32_32x32x64_f8f6f4(kf1, q8, cb, 0, 0, 0, scq, 0, sc1); }
    asm volatile("s_nop 15\n\ts_nop 15\n\ts_nop 15\n\ts_nop 15\n\ts_nop 15\n\ts_nop 15" : "+v"(c0), "+v"(c1));
    v8i32 p8 = {0, 0, 0, 0, 0, 0, 0, 0};
    f32x16 d0, d1;
#define A8_STEP(S0, S1, N0, N1, t, SOFTMAX, BAR) do { \
        if (BAR) { A8_WAIT_BAR(0);                                                     \
            _Pragma("unroll") for (int i_ = 0; i_ < 4; ++i_) { const int tk_ = (t) + 5 + i_, tv_ = (t) + 3 + i_; \
                if (isk) { if (tk_ < NT) A8_DMA(tk_, (tk_ & 7) * SLOTB); } else { if (tv_ < NT) A8_DMA(tv_, (tv_ & 7) * SLOTB); } } } \
        v8i32 kf0, kf1, vf0, vf1; \
        { const lds_cptr kp_ = kb + (((t) + 1) & 7) * SLOTB; A8_FRAG(kf0, kp_, 0); A8_FRAG(kf1, kp_, 2048); }     \
        { const lds_cptr vp_ = vb + (((t) == 0 ? 0 : (t) - 1) & 7) * SLOTB; A8_FRAG(vf0, vp_, 0); A8_FRAG(vf1, vp_, 2048); }     \
        __builtin_amdgcn_sched_barrier(0); \
        float rmc; \
        { float a = fmaxf(S0[0], S1[0]), bq = fmaxf(S0[1], S1[1]); \
          _Pragma("unroll") for (int r = 2; r < 16; r += 2) { a = __builtin_fmaxf(__builtin_fmaxf(a, S0[r]), S1[r]); bq = __builtin_fmaxf(__builtin_fmaxf(bq, S0[r + 1]), S1[r + 1]); } \
          rmc = fmaxf(a, bq); } \
        { auto rr = __builtin_amdgcn_permlane32_swap(__float_as_uint(rmc), __float_as_uint(rmc), false, false); rmc = fmaxf(__uint_as_float(rr[0]), __uint_as_float(rr[1])); } \
        __builtin_amdgcn_sched_barrier(0); \
        N0 = __builtin_amdgcn_mfma_scale_f32_32x32x64_f8f6f4(kf0, q8, cb, 0, 0, 0, scq, 0, sc1); \
        N1 = __builtin_amdgcn_mfma_scale_f32_32x32x64_f8f6f4(kf1, q8, cb, 0, 0, 0, scq, 0, sc1); \
        o0 = __builtin_amdgcn_mfma_scale_f32_32x32x64_f8f6f4(p8, vf0, o0, 0, 0, 0, sc1, 0, sc1); \
        o1 = __builtin_amdgcn_mfma_scale_f32_32x32x64_f8f6f4(p8, vf1, o1, 0, 0, 0, sc1, 0, sc1); \
        ls4 = __builtin_amdgcn_mfma_scale_f32_16x16x128_f8f6f4(p8, sel, ls4, 0, 0, 0, sc1, 0, sc1); \
        __builtin_amdgcn_sched_barrier(0); \
        if (SOFTMAX) { \
            bool resc = false; \
            if ((t) == 0 || __any(rmc > DTH)) {                                       \
                const float dl = ((t) == 0) ? (rmc - DB) * 0.125f - LP : fmaxf((rmc - DB) * 0.125f - LP, 0.f); mhat += dl; const float dl8 = 8.0f * dl; \
                _Pragma("unroll") for (int r = 0; r < 16; ++r) { S0[r] -= dl8; S1[r] -= dl8; N0[r] -= dl8; N1[r] -= dl8; cb[r] -= dl8; } \
                const float f = __builtin_amdgcn_exp2f(-dl); if (hi == 0) wsf[r32] = f; resc = true; } \
            _Pragma("unroll") for (int g = 0; g < 4; ++g) { unsigned wa = __builtin_amdgcn_cvt_pk_u8_f32(S0[4 * g], 0, 0u), wb = __builtin_amdgcn_cvt_pk_u8_f32(S1[4 * g], 0, 0u); \
                _Pragma("unroll") for (int j = 1; j < 4; ++j) { wa = __builtin_amdgcn_cvt_pk_u8_f32(S0[4 * g + j], j, wa); wb = __builtin_amdgcn_cvt_pk_u8_f32(S1[4 * g + j], j, wb); } \
                p8[g] = (int)wa; p8[4 + g] = (int)wb; } \
            if (resc) { asm volatile("s_waitcnt lgkmcnt(0)" ::: "memory"); \
                _Pragma("unroll") for (int r = 0; r < 16; ++r) { const float f = wsf[crow(r, hi)]; o0[r] *= f; o1[r] *= f; } \
                _Pragma("unroll") for (int i = 0; i < 4; ++i) ls4[i] *= wsf[qs0 + i]; } \
        } \
    } while (0)
    static_assert(NT % 4 == 0, "groups of four tiles");
#pragma nounroll
    for (int t = 0; t < NT; t += 4) {
        A8_STEP(c0, c1, d0, d1, t, true, true);
        A8_STEP(d0, d1, c0, c1, t + 1, true, false);
        A8_STEP(c0, c1, d0, d1, t + 2, true, false);
        A8_STEP(d0, d1, c0, c1, t + 3, true, false);
    }
    A8_STEP(c0, c1, d0, d1, NT, false, true);
#undef A8_STEP
    asm volatile("s_waitcnt lgkmcnt(0)\n\ts_barrier" ::: "memory");
    if (has_next) { const int nkvh = nh >> 2;
        const unsigned char* nsrc = isk ? K8 + ((size_t)nb * KVSEQ + drow) * DMK + nkvh * 64 + dc * 16 : Vt8 + ((size_t)(nb * 4 + nkvh) * 64 + drow) * KVSEQ + dc * 16;
#define A8_DMAN(t, slot) glds16(nsrc + (size_t)(t) * dstep, (unsigned)__builtin_amdgcn_readfirstlane(ddst + (slot)))
        A8_DMAN(0, 0); A8_DMAN(1, SLOTB); A8_DMAN(2, 2 * SLOTB); if (isk) { A8_DMAN(3, 3 * SLOTB); A8_DMAN(4, 4 * SLOTB); }
#undef A8_DMAN
    }
    if ((lane & 7) == 0) {
#pragma unroll
        for (int i = 0; i < 4; ++i) wsf[32 + qs0 + i] = ls4[i]; }
    asm volatile("s_waitcnt lgkmcnt(0)" ::: "memory");
    unsigned char* Ow = O8 + (size_t)((size_t)b * SEQ + q0 + wid * 32) * DMQ + h * 64;
    { unsigned char* stg = (unsigned char*)(shm + LDS2_OST) + wid * 4096;
#pragma unroll
      for (int r = 0; r < 16; ++r) { const int orow = crow(r, hi); const float rl = __builtin_amdgcn_rcpf(wsf[32 + orow]) * (OS / VS);
          const float a = o0[r] * rl, c = o1[r] * rl;
          stg[orow * 64 + r32] = (unsigned char)__builtin_amdgcn_cvt_pk_fp8_f32(a, a, 0, false); stg[orow * 64 + 32 + r32] = (unsigned char)__builtin_amdgcn_cvt_pk_fp8_f32(c, c, 0, false); }
      asm volatile("s_waitcnt lgkmcnt(0)" ::: "memory");
#pragma unroll
      for (int i = 0; i < 2; ++i) { const int row = i * 16 + (lane >> 2), ch = lane & 3; const u32x4 v = *(const u32x4*)(stg + row * 64 + ch * 16); *(u32x4*)(Ow + (size_t)row * DMQ + ch * 16) = v; } }
    asm volatile("s_waitcnt lgkmcnt(0)" ::: "memory");
#undef A8_DMA
#undef A8_FRAG
}
struct Tensors { const unsigned char* Q8; const unsigned char* K8; const unsigned char* Vt8; unsigned char* O8; };
__device__ __forceinline__ void attn_phase(char* lds, const Tensors& T, int grid, int block) {
    const int vcu = (grid % 8 == 0) ? (block % 8) * (grid / 8) + block / 8 : block;
    const int n = (grid == 256) ? 8 : (vcu < 2048 ? (2048 - vcu + grid - 1) / grid : 0);
    for (int i = 0; i < n; ++i) {
        const int idx = (grid == 256) ? (vcu >> 5) * 256 + i * 32 + (vcu & 31) : i * grid + vcu;
        const int idn = (grid == 256) ? (vcu >> 5) * 256 + (i + 1) * 32 + (vcu & 31) : (i + 1) * grid + vcu;
        const int b = idx >> 8, r = idx & 255, rn = idn & 255;
        attn_unit(b, (r >> 6) * 4 + ((r >> 4) & 3), r & 15, i == 0, i + 1 < n, idn >> 8, (rn >> 6) * 4 + ((rn >> 4) & 3), T.Q8, T.K8, T.Vt8, T.O8, lds);
    }
}
#undef A8_WAIT_BAR
}
namespace pg8 {
struct SchedDense {
    int nM, nN, G, c;
    __device__ __forceinline__ bool next(int i, Unit& u) const {
        const int L = i * G + c; if (L >= nM * nN) return false;
        tile_of(L, nM, nN, u.pm, u.pn); u.arow = u.pm * BM; u.acol = 0; u.brow = u.pn * BM; u.x0 = 0; u.x1 = 0; u.x2 = 0; u.ord = i; u.brow2 = 0; u.ksplit = 0; return true; }
};
struct SchedOut {
    int G, c, E;
    __device__ __forceinline__ bool next(int i, Unit& u) const {
        u.acol = 0; u.x0 = 0; u.x1 = 0; u.x2 = 0; u.ord = i; u.brow2 = 0; u.ksplit = 0;
        if (E == 0) { const int L = i * G + c; if (L >= (MT / 256) * 4) return false; tile_of(L, MT / 256, 4, u.pm, u.pn); }
        else { const bool early = c >= G - E;
            if (early && i < 2) { const int e = c - (G - E), m = (e >> 3) + (E >> 3) * i; u.pm = 6 * (e & 7) + (m >> 2); u.pn = m & 3; }
            else { const int L = (early ? i - 2 : i) * G + c, nM = MT / 256 - E / 2; if (L >= nM * 4) return false; int pm_; tile_of(L, nM, 4, pm_, u.pn); u.pm = E / 2 + pm_; } }
        u.arow = u.pm * BM; u.brow = u.pn * BM; return true; }
};
__host__ __device__ __forceinline__ int in_gs(int g) { return g == 0 ? 0 : 1 + 27 * g; }
struct SchedIn {
    int G, c, E;
    __device__ __forceinline__ int cl() const { return E ? (c + E) % G : c; }
    __device__ __forceinline__ bool next(int i, Unit& u) const {
        u.acol = 0; u.x0 = 0; u.x1 = 0; u.x2 = 0; u.ord = i; u.brow2 = 0; u.ksplit = 0;
        if (E == 0) { const int L = i * G + c; if (L >= (MT / 256) * 8) return false; tile_of(L, MT / 256, 8, u.pm, u.pn); }
        else { const bool early = c >= G - E;
            if (early && i < 2) { const int e = c - (G - E), m = (e >> 3) + (E >> 3) * i, ep = 3 * (e & 7) + (m >> 3); u.pm = in_gs(ep % 5) + ep / 5; u.pn = m & 7; }
            else { const int L = (early ? i - 2 : i) * G + cl(); if (L >= 112 * 8) return false; int r; tile_of(L, 112, 8, r, u.pn);
                const int g = (r >= 23) + (r >= 45) + (r >= 67) + (r >= 89), base = g == 0 ? 0 : 1 + 22 * g;
                u.pm = in_gs(g) + (g < 4 ? 5 : 4) + (r - base); } }
        u.arow = u.pm * BM; u.brow = u.pn * BM; return true; }
};
struct SchedGates {
    int nM, G, c;
    __device__ __forceinline__ bool next(int i, Unit& u) const {
        const int L = i * G + c; if (L >= nM * 16) return false;
        tile_of(L, nM, 16, u.pm, u.pn); u.arow = u.pm * BM; u.acol = (u.pn >> 1) * 128; u.brow = u.pn * BM; u.x0 = 0; u.x1 = 0; u.x2 = 0; u.ord = i; u.brow2 = 0; u.ksplit = 0; return true; }
};
struct SchedQKV {
    int G, c;
    __device__ __forceinline__ bool next(int i, Unit& u) const {
        const int L = i * G + c; if (L >= 128 * 6 + 16) return false;
        if (L < 768) tile_of(L, 128, 6, u.pm, u.pn); else { const int j = L - 768; u.pm = 128 + (j >> 1); u.pn = 4 + (j & 1); }
        u.arow = u.pm * BM; u.acol = 0; u.brow = u.pn * BM; u.x0 = 0; u.x1 = 0; u.x2 = 0; u.ord = i; u.brow2 = 0; u.ksplit = 0; return true; }
};
template <bool UP>
struct SchedMoe {
    unsigned cnt[24]; int G, c, total;
    __device__ __forceinline__ void init(const unsigned* cw, int G_, int c_) {
        int acc = 0;
#pragma unroll
        for (int j = 0; j < 24; ++j) { cnt[j] = (unsigned)__builtin_amdgcn_readfirstlane((int)__hip_atomic_load(cw + j, __ATOMIC_RELAXED, __HIP_MEMORY_SCOPE_AGENT)); acc += (int)((cnt[j] + 255u) >> 8); }
        total = acc * (UP ? 8 : 4); G = G_; c = c_;
    }
    __device__ __forceinline__ bool next(int i, Unit& u) const {
        const int L = i * G + c; if (L >= total) return false;
        const int tl = UP ? (L >> 3) : (L >> 2), pn = UP ? (L & 7) : (L & 3); int gid = 0, base = 0, acc = 0; unsigned ce = cnt[0];
#pragma unroll
        for (int j = 0; j < 24; ++j) { const int tj = (int)((cnt[j] + 255u) >> 8); if (tl >= acc) { gid = j; base = acc; ce = cnt[j]; } acc += tj; }
        const int grp = gid / 6, pid = gid - 6 * grp, ea = 4 * grp + (pid < 3 ? 0 : pid < 5 ? 1 : 2), eb = 4 * grp + (pid < 3 ? pid + 1 : pid < 5 ? pid - 1 : 3);
        u.pm = tl; u.pn = pn; u.arow = tl * BM; u.acol = 0; u.x0 = gid; u.x2 = (tl - base) * BM; u.x1 = (int)ce - u.x2; u.ord = i;
        if (UP) { u.brow = (pn < 4 ? ea : eb) * 1024 + (pn & 3) * BM; u.brow2 = 0; u.ksplit = 0; }
        else { u.brow = ea * 1024 + pn * BM; u.brow2 = eb * 1024 + pn * BM; u.ksplit = 4; }
        return true;
    }
};

__device__ __forceinline__ unsigned pk4_fp8(float a, float b, float c, float d) { unsigned w = 0u; w = (unsigned)__builtin_amdgcn_cvt_pk_fp8_f32(a, b, (int)w, false); w = (unsigned)__builtin_amdgcn_cvt_pk_fp8_f32(c, d, (int)w, true); return w; }
constexpr float W8_SCALE = 32.0f, ACT8_SCALE = 4.0f, Y8_SCALE = 8.0f, BB8_SCALE = 16.0f, LA8_SCALE = 256.0f;
struct EpiInProj {
    static constexpr bool PERM = true;
    bf16_t* Gb; bf16_t* Ub;
    __device__ __forceinline__ void operator()(const f32x4 (&acc)[2][2][4][2], const Unit& u, int wr, int wc, int fr, int fq) const {
        const bool isg = u.pn < 4; bf16_t* base = isg ? Gb : Ub; const int colt = (isg ? u.pn : u.pn - 4) * BM + wc * 32 + 8 * fq;
#pragma unroll
        for (int ai = 0; ai < 2; ++ai)
#pragma unroll
            for (int m = 0; m < 4; ++m) { bf16_t* rowp = base + (size_t)(u.pm * BM + ai * HALF + wr * 64 + m * 16 + fr) * 1024 + colt;
#pragma unroll
                for (int bj = 0; bj < 2; ++bj) { f32x4 v0 = acc[ai][bj][m][0], v1 = acc[ai][bj][m][1];
                    if (isg) {
                        const f32x4 e0 = (v0 * v0 * (-2.302208198f * 0.044715f) + -2.302208198f) * v0, e1 = (v1 * v1 * (-2.302208198f * 0.044715f) + -2.302208198f) * v1;
                        const f32x4 d0 = (f32x4){__builtin_amdgcn_exp2f(e0[0]), __builtin_amdgcn_exp2f(e0[1]), __builtin_amdgcn_exp2f(e0[2]), __builtin_amdgcn_exp2f(e0[3])} + 1.0f;
                        const f32x4 d1 = (f32x4){__builtin_amdgcn_exp2f(e1[0]), __builtin_amdgcn_exp2f(e1[1]), __builtin_amdgcn_exp2f(e1[2]), __builtin_amdgcn_exp2f(e1[3])} + 1.0f;
                        v0 = v0 * (f32x4){__builtin_amdgcn_rcpf(d0[0]), __builtin_amdgcn_rcpf(d0[1]), __builtin_amdgcn_rcpf(d0[2]), __builtin_amdgcn_rcpf(d0[3])};
                        v1 = v1 * (f32x4){__builtin_amdgcn_rcpf(d1[0]), __builtin_amdgcn_rcpf(d1[1]), __builtin_amdgcn_rcpf(d1[2]), __builtin_amdgcn_rcpf(d1[3])}; }
                    u32x4 w; w.x = cvt_pk_bf16(v0[0], v0[1]); w.y = cvt_pk_bf16(v0[2], v0[3]); w.z = cvt_pk_bf16(v1[0], v1[1]); w.w = cvt_pk_bf16(v1[2], v1[3]);
                    *(u32x4*)(rowp + bj * HALF) = w; } }
    }
};
struct EpiGates {
    static constexpr bool PERM = true;
    const bf16_t* UC; unsigned char* LB[2]; const float* ga_b; const float* gx_b; const float* lam;
    __device__ __forceinline__ void operator()(const f32x4 (&acc)[2][2][4][2], const Unit& u, int wr, int wc, int fr, int fq) const {
        const int d = u.pn & 1, c0 = (u.pn >> 1) * 128 + wc * 32 + 8 * fq;
        typedef float f32x2 __attribute__((ext_vector_type(2)));
        f32x2 ba[4], bx[4], sp2[4];
#pragma unroll
        for (int j = 0; j < 8; ++j) { ba[j >> 1][j & 1] = -1.4426950408889634f * ga_b[d * 1024 + c0 + j]; bx[j >> 1][j & 1] = -1.4426950408889634f * gx_b[d * 1024 + c0 + j]; const float l = lam[d * 1024 + c0 + j];
            const float ex = __expf(-l); const float spv = (ex < 0.05f) ? ex * (1.0f - ex * (0.5f - ex * (0.33333334f - 0.25f * ex))) : __logf(1.0f + ex); const float sp = -8.0f * 1.4426950408889634f * spv;
            sp2[j >> 1][j & 1] = 2.0f * sp; }
        unsigned char* lb = d ? LB[1] : LB[0];
#pragma unroll
        for (int ai = 0; ai < 2; ++ai) {
            u32x4 uva[4];
#pragma unroll
            for (int m = 0; m < 4; ++m) uva[m] = *(const u32x4*)(UC + (size_t)(u.pm * BM + ai * HALF + wr * 64 + m * 16 + fr) * 1024 + c0);
            __builtin_amdgcn_sched_barrier(0);
#pragma unroll
            for (int m = 0; m < 4; ++m) { const size_t off = (size_t)(u.pm * BM + ai * HALF + wr * 64 + m * 16 + fr) * 1024 + c0;
                const u32x4 uv = uva[m];
                const f32x2 uu[4] = {{__builtin_bit_cast(float, uv.x << 16), __builtin_bit_cast(float, uv.x & 0xffff0000u)}, {__builtin_bit_cast(float, uv.y << 16), __builtin_bit_cast(float, uv.y & 0xffff0000u)},
                                     {__builtin_bit_cast(float, uv.z << 16), __builtin_bit_cast(float, uv.z & 0xffff0000u)}, {__builtin_bit_cast(float, uv.w << 16), __builtin_bit_cast(float, uv.w & 0xffff0000u)}};
                float l2[8], bt[8];
#pragma unroll
                for (int jp = 0; jp < 4; ++jp) { const f32x2 aa = {acc[ai][0][m][jp >> 1][2 * (jp & 1)], acc[ai][0][m][jp >> 1][2 * (jp & 1) + 1]}, ax = {acc[ai][1][m][jp >> 1][2 * (jp & 1)], acc[ai][1][m][jp >> 1][2 * (jp & 1) + 1]};
                    const f32x2 za = aa + ba[jp], zx = ax + bx[jp];
                    const f32x2 da = (f32x2){__builtin_amdgcn_exp2f(za.x), __builtin_amdgcn_exp2f(za.y)} + 1.0f, q = (f32x2){__builtin_amdgcn_exp2f(zx.x), __builtin_amdgcn_exp2f(zx.y)} + 1.0f;
                    const f32x2 r = {__builtin_amdgcn_rcpf(da.x), __builtin_amdgcn_rcpf(da.y)};
                    const f32x2 t2 = sp2[jp] * r, lq = t2 * (0.5f * LA8_SCALE);
                    const f32x2 a2 = {__builtin_amdgcn_exp2f(t2.x), __builtin_amdgcn_exp2f(t2.y)};
                    f32x2 w = a2 * -(BB8_SCALE * BB8_SCALE) + (BB8_SCALE * BB8_SCALE); w.x = fmaxf(w.x, 1e-30f); w.y = fmaxf(w.y, 1e-30f);
                    const f32x2 ag = w * (q * q); const f32x2 bv = (w * (f32x2){__builtin_amdgcn_rsqf(ag.x), __builtin_amdgcn_rsqf(ag.y)}) * uu[jp];
                    l2[2 * jp] = lq.x; l2[2 * jp + 1] = lq.y; bt[2 * jp] = __builtin_amdgcn_fmed3f(bv.x, -440.f, 440.f); bt[2 * jp + 1] = __builtin_amdgcn_fmed3f(bv.y, -440.f, 440.f); }
                u32x4 w; w.x = pk4_fp8(l2[0], bt[0], l2[1], bt[1]); w.y = pk4_fp8(l2[2], bt[2], l2[3], bt[3]); w.z = pk4_fp8(l2[4], bt[4], l2[5], bt[5]); w.w = pk4_fp8(l2[6], bt[6], l2[7], bt[7]);
                *(u32x4*)(lb + 2 * off) = w; } }
    }
};
template <bool BASE_BF16>
struct EpiResid {
    static constexpr bool PERM = true;
    const float* baseL; const float* baseC; bf16_t* XB; const float* gate; float ascale;
    __device__ __forceinline__ void operator()(const f32x4 (&acc)[2][2][4][2], const Unit& u, int wr, int wc, int fr, int fq) const {
        const int row0 = u.pm * BM; const bool isl = row0 < ML;
        const float* bs = isl ? baseL + (size_t)row0 * 1024 : baseC + (size_t)(row0 - ML) * 1024; bf16_t* os = XB + (size_t)row0 * 1024;
        const float* gv = gate + (isl ? (row0 >> 12) : 8) * 6144; const int col0 = u.pn * BM + wc * 32 + 8 * fq;
        f32x4 gg[2][2];
#pragma unroll
        for (int bj = 0; bj < 2; ++bj)
#pragma unroll
            for (int n = 0; n < 2; ++n) gg[bj][n] = *(const f32x4*)(gv + col0 + bj * HALF + n * 4) * ascale;
        constexpr int MB = BASE_BF16 ? 4 : 2;
#pragma unroll
        for (int ai = 0; ai < 2; ++ai)
#pragma unroll
            for (int m0 = 0; m0 < 4; m0 += MB) {
                u32x4 wb[MB][2]; f32x4 fb[MB][2][2];
#pragma unroll
                for (int mi = 0; mi < MB; ++mi) { const size_t off = (size_t)(ai * HALF + wr * 64 + (m0 + mi) * 16 + fr) * 1024 + col0;
#pragma unroll
                    for (int bj = 0; bj < 2; ++bj) {
                        if (BASE_BF16) wb[mi][bj] = *(const u32x4*)(os + off + bj * HALF);
                        else { fb[mi][bj][0] = __builtin_nontemporal_load((const f32x4*)(bs + off + bj * HALF)); fb[mi][bj][1] = __builtin_nontemporal_load((const f32x4*)(bs + off + bj * HALF + 4)); } } }
                __builtin_amdgcn_sched_barrier(0);
#pragma unroll
                for (int mi = 0; mi < MB; ++mi) { const int m = m0 + mi; const size_t off = (size_t)(ai * HALF + wr * 64 + m * 16 + fr) * 1024 + col0;
#pragma unroll
                    for (int bj = 0; bj < 2; ++bj) { f32x4 b0, b1;
                        if (BASE_BF16) { const u32x4 w = wb[mi][bj];
                            b0 = (f32x4){__builtin_bit_cast(float, w.x << 16), __builtin_bit_cast(float, w.x & 0xffff0000u), __builtin_bit_cast(float, w.y << 16), __builtin_bit_cast(float, w.y & 0xffff0000u)};
                            b1 = (f32x4){__builtin_bit_cast(float, w.z << 16), __builtin_bit_cast(float, w.z & 0xffff0000u), __builtin_bit_cast(float, w.w << 16), __builtin_bit_cast(float, w.w & 0xffff0000u)}; }
                        else { b0 = fb[mi][bj][0]; b1 = fb[mi][bj][1]; }
                        const f32x4 v0 = b0 + gg[bj][0] * acc[ai][bj][m][0], v1 = b1 + gg[bj][1] * acc[ai][bj][m][1];
                        u32x4 o; o.x = cvt_pk_bf16(v0[0], v0[1]); o.y = cvt_pk_bf16(v0[2], v0[3]); o.z = cvt_pk_bf16(v1[0], v1[1]); o.w = cvt_pk_bf16(v1[2], v1[3]);
                        *(u32x4*)(os + off + bj * HALF) = o; } }
                __builtin_amdgcn_sched_barrier(0); }
    }
};
struct EpiNull { static constexpr bool PERM = true;
    __device__ __forceinline__ void operator()(const f32x4 (&acc)[2][2][4][2], const Unit& u, int wr, int wc, int fr, int fq) const { } };
template <bool WT = false>
struct EpiMoe1 {
    static constexpr bool PERM = true;
    unsigned char* ACT; const PG8_LAS float* tabw;
    __device__ __forceinline__ void operator()(const f32x4 (&acc)[2][2][4][2], const Unit& u, int wr, int wc, int fr, int fq) const {
        const int colt = u.pn * 128 + wc * 32 + 8 * fq;
#pragma unroll
        for (int ai = 0; ai < 2; ++ai)
#pragma unroll
            for (int m = 0; m < 4; ++m) { const int rl = ai * HALF + wr * 64 + m * 16 + fr; unsigned char* rowp = ACT + (size_t)(u.pm * BM + rl) * 1024 + colt; float o[8];
                typedef float f32x2 __attribute__((ext_vector_type(2)));
                const float gw = tabw[u.ord * 256 + rl] * (ACT8_SCALE / (W8_SCALE * W8_SCALE));
#pragma unroll
                for (int jp = 0; jp < 4; ++jp) { const f32x2 a1 = {acc[ai][0][m][jp >> 1][2 * (jp & 1)], acc[ai][0][m][jp >> 1][2 * (jp & 1) + 1]}, a3 = {acc[ai][1][m][jp >> 1][2 * (jp & 1)], acc[ai][1][m][jp >> 1][2 * (jp & 1) + 1]};
                    const f32x2 x = a1 * (-1.4426950408889634f / W8_SCALE); const f32x2 d = (f32x2){__builtin_amdgcn_exp2f(x.x), __builtin_amdgcn_exp2f(x.y)} + 1.0f;
                    const f32x2 sg = (f32x2){__builtin_amdgcn_rcpf(d.x), __builtin_amdgcn_rcpf(d.y)} * gw; const f32x2 v = (a1 * a3) * sg;
                    o[2 * jp] = __builtin_amdgcn_fmed3f(v.x, -440.f, 440.f); o[2 * jp + 1] = __builtin_amdgcn_fmed3f(v.y, -440.f, 440.f); }
                typedef unsigned u32x2 __attribute__((ext_vector_type(2)));
                u32x2 w; w.x = pk4_fp8(o[0], o[1], o[2], o[3]); w.y = pk4_fp8(o[4], o[5], o[6], o[7]);
                if (WT) __hip_atomic_store((__attribute__((address_space(1))) unsigned long long*)rowp, ((unsigned long long)w.y << 32) | (unsigned long long)w.x, __ATOMIC_RELAXED, __HIP_MEMORY_SCOPE_AGENT);
                else *(u32x2*)rowp = w; }
    }
};
template <bool FINAL>
struct EpiMoe2 {
    static constexpr bool PERM = true;
    bf16_t* XB; float* out; const float* gfm; const PG8_LAS int* tab;
    __device__ __forceinline__ void operator()(const f32x4 (&acc)[2][2][4][2], const Unit& u, int wr, int wc, int fr, int fq) const {
        const int col0 = u.pn * BM + wc * 32 + 8 * fq; constexpr float sc = 1.0f / (W8_SCALE * ACT8_SCALE);
#pragma unroll
        for (int ai = 0; ai < 2; ++ai)
#pragma unroll
            for (int m0 = 0; m0 < 4; m0 += 2) {
                int tk[2]; u32x4 xw[2][2]; f32x4 gq[2][2][2];
#pragma unroll
                for (int mi = 0; mi < 2; ++mi) { const int t_ = tab[u.ord * 256 + ai * HALF + wr * 64 + (m0 + mi) * 16 + fr]; tk[mi] = t_; const int tok = t_ < 0 ? 0 : t_;
                    const float* gv = gfm + (tok < ML ? (tok >> 12) : 8) * 6144 + col0; const bf16_t* xp = XB + (size_t)tok * 1024 + col0;
#pragma unroll
                    for (int bj = 0; bj < 2; ++bj) { xw[mi][bj] = FINAL ? __builtin_nontemporal_load((const u32x4*)(xp + bj * HALF)) : *(const u32x4*)(xp + bj * HALF); gq[mi][bj][0] = *(const f32x4*)(gv + bj * HALF); gq[mi][bj][1] = *(const f32x4*)(gv + bj * HALF + 4); } }
                __builtin_amdgcn_sched_barrier(0);
#pragma unroll
                for (int mi = 0; mi < 2; ++mi) { const int m = m0 + mi, tok = tk[mi];
                    if (tok >= 0) { bf16_t* xp = XB + (size_t)tok * 1024 + col0;
#pragma unroll
                        for (int bj = 0; bj < 2; ++bj) { const f32x4 g0 = gq[mi][bj][0] * sc, g1 = gq[mi][bj][1] * sc; const u32x4 w = xw[mi][bj];
                            const f32x4 b0 = {__builtin_bit_cast(float, w.x << 16), __builtin_bit_cast(float, w.x & 0xffff0000u), __builtin_bit_cast(float, w.y << 16), __builtin_bit_cast(float, w.y & 0xffff0000u)};
                            const f32x4 b1 = {__builtin_bit_cast(float, w.z << 16), __builtin_bit_cast(float, w.z & 0xffff0000u), __builtin_bit_cast(float, w.w << 16), __builtin_bit_cast(float, w.w & 0xffff0000u)};
                            const f32x4 v0 = b0 + g0 * acc[ai][bj][m][0], v1 = b1 + g1 * acc[ai][bj][m][1];
                            if (FINAL) { float* op = out + (size_t)tok * 1024 + col0 + bj * HALF; *(f32x4*)op = v0; *(f32x4*)(op + 4) = v1; }
                            else { u32x4 o; o.x = cvt_pk_bf16(v0[0], v0[1]); o.y = cvt_pk_bf16(v0[2], v0[3]); o.z = cvt_pk_bf16(v1[0], v1[1]); o.w = cvt_pk_bf16(v1[2], v1[3]); *(u32x4*)(xp + bj * HALF) = o; } } } }
                __builtin_amdgcn_sched_barrier(0); }
    }
};
struct EpiQKV {
    static constexpr bool PERM = true;
    unsigned char* Q; unsigned char* Kb; unsigned char* Vt; const float* qn; const float* kn; const PG8_LAS float* rope;
    __device__ __forceinline__ void operator()(const f32x4 (&acc)[2][2][4][2], const Unit& u, int wr, int wc, int fr, int fq) const {
        typedef unsigned u32x2 __attribute__((ext_vector_type(2)));
        const int row0 = u.pm * BM; const bool isl = row0 < ML;
        if (u.pn == 5) {
#pragma unroll
            for (int ai = 0; ai < 2; ++ai)
#pragma unroll
                for (int m = 0; m < 4; ++m) { const int row = row0 + ai * HALF + wr * 64 + m * 16 + fr;
                    const int b = isl ? (row >> 12) : ((row - ML) >> 8), key = isl ? CTXL + (row & 4095) : ((row - ML) & 255);
                    unsigned char* base = Vt + (size_t)b * 4 * 64 * KVL + (size_t)(key >> 6) * 64 + attn8::vpos(key & 63);
#pragma unroll
                    for (int bj = 0; bj < 2; ++bj)
#pragma unroll
                        for (int n = 0; n < 2; ++n)
#pragma unroll
                            for (int j = 0; j < 4; ++j) { const int col = bj * HALF + wc * 32 + 8 * fq + 4 * n + j; const float v = acc[ai][bj][m][n][j] * (attn8::VS / W8_SCALE);
                                base[(size_t)col * KVL] = (unsigned char)__builtin_amdgcn_cvt_pk_fp8_f32(v, v, 0, false); } }
            return;
        }
        const bool isq = u.pn < 4; const float* nw = isq ? qn : kn; const float sc = isq ? attn8::QS : attn8::KS;
        f32x4 w1[2], w2[2];
#pragma unroll
        for (int bj = 0; bj < 2; ++bj) { w1[bj] = *(const f32x4*)(nw + 32 * bj + 4 * fq); w2[bj] = *(const f32x4*)(nw + 32 * bj + 16 + 4 * fq); }
#pragma unroll
        for (int ai = 0; ai < 2; ++ai)
#pragma unroll
            for (int m = 0; m < 4; ++m) { const int row = row0 + ai * HALF + wr * 64 + m * 16 + fr;
                f32x4 a1[2], a2[2]; float ss = 0.f;
#pragma unroll
                for (int bj = 0; bj < 2; ++bj) { a1[bj] = acc[ai][bj][m][0] * (1.0f / W8_SCALE); a2[bj] = acc[ai][bj][m][1] * (1.0f / W8_SCALE);
                    ss += (a1[bj][0] * a1[bj][0] + a1[bj][1] * a1[bj][1]) + (a1[bj][2] * a1[bj][2] + a1[bj][3] * a1[bj][3]) + (a2[bj][0] * a2[bj][0] + a2[bj][1] * a2[bj][1]) + (a2[bj][2] * a2[bj][2] + a2[bj][3] * a2[bj][3]); }
                ss += __shfl_xor(ss, 16); ss += __shfl_xor(ss, 32);
                const float rstd = __builtin_amdgcn_rsqf(ss * (1.0f / 64.0f) + EPS) * sc;
                int dest;
                if (isl) { const int t = row & 4095; const int pos[2] = {t >> 6, t & 63};
#pragma unroll
                    for (int bj = 0; bj < 2; ++bj) { const f32x4 cs = *(const PG8_LAS f32x4*)(rope + pos[bj] * 16 + 4 * fq), sn = *(const PG8_LAS f32x4*)(rope + 1024 + pos[bj] * 16 + 4 * fq);
                        const f32x4 y1 = a1[bj] * w1[bj] * rstd, y2 = a2[bj] * w2[bj] * rstd;
                        a1[bj] = y1 * cs - y2 * sn; a2[bj] = y2 * cs + y1 * sn; }
                    dest = isq ? row : (row >> 12) * KVL + CTXL + t;
                } else {
#pragma unroll
                    for (int bj = 0; bj < 2; ++bj) { a1[bj] = a1[bj] * w1[bj] * rstd; a2[bj] = a2[bj] * w2[bj] * rstd; }
                    dest = ((row - ML) >> 8) * KVL + ((row - ML) & 255);
                }
                unsigned char* rowp = isq ? Q + (size_t)dest * 1024 + (u.pn * 4 + wc) * 64 + 8 * fq : Kb + (size_t)dest * 256 + wc * 64 + 8 * fq;
#pragma unroll
                for (int bj = 0; bj < 2; ++bj) { u32x2 w; w.x = pk4_fp8(a1[bj][0], a1[bj][1], a1[bj][2], a1[bj][3]); w.y = pk4_fp8(a2[bj][0], a2[bj][1], a2[bj][2], a2[bj][3]);
                    *(u32x2*)(rowp + bj * 32) = w; } }
    }
};
}
struct Frame {
    LAS unsigned char* lds;
    volatile LAS unsigned* MISC;
    gu32* ctl;
    int tid, lane, wave, vcu, G;
    unsigned char* ws; float* out;
    const float* in[26];
};
enum { I_X = 0, I_C, I_CTX, I_CCTX, I_ADAW, I_ADAB, I_NMIX, I_NFFN, I_LIN, I_LCW, I_LCB, I_GAW, I_GAB, I_GXW, I_GXB, I_LAM, I_LOUT, I_QKV, I_QN, I_KN, I_OW, I_RW, I_RB, I_W1, I_W3, I_W2 };

__device__ __forceinline__ float wave_sum(float v) {
#pragma unroll
    for (int o = 1; o < 64; o <<= 1) v += __shfl_xor(v, o);
    return v;
}
__device__ __forceinline__ int dl_perm(int s) { return 4 * (s >> 3) + (s & 3) + ((s & 4) ? 16 : 0); }

template <bool F8 = false>
__device__ __forceinline__ void tr_item(const float* src, int ldn, int k0, int scol0, void* dstv, int ldk, int drow0, bool rp, LAS float* scr, int lane, float sc = 1.0f) {
    float tv[32];
#pragma unroll
    for (int i = 0; i < 32; ++i) { const int kk = 2 * i + (lane >> 5); tv[i] = __builtin_nontemporal_load(src + (size_t)(k0 + kk) * ldn + scol0 + (lane & 31)); }
#pragma unroll
    for (int i = 0; i < 32; ++i) { const int kk = 2 * i + (lane >> 5); scr[kk * 33 + (lane & 31)] = tv[i]; }
    LDS_WAIT(); asm volatile("" ::: "memory");
    const int c = lane & 7;
#pragma unroll
    for (int j = 0; j < 4; ++j) { const int n = (lane >> 3) + 8 * j; const int sn = rp ? dl_perm(n) : n; const LAS float* s = scr + (8 * c) * 33 + sn;
        if constexpr (F8) { v2u o; o.x = pg8::pk4_fp8(32.0f * s[0 * 33], 32.0f * s[1 * 33], 32.0f * s[2 * 33], 32.0f * s[3 * 33]); o.y = pg8::pk4_fp8(32.0f * s[4 * 33], 32.0f * s[5 * 33], 32.0f * s[6 * 33], 32.0f * s[7 * 33]);
            *(GAS v2u*)((unsigned char*)dstv + (size_t)(drow0 + n) * ldk + k0 + 8 * c) = o; }
        else { bf16* dst = (bf16*)dstv; v4u o; o.x = pk2(sc * s[0 * 33], sc * s[1 * 33]); o.y = pk2(sc * s[2 * 33], sc * s[3 * 33]); o.z = pk2(sc * s[4 * 33], sc * s[5 * 33]); o.w = pk2(sc * s[6 * 33], sc * s[7 * 33]);
            *(GAS v4u*)(dst + (size_t)(drow0 + n) * ldk + k0 + 8 * c) = o; } }
    LDS_WAIT(); asm volatile("" ::: "memory");
}

constexpr int CV_IN = 1024, CV_G = 256, CV_OUT = 512, CV_13 = 8192, CV_2 = 4096, CV_QKV = 768, CV_O = 512;
constexpr int CV_A_END = CV_IN + CV_G + CV_OUT, CV_B_END = CV_A_END + CV_13 + CV_2, CV_END = CV_B_END + CV_QKV + CV_O + CV_13 + CV_2;
__device__ __forceinline__ void conv_items(Frame& F, int lo, int hi, int gwi, int nwg) {
    LAS float* scr = (LAS float*)(F.lds + RING_OFF + 59392 + F.wave * 8704);
    for (int it = lo + gwi; it < hi; it += nwg) {
        int r = it;
        if (r < CV_IN) { const int g = r >> 4, kb = r & 15; tr_item(F.in[I_LIN], 2048, kb * 64, g * 32, (bf16*)(F.ws + WS_W_IN), 1024, g * 32, false, scr, F.lane); continue; } r -= CV_IN;
        if (r < CV_G) { const int un = r >> 4, rem = r & 15, grp = rem >> 1, kb = rem & 1, n = un >> 1, d = un & 1;
            const float* src = (grp < 4 ? F.in[I_GAW] : F.in[I_GXW]) + (size_t)(d * 8 + n) * 16384;
            tr_item(src, 128, kb * 64, (grp & 3) * 32, (bf16*)(F.ws + WS_W_G), 128, un * 256 + grp * 32, false, scr, F.lane, -1.4426950408889634f); continue; } r -= CV_G;
        if (r < CV_OUT) { const int g = r >> 4, kb = r & 15; tr_item(F.in[I_LOUT], 1024, kb * 64, g * 32, (bf16*)(F.ws + WS_W_OUT), 1024, g * 32, false, scr, F.lane); continue; } r -= CV_OUT;
        int layer = 0;
        if (r >= CV_13 + CV_2) { r -= CV_13 + CV_2;
            if (r < CV_QKV) { const int g = r >> 4, kb = r & 15, pn = g >> 3, gi = g & 7; const bool rp = pn < 5;
                const int scol0 = rp ? pn * 256 + (gi & 3) * 64 + (gi >> 2) * 32 : 1280 + gi * 32;
                tr_item<true>(F.in[I_QKV], 1536, kb * 64, scol0, F.ws + WS_W_QKV, 1024, g * 32, rp, scr, F.lane); continue; } r -= CV_QKV;
            if (r < CV_O) { const int g = r >> 4, kb = r & 15; tr_item<true>(F.in[I_OW], 1024, kb * 64, g * 32, F.ws + WS_W_O, 1024, g * 32, false, scr, F.lane); continue; } r -= CV_O;
            layer = 1; }
        if (r < CV_13) { const int le = layer * 16 + (r >> 9), rem = r & 511, g = rem >> 4, kb = rem & 15, pn = g >> 3, gi = g & 7, bj = gi >> 2, sub = gi & 3;
            const float* src = (bj ? F.in[I_W3] : F.in[I_W1]) + (size_t)le * 1024 * 512;
            tr_item<true>(src, 512, kb * 64, pn * 128 + sub * 32, F.ws + WS_W13 + (size_t)le * 1024 * 1024, 1024, g * 32, false, scr, F.lane); continue; } r -= CV_13;
        { const int le = layer * 16 + (r >> 8), rem = r & 255, g = rem >> 3, kb = rem & 7;
            tr_item<true>(F.in[I_W2] + (size_t)le * 512 * 1024, 1024, kb * 64, g * 32, F.ws + WS_W2 + (size_t)le * 1024 * 512, 512, g * 32, false, scr, F.lane); }
    }
}
__device__ __forceinline__ void conv_tail(Frame& F, int b0, int lo, int hi, int me = -1) {
    if (me < 0) me = (int)blockIdx.x;
    if (b0 >= F.G) b0 = 0;
    if (me >= b0) conv_items(F, lo, hi, (me - b0) * NWAVES + F.wave, (F.G - b0) * NWAVES);
}
constexpr int CV_T10 = 3800, CV_T11 = 2200, CV_T13 = 5600, CV_T8C = 3000;

__device__ __forceinline__ void p0_prologue(Frame& F) {
    LAS float* scond = (LAS float*)(F.lds + RING_OFF);
    LAS float* red = (LAS float*)(F.lds + RING_OFF + 40960);
    float* mod = (float*)(F.ws + WS_MOD);
    bool did = false;
    for (int unit = blockIdx.x; unit < 192; unit += F.G) {
        if (!did) { for (int idx = F.tid; idx < 9 * 1024; idx += NWAVES * 64) { const int r = idx >> 10, k = idx & 1023; const float v = r < 8 ? F.in[I_C][r * 1024 + k] : F.in[I_CCTX][k]; scond[idx] = v * sigmoid_f(v); }
            __syncthreads(); did = true; }
        const int l = unit / 96, cg = unit % 96;
        const int ks = F.lane >> 4, cq = F.lane & 15;
        f32x4 acc[9];
#pragma unroll
        for (int r = 0; r < 9; ++r) acc[r] = (f32x4){0.f, 0.f, 0.f, 0.f};
        const float* wp = F.in[I_ADAW] + ((size_t)l * 1024 + F.wave * 128 + ks) * 6144 + cg * 64 + cq * 4;
#pragma unroll 1
        for (int k0 = 0; k0 < 32; k0 += 8) { f32x4 wv[8];
#pragma unroll
            for (int i = 0; i < 8; ++i) wv[i] = __builtin_nontemporal_load((const f32x4*)(wp + (size_t)(k0 + i) * 4 * 6144));
#pragma unroll
            for (int i = 0; i < 8; ++i) { const int k = F.wave * 128 + (k0 + i) * 4 + ks;
#pragma unroll
                for (int r = 0; r < 9; ++r) acc[r] += scond[r * 1024 + k] * wv[i]; } }
#pragma unroll
        for (int r = 0; r < 9; ++r) *(LAS f32x4*)(red + ((F.wave * 4 + ks) * 9 + r) * 64 + cq * 4) = acc[r];
        __syncthreads();
        for (int idx = F.tid; idx < 576; idx += NWAVES * 64) { const int r = idx >> 6, ln = idx & 63; float s = F.in[I_ADAB][l * 6144 + cg * 64 + ln];
#pragma unroll 8
            for (int w = 0; w < 32; ++w) s += red[(w * 9 + r) * 64 + ln];
            mod[(size_t)(l * 9 + r) * 6144 + cg * 64 + ln] = s; }
        __syncthreads();
    }
    __syncthreads();
    { const int rb0 = F.G >= 194 ? 192 : 0; const int gt = ((int)blockIdx.x - rb0) * (NWAVES * 64) + F.tid; if (gt >= 0 && gt < 1024) { const int pos = gt >> 4, i = gt & 15;
        double th = 1.0; for (int k = 0; k < i; ++k) th *= 0.56234132519034908;
        const double t2 = th * th; double sn = th, cs = 1.0, ts = th, tc = 1.0;
        for (int k = 1; k <= 12; ++k) { tc *= -t2 * (1.0 / (double)((2 * k - 1) * (2 * k))); cs += tc; ts *= -t2 * (1.0 / (double)((2 * k) * (2 * k + 1))); sn += ts; }
        double c = 1.0, s2 = 0.0; for (int k = 0; k < pos; ++k) { const double cn = c * cs - s2 * sn; s2 = s2 * cs + c * sn; c = cn; }
        float* rp = (float*)(F.ws + WS_ROPE); rp[gt] = (float)c; rp[1024 + gt] = (float)s2; } }
    conv_items(F, 0, CV_A_END, F.vcu * NWAVES + F.wave, F.G * NWAVES);
    conv_items(F, CV_B_END + CV_T10 + CV_T11 + CV_T13, CV_END, F.vcu * NWAVES + F.wave, F.G * NWAVES);
}

struct RowVec { f32x4 v[4]; };
__device__ __forceinline__ void load_modvec(Frame& F, int l, int mrow, int chunk_shift, const float* nw, RowVec& gsc, RowVec& sh) {
    const float* mod = (const float*)(F.ws + WS_MOD) + (size_t)(l * 9 + mrow) * 6144;
#pragma unroll
    for (int j = 0; j < 4; ++j) { const int col = 4 * F.lane + 256 * j; const f32x4 w = *(const f32x4*)(nw + col), sc = *(const f32x4*)(mod + (chunk_shift + 1) * 1024 + col);
        gsc.v[j] = w * (1.0f + sc); sh.v[j] = *(const f32x4*)(mod + chunk_shift * 1024 + col); }
}
__device__ __forceinline__ void store_bf16_row(bf16* dst, int lane, const RowVec& h) {
#pragma unroll
    for (int j = 0; j < 4; ++j) { v2u o; o.x = pk2(h.v[j][0], h.v[j][1]); o.y = pk2(h.v[j][2], h.v[j][3]); *(GAS v2u*)(dst + 4 * lane + 256 * j) = o; }
}
__device__ __forceinline__ void rms_mod(const RowVec& x, const RowVec& gsc, const RowVec& sh, RowVec& h) {
    float ss = 0.f;
#pragma unroll
    for (int j = 0; j < 4; ++j) ss += (x.v[j][0] * x.v[j][0] + x.v[j][1] * x.v[j][1]) + (x.v[j][2] * x.v[j][2] + x.v[j][3] * x.v[j][3]);
    ss = wave_sum(ss);
    const float rstd = 1.0f / sqrtf(ss * (1.0f / 1024.0f) + EPS);
#pragma unroll
    for (int j = 0; j < 4; ++j) h.v[j] = x.v[j] * rstd * gsc.v[j] + sh.v[j];
}

__device__ __forceinline__ void load_xrow(const float* xL, const float* xC, int row, int lane, RowVec& x) {
    const float* src = row < ML ? xL + (size_t)row * 1024 : xC + (size_t)(row - ML) * 1024;
#pragma unroll
    for (int j = 0; j < 4; ++j) x.v[j] = __builtin_nontemporal_load((const f32x4*)(src + 4 * lane + 256 * j));
}
__device__ __forceinline__ void load_xrow_bf(const bf16* XB, int row, int lane, RowVec& x) {
    const bf16* src = XB + (size_t)row * 1024;
#pragma unroll
    for (int j = 0; j < 4; ++j) { const v2u w = *(const GAS v2u*)(src + 4 * lane + 256 * j); x.v[j] = (f32x4){bflo(w.x), bfhi(w.x), bflo(w.y), bfhi(w.y)}; }
}
__device__ __forceinline__ void rows_modulate(Frame& F, const float* xL, const float* xC, int nrows, int l, int chunk_shift, const float* nw) {
    const int gwv = blockIdx.x * NWAVES + F.wave, NGW = F.G * NWAVES;
    const int r0 = (int)((long)gwv * nrows / NGW), r1 = (int)((long)(gwv + 1) * nrows / NGW);
    bf16* XN = (bf16*)(F.ws + WS_XN);
    int curb = -1; RowVec gsc, sh, xn;
    if (r0 < r1) load_xrow(xL, xC, r0, F.lane, xn);
    for (int row = r0; row < r1; ++row) {
        const int mrow = row < ML ? (row >> 12) : 8;
        if (mrow != curb) { load_modvec(F, l, mrow, chunk_shift, nw, gsc, sh); curb = mrow; }
        RowVec x = xn, h;
        if (row + 1 < r1) load_xrow(xL, xC, row + 1, F.lane, xn);
        rms_mod(x, gsc, sh, h);
        store_bf16_row(XN + (size_t)row * 1024, F.lane, h);
    }
}

__device__ __forceinline__ void rows_modulate_ho(Frame& F, const float* xL, const float* xC, int l, int chunk_shift, const float* nw, int nprod, bool fast, unsigned* hcnt) {
    const int w = blockIdx.x * NWAVES + F.wave, W = nprod * NWAVES;
    bf16* XN = (bf16*)(F.ws + WS_XN);
    int r, rstep, rend;
    if (fast) { const int g = w >> 8; r = pg8::in_gs(g) * 256 + (w & 255); rstep = 256; rend = pg8::in_gs(g + 1) * 256; } else { r = w; rstep = W; rend = MT; }
    int curb = -1, pp1 = -1, pp2 = -1; RowVec gsc, sh, xn;
    if (r < rend) load_xrow(xL, xC, r, F.lane, xn);
    for (; r < rend; r += rstep) {
        const int mrow = r < ML ? (r >> 12) : 8;
        if (mrow != curb) { load_modvec(F, l, mrow, chunk_shift, nw, gsc, sh); curb = mrow; }
        RowVec x = xn, h;
        if (r + rstep < rend) load_xrow(xL, xC, r + rstep, F.lane, xn);
        rms_mod(x, gsc, sh, h);
        asm volatile("" ::: "memory");
        if (pp2 >= 0 && F.lane == 0) pg8::ho_publish(hcnt, pp2);
        bf16* dst = XN + (size_t)r * 1024;
#pragma unroll
        for (int j = 0; j < 4; ++j) { const unsigned lo = pk2(h.v[j][0], h.v[j][1]), hi = pk2(h.v[j][2], h.v[j][3]);
            __hip_atomic_store((GAS unsigned long long*)(dst + 4 * F.lane + 256 * j), ((unsigned long long)hi << 32) | (unsigned long long)lo, __ATOMIC_RELAXED, __HIP_MEMORY_SCOPE_AGENT); }
        pp2 = pp1; pp1 = r >> 8;
    }
    asm volatile("s_waitcnt vmcnt(0)" ::: "memory");
    if (F.lane == 0) { if (pp2 >= 0) pg8::ho_publish(hcnt, pp2); if (pp1 >= 0) pg8::ho_publish(hcnt, pp1); }
}

__device__ __forceinline__ void route_topk(const float (&lg)[16], int& e0, int& e1, float& w0, float& w1);
__device__ __forceinline__ void route_row(const RowVec& h, const LAS float* rw, const float* rb, int lane, int& e0, int& e1, float& w0, float& w1) {
    f32x2 acc2[8];
#pragma unroll
    for (int e = 0; e < 8; ++e) acc2[e] = (f32x2){0.f, 0.f};
#pragma unroll
    for (int j = 0; j < 4; ++j)
#pragma unroll
        for (int i = 0; i < 4; ++i) { const int k = 4 * lane + 256 * j + i; const f32x2 hv2 = {h.v[j][i], h.v[j][i]}; const LAS f32x4* wr = (const LAS f32x4*)(rw + k * 16 + (k >> 2) * 4);
#pragma unroll
            for (int q = 0; q < 4; ++q) { const f32x4 w = wr[q]; acc2[2 * q] = acc2[2 * q] + hv2 * (f32x2){w[0], w[1]}; acc2[2 * q + 1] = acc2[2 * q + 1] + hv2 * (f32x2){w[2], w[3]}; } }
    float acc[16];
#pragma unroll
    for (int e = 0; e < 8; ++e) { acc[2 * e] = acc2[e][0]; acc[2 * e + 1] = acc2[e][1]; }
    float r8[8], r4[4], r2[2], r1v;
    { const bool hi = (lane & 32) != 0;
#pragma unroll
      for (int i = 0; i < 8; ++i) { const float send = hi ? acc[i] : acc[8 + i], keep = hi ? acc[8 + i] : acc[i]; r8[i] = keep + __shfl_xor(send, 32); } }
    { const bool hi = (lane & 16) != 0;
#pragma unroll
      for (int i = 0; i < 4; ++i) { const float send = hi ? r8[i] : r8[4 + i], keep = hi ? r8[4 + i] : r8[i]; r4[i] = keep + __shfl_xor(send, 16); } }
    { const bool hi = (lane & 8) != 0;
#pragma unroll
      for (int i = 0; i < 2; ++i) { const float send = hi ? r4[i] : r4[2 + i], keep = hi ? r4[2 + i] : r4[i]; r2[i] = keep + __shfl_xor(send, 8); } }
    { const bool hi = (lane & 4) != 0; const float send = hi ? r2[0] : r2[1], keep = hi ? r2[1] : r2[0]; r1v = keep + __shfl_xor(send, 4); }
    r1v += __shfl_xor(r1v, 2); r1v += __shfl_xor(r1v, 1);
    float lg[16];
#pragma unroll
    for (int e = 0; e < 16; ++e) lg[e] = __builtin_bit_cast(float, __builtin_amdgcn_readlane(__builtin_bit_cast(int, r1v), 4 * e)) + rb[e];
    route_topk(lg, e0, e1, w0, w1);
}
__device__ __forceinline__ void route_topk(const float (&lg)[16], int& e0, int& e1, float& w0, float& w1) {
    float mx = lg[0];
#pragma unroll
    for (int e = 1; e < 16; ++e) mx = fmaxf(mx, lg[e]);
    float p[16];
#pragma unroll
    for (int e = 0; e < 16; ++e) p[e] = __expf(lg[e] - mx);
    float gs[4];
#pragma unroll
    for (int g = 0; g < 4; ++g) { const float a = fmaxf(p[4 * g], p[4 * g + 1]), b = fminf(p[4 * g], p[4 * g + 1]), c = fmaxf(p[4 * g + 2], p[4 * g + 3]), d = fminf(p[4 * g + 2], p[4 * g + 3]);
        gs[g] = fmaxf(a, c) + fmaxf(fminf(a, c), fmaxf(b, d)); }
    int sel = 0; float best = gs[0];
#pragma unroll
    for (int g = 1; g < 4; ++g) if (gs[g] > best) { best = gs[g]; sel = g; }
    float q[4];
#pragma unroll
    for (int i = 0; i < 4; ++i) q[i] = sel == 0 ? p[i] : sel == 1 ? p[4 + i] : sel == 2 ? p[8 + i] : p[12 + i];
    int i1 = 0; float m1 = q[0];
#pragma unroll
    for (int i = 1; i < 4; ++i) if (q[i] > m1) { m1 = q[i]; i1 = i; }
    int i2 = -1; float m2 = -1.f;
#pragma unroll
    for (int i = 0; i < 4; ++i) if (i != i1 && q[i] > m2) { m2 = q[i]; i2 = i; }
    const float inv = 1.0f / (m1 + m2);
    e0 = sel * 4 + i1; e1 = sel * 4 + i2; w0 = m1 * inv; w1 = m2 * inv;
}

__device__ __forceinline__ void rows_route(Frame& F, int nrows, int l) {
    const bf16* XB = (const bf16*)(F.ws + WS_XB);
    constexpr int HP = 1028;
    LAS float* Wt = (LAS float*)(F.lds + RING_OFF);
    LAS float* Ht = (LAS float*)(F.lds + RING_OFF + 65536);
    LAS float* part = (LAS float*)(F.lds + TAB_OFF);
    LAS float* logit = (LAS float*)(F.lds + TAB_OFF + 8192);
    LAS unsigned char* pe = (LAS unsigned char*)(F.lds + TAB_OFF + 9216);
    LAS unsigned short* pr = (LAS unsigned short*)(F.lds + TAB_OFF + 9216 + 2048);
    static_assert(TAB_OFF + 9216 + 2048 + 3072 <= LDS_BYTES && RING_OFF + 65536 + 16 * 1028 * 4 <= MISC_OFF, "router LDS map");
    { int t0_ = F.tid; asm volatile("" : "+v"(t0_));
      for (int idx = t0_; idx < 1024 * 16 / 4; idx += NWAVES * 64) ((LAS f32x4*)Wt)[idx] = ((const f32x4*)F.in[I_RW])[idx]; }
    const int NGW = F.G * NWAVES;
    const int b0 = (int)((long)(blockIdx.x * NWAVES) * nrows / NGW), b1 = (int)((long)(blockIdx.x * NWAVES + NWAVES) * nrows / NGW);
    unsigned char* XN8 = F.ws + WS_XN; v4u* route = (v4u*)(F.ws + WS_ROUTE);
    const float* nw = F.in[I_NFFN] + l * 1024; const float* rb = F.in[I_RB];
    const int ngroups = (b1 - b0 + 15) >> 4;
    int curb = -1; RowVec gsc, sh;
    v2u xr[2][4];
#define RR_LOAD(g_) do { _Pragma("unroll") for (int q = 0; q < 2; ++q) { const int row_ = b0 + 16 * (g_) + 2 * F.wave + q; const int rc_ = row_ < b1 ? row_ : b1 - 1; \
        _Pragma("unroll") for (int j = 0; j < 4; ++j) xr[q][j] = *(const GAS v2u*)(XB + (size_t)rc_ * 1024 + 4 * F.lane + 256 * j); } } while (0)
    RR_LOAD(0);
    for (int g = 0; g < ngroups; ++g) {
#pragma unroll
        for (int q = 0; q < 2; ++q) { const int rr = 2 * F.wave + q, row = b0 + 16 * g + rr; const bool valid = row < b1;
            RowVec x, h;
#pragma unroll
            for (int j = 0; j < 4; ++j) x.v[j] = (f32x4){bflo(xr[q][j].x), bfhi(xr[q][j].x), bflo(xr[q][j].y), bfhi(xr[q][j].y)};
            const int mrow = (valid ? row : b1 - 1) < ML ? ((valid ? row : b1 - 1) >> 12) : 8;
            if (mrow != curb) { load_modvec(F, l, mrow, 3, nw, gsc, sh); curb = mrow; }
            rms_mod(x, gsc, sh, h);
            if (valid) { unsigned char* d8 = XN8 + (size_t)row * 1024;
#pragma unroll
                for (int j = 0; j < 4; ++j) *(GAS unsigned*)(d8 + 4 * F.lane + 256 * j) = pg8::pk4_fp8(h.v[j][0], h.v[j][1], h.v[j][2], h.v[j][3]); }
#pragma unroll
            for (int j = 0; j < 4; ++j) *(LAS f32x4*)(Ht + rr * HP + 4 * F.lane + 256 * j) = valid ? h.v[j] : (f32x4){0.f, 0.f, 0.f, 0.f}; }
        if (g + 1 < ngroups) RR_LOAD(g + 1);
        __syncthreads();
        { const int r = F.lane & 15, kq = F.lane >> 4; f32x4 acc = {0.f, 0.f, 0.f, 0.f};
          const LAS float* ap = Ht + r * HP + 128 * F.wave + kq; const LAS float* bp = Wt + (128 * F.wave + kq) * 16 + r;
#pragma unroll 8
          for (int s_ = 0; s_ < 32; ++s_) acc = __builtin_amdgcn_mfma_f32_16x16x4f32(ap[4 * s_], bp[64 * s_], acc, 0, 0, 0);
#pragma unroll
          for (int i = 0; i < 4; ++i) part[(F.wave * 16 + 4 * kq + i) * 16 + r] = acc[i]; }
        __syncthreads();
        if (F.tid < 256) { float sacc = rb[F.tid & 15];
#pragma unroll
            for (int w = 0; w < 8; ++w) sacc += part[w * 256 + F.tid];
            logit[F.tid] = sacc; }
        __syncthreads();
        if (F.tid < 16) { const int row = b0 + 16 * g + F.tid;
            if (row < b1) { float lg[16];
#pragma unroll
                for (int e = 0; e < 16; ++e) lg[e] = logit[F.tid * 16 + e];
                int e0, e1; float w0, w1; route_topk(lg, e0, e1, w0, w1);
                const int a0 = e0 & 3, a1 = e1 & 3, lo = a0 < a1 ? a0 : a1, hi_ = a0 < a1 ? a1 : a0, pid = lo == 0 ? hi_ - 1 : lo == 1 ? hi_ + 1 : 5, gid = 6 * (e0 >> 2) + pid;
                const float wa = a0 < a1 ? w0 : w1, wb = a0 < a1 ? w1 : w0;
                v4u o; o.x = (unsigned)gid; o.y = __builtin_bit_cast(unsigned, wa); o.z = __builtin_bit_cast(unsigned, wb); o.w = 0u; route[row] = o;
                pe[row - b0] = (unsigned char)gid; } }
    }
#undef RR_LOAD
    __syncthreads();
    if (F.wave == 0) {
        const int nr = b1 - b0; int run[24];
#pragma unroll
        for (int j = 0; j < 24; ++j) run[j] = 0;
        for (int p0 = 0; p0 < nr; p0 += 64) { const int p = p0 + F.lane; const int e = p < nr ? (int)pe[p] : 255; int myr = 0;
#pragma unroll
            for (int j = 0; j < 24; ++j) { const unsigned long long m = __ballot(e == j); const int below = __popcll(m & ((1ull << F.lane) - 1ull));
                if (e == j) myr = run[j] + below; run[j] += __popcll(m); }
            if (p < nr) pr[p] = (unsigned short)myr; }
        int mycnt = 0;
#pragma unroll
        for (int j = 0; j < 24; ++j) mycnt = (F.lane == j) ? run[j] : mycnt;
        int basev = 0;
        if (F.lane < 24) basev = (int)__hip_atomic_fetch_add((unsigned*)(F.ctl + CW_CNT + 64 * l) + F.lane, (unsigned)mycnt, RLX_AGENT);
        int base[24];
#pragma unroll
        for (int j = 0; j < 24; ++j) base[j] = __builtin_amdgcn_readlane(basev, j);
        LDS_WAIT();
        int* ridx = (int*)(F.ws + WS_RIDX);
        for (int p0 = 0; p0 < nr; p0 += 64) { const int p = p0 + F.lane;
            if (p < nr) { const int e = (int)pe[p]; int bs = 0;
#pragma unroll
                for (int j = 0; j < 24; ++j) bs = (e == j) ? base[j] : bs;
                ridx[(size_t)e * MT + bs + (int)pr[p]] = b0 + p; } }
    }
    __syncthreads();
}

__device__ __forceinline__ void rows_modulate_xb(Frame& F, int nrows, int l) {
    const int gwv = blockIdx.x * NWAVES + F.wave, NGW = F.G * NWAVES;
    const int r0 = (int)((long)gwv * nrows / NGW), r1 = (int)((long)(gwv + 1) * nrows / NGW);
    const bf16* XB = (const bf16*)(F.ws + WS_XB); unsigned char* XN8 = F.ws + WS_XN; const float* nw = F.in[I_NMIX] + l * 1024;
    int curb = -1; RowVec gsc, sh, xn;
    if (r0 < r1) load_xrow_bf(XB, r0, F.lane, xn);
    for (int row = r0; row < r1; ++row) {
        const int mrow = row < ML ? (row >> 12) : 8;
        if (mrow != curb) { load_modvec(F, l, mrow, 0, nw, gsc, sh); curb = mrow; }
        RowVec x = xn, h;
        if (row + 1 < r1) load_xrow_bf(XB, row + 1, F.lane, xn);
        rms_mod(x, gsc, sh, h);
        unsigned char* d8 = XN8 + (size_t)row * 1024;
#pragma unroll
        for (int j = 0; j < 4; ++j) *(GAS unsigned*)(d8 + 4 * F.lane + 256 * j) = pg8::pk4_fp8(h.v[j][0], h.v[j][1], h.v[j][2], h.v[j][3]);
    }
}

__device__ __forceinline__ void rows_conv(Frame& F) {
    const bf16* U = (const bf16*)((unsigned char*)F.out + DO_U); bf16* UC = (bf16*)(F.ws + WS_XN);
    const int cg = F.tid & 127, rsub = F.tid >> 7, c0 = cg * 8;
    float w[4][8], cb[8];
#pragma unroll
    for (int j = 0; j < 8; ++j) { cb[j] = F.in[I_LCB][c0 + j];
#pragma unroll
        for (int k = 0; k < 4; ++k) w[k][j] = F.in[I_LCW][k * 1024 + c0 + j]; }
    for (int run = blockIdx.x * 4 + rsub; run < MT / 16; run += F.G * 4) {
        const int row0 = run * 16; const int t0 = row0 < ML ? (row0 & 4095) : ((row0 - ML) & 255), T = row0 < ML ? 4096 : 256;
        v4u win[19];
#pragma unroll
        for (int i = 0; i < 19; ++i) { const int tt = t0 + i - 2; win[i] = (v4u){0u, 0u, 0u, 0u};
            if (tt >= 0 && tt < T) win[i] = __builtin_nontemporal_load((const GAS v4u*)(U + (size_t)(row0 + i - 2) * 1024 + c0)); }
#pragma unroll
        for (int i = 0; i < 16; ++i) { float acc[8];
#pragma unroll
            for (int j = 0; j < 8; ++j) acc[j] = cb[j];
#pragma unroll
            for (int k = 0; k < 4; ++k) { const v4u uv = win[i + k];
                acc[0] += w[k][0] * bflo(uv.x); acc[1] += w[k][1] * bfhi(uv.x); acc[2] += w[k][2] * bflo(uv.y); acc[3] += w[k][3] * bfhi(uv.y);
                acc[4] += w[k][4] * bflo(uv.z); acc[5] += w[k][5] * bfhi(uv.z); acc[6] += w[k][6] * bflo(uv.w); acc[7] += w[k][7] * bfhi(uv.w); }
            v4u o; o.x = pk2(acc[0], acc[1]); o.y = pk2(acc[2], acc[3]); o.z = pk2(acc[4], acc[5]); o.w = pk2(acc[6], acc[7]);
            *(GAS v4u*)(UC + (size_t)(row0 + i) * 1024 + c0) = o; }
    }
}

__device__ __forceinline__ int scan_q(int d, int pc) { return d == 0 ? pc : (pc < 8 ? 7 - pc : 143 - pc); }
__device__ __forceinline__ int scan_row0(int b, int pc) { return pc < 8 ? ML + b * 256 + pc * 32 : b * 4096 + (pc - 8) * 32; }
__device__ __forceinline__ const unsigned char* scan_lb(Frame& F, int d) { return (const unsigned char*)(F.ws + (d ? WS_BB0 : WS_LA0)); }
#define LB_DEC(w, a0, b0, a1, b1) do { const f32x2 lo_ = __builtin_amdgcn_cvt_pk_f32_fp8((int)(w), false), hi_ = __builtin_amdgcn_cvt_pk_f32_fp8((int)(w), true); \
        a0 = fast_exp2(lo_[0] * (1.0f / pg8::LA8_SCALE)); b0 = lo_[1]; a1 = fast_exp2(hi_[0] * (1.0f / pg8::LA8_SCALE)); b1 = hi_[1]; } while (0)
__device__ __forceinline__ void scan_local(Frame& F) {
    f32x4* summ = (f32x4*)((unsigned char*)F.out + DO_SUMM);
    const int c2 = 2 * F.tid;
    for (int item = blockIdx.x; item < BATCH * NQ; item += F.G) {
        const int b = item / NQ, pc = item % NQ, row0 = scan_row0(b, pc);
#pragma unroll
        for (int d = 0; d < 2; ++d) {
            const unsigned char* lb = scan_lb(F, d) + ((size_t)row0 * 1024 + c2) * 2;
            float P0 = 1.f, P1 = 1.f, H0 = 0.f, H1 = 0.f; unsigned wav[32];
#pragma unroll
            for (int i = 0; i < 32; ++i) wav[i] = *(const GAS unsigned*)(lb + (size_t)i * 2048);
#pragma unroll
            for (int ii = 0; ii < 32; ++ii) { const int i = d ? 31 - ii : ii; float a0, b0, a1, b1; LB_DEC(wav[i], a0, b0, a1, b1);
                H0 = a0 * H0 + b0; H1 = a1 * H1 + b1; P0 *= a0; P1 *= a1; }
            summ[((size_t)((b * 2 + d) * NQ + scan_q(d, pc)) * 1024 + c2) >> 1] = (f32x4){P0, H0, P1, H1};
        }
    }
}
__device__ __forceinline__ void scan_carry(Frame& F) {
    const f32x2* summ = (const f32x2*)((unsigned char*)F.out + DO_SUMM); float* carry = (float*)((unsigned char*)F.out + DO_CARRY);
    LAS f32x2* comp = (LAS f32x2*)(F.lds + RING_OFF);
    for (int u = blockIdx.x; u < 256; u += F.G) {
        const int bd = u >> 4, c = (u & 15) * 64 + F.lane, q0 = F.wave * 17; f32x2 s[17];
#pragma unroll
        for (int k = 0; k < 17; ++k) s[k] = summ[(size_t)(bd * NQ + q0 + k) * 1024 + c];
        float Pc = 1.f, Hc = 0.f;
#pragma unroll
        for (int k = 0; k < 17; ++k) { Hc = s[k][0] * Hc + s[k][1]; Pc *= s[k][0]; }
        comp[F.wave * 64 + F.lane] = (f32x2){Pc, Hc};
        __syncthreads();
        float h = 0.f;
        for (int w = 0; w < F.wave; ++w) { const f32x2 cw = comp[w * 64 + F.lane]; h = cw[0] * h + cw[1]; }
#pragma unroll
        for (int k = 0; k < 17; ++k) { carry[(size_t)(bd * NQ + q0 + k) * 1024 + c] = h; h = s[k][0] * h + s[k][1]; }
        __syncthreads();
    }
}
__device__ __forceinline__ void scan_final(Frame& F) {
    const float* carry = (const float*)((unsigned char*)F.out + DO_CARRY); const bf16* Gb = (const bf16*)(F.ws + WS_G); bf16* YGb = (bf16*)(F.ws + WS_XN);
    const int c2 = 2 * F.tid;
    for (int item = blockIdx.x; item < BATCH * NQ; item += F.G) {
        const int b = item / NQ, pc = item % NQ, row0 = scan_row0(b, pc);
        float hf0[32], hf1[32];
        { const unsigned char* lb = scan_lb(F, 0) + ((size_t)row0 * 1024 + c2) * 2;
          const f32x2 cin = *(const f32x2*)(carry + (size_t)((b * 2 + 0) * NQ + scan_q(0, pc)) * 1024 + c2); float h0 = cin[0], h1 = cin[1];
          unsigned wav[32];
#pragma unroll
          for (int i = 0; i < 32; ++i) wav[i] = *(const GAS unsigned*)(lb + (size_t)i * 2048);
#pragma unroll
          for (int i = 0; i < 32; ++i) { float a0, b0, a1, b1; LB_DEC(wav[i], a0, b0, a1, b1);
              h0 = a0 * h0 + b0; h1 = a1 * h1 + b1; hf0[i] = h0; hf1[i] = h1; } }
        { const unsigned char* lb = scan_lb(F, 1) + ((size_t)row0 * 1024 + c2) * 2; const bf16* gp = Gb + (size_t)row0 * 1024 + c2; bf16* yp = YGb + (size_t)row0 * 1024 + c2;
          const f32x2 cin = *(const f32x2*)(carry + (size_t)((b * 2 + 1) * NQ + scan_q(1, pc)) * 1024 + c2); float h0 = cin[0], h1 = cin[1];
          unsigned wav[32], gv[32];
#pragma unroll
          for (int i = 0; i < 32; ++i) wav[i] = *(const GAS unsigned*)(lb + (size_t)i * 2048);
#pragma unroll
          for (int i = 0; i < 32; ++i) gv[i] = *(const GAS unsigned*)(gp + (size_t)i * 1024);
#pragma unroll
          for (int ii = 0; ii < 32; ++ii) { const int i = 31 - ii; float a0, b0, a1, b1; LB_DEC(wav[i], a0, b0, a1, b1);
              h0 = a0 * h0 + b0; h1 = a1 * h1 + b1;
              const unsigned g = gv[i];
              *(GAS unsigned*)(yp + (size_t)i * 1024) = pk2((hf0[i] + h0) * (bflo(g) * (1.0f / pg8::BB8_SCALE)), (hf1[i] + h1) * (bfhi(g) * (1.0f / pg8::BB8_SCALE))); } }
    }
}

__device__ __forceinline__ int scan_po_panel(int pos, bool reorder) { if (!reorder || pos >= 48) return pos; const int k = pos / 24, j = pos % 24; return 6 * (j & 7) + 3 * k + (j >> 3); }
__device__ __forceinline__ void scan_final_ho(Frame& F, int nprod, bool reorder, unsigned* hcnt) {
    const float* carry = (const float*)((unsigned char*)F.out + DO_CARRY); const bf16* Gb = (const bf16*)(F.ws + WS_G); bf16* YGb = (bf16*)(F.ws + WS_XN);
    const int c2 = 2 * F.tid; int pend = -1;
    for (int t = blockIdx.x; t < BATCH * NQ; t += nprod) {
        asm volatile("" ::: "memory");
        const int panel = scan_po_panel(t >> 3, reorder), b = panel < 128 ? (panel >> 4) : panel - 128, pc = (panel < 128 ? 8 + (panel & 15) * 8 : 0) + (t & 7), row0 = scan_row0(b, pc);
        float hf0[32], hf1[32];
        { const unsigned char* lb = scan_lb(F, 0) + ((size_t)row0 * 1024 + c2) * 2;
          const f32x2 cin = *(const f32x2*)(carry + (size_t)((b * 2 + 0) * NQ + scan_q(0, pc)) * 1024 + c2); float h0 = cin[0], h1 = cin[1];
          unsigned wav[32];
#pragma unroll
          for (int i = 0; i < 32; ++i) wav[i] = __builtin_nontemporal_load((const GAS unsigned*)(lb + (size_t)i * 2048));
#pragma unroll
          for (int i = 0; i < 32; ++i) { float a0, b0, a1, b1; LB_DEC(wav[i], a0, b0, a1, b1);
              h0 = a0 * h0 + b0; h1 = a1 * h1 + b1; hf0[i] = h0; hf1[i] = h1; } }
        asm volatile("" ::: "memory");
        if (pend >= 0) { __syncthreads(); if (F.tid == 0) pg8::ho_publish(hcnt, pend); }
        { const unsigned char* lb = scan_lb(F, 1) + ((size_t)row0 * 1024 + c2) * 2; const bf16* gp = Gb + (size_t)row0 * 1024 + c2; bf16* yp = YGb + (size_t)row0 * 1024 + c2;
          const f32x2 cin = *(const f32x2*)(carry + (size_t)((b * 2 + 1) * NQ + scan_q(1, pc)) * 1024 + c2); float h0 = cin[0], h1 = cin[1];
          unsigned wav[32], gv[32];
#pragma unroll
          for (int i = 0; i < 32; ++i) wav[i] = __builtin_nontemporal_load((const GAS unsigned*)(lb + (size_t)i * 2048));
#pragma unroll
          for (int i = 0; i < 32; ++i) gv[i] = __builtin_nontemporal_load((const GAS unsigned*)(gp + (size_t)i * 1024));
#pragma unroll
          for (int ii = 0; ii < 32; ++ii) { const int i = 31 - ii; float a0, b0, a1, b1; LB_DEC(wav[i], a0, b0, a1, b1);
              h0 = a0 * h0 + b0; h1 = a1 * h1 + b1;
              const unsigned g = gv[i];
              __hip_atomic_store((GAS unsigned*)(yp + (size_t)i * 1024), pk2((hf0[i] + h0) * (bflo(g) * (1.0f / pg8::BB8_SCALE)), (hf1[i] + h1) * (bfhi(g) * (1.0f / pg8::BB8_SCALE))), __ATOMIC_RELAXED, __HIP_MEMORY_SCOPE_AGENT); } }
        pend = panel;
    }
    asm volatile("s_waitcnt vmcnt(0)" ::: "memory");
    __syncthreads();
    if (pend >= 0 && F.tid == 0) pg8::ho_publish(hcnt, pend);
}
#ifndef MK_N_LAUNCHES
#define MK_N_LAUNCHES 1
#endif
constexpr int NPHASE = 15;
#ifndef PH_STOP
#define PH_STOP 15
#endif
#ifndef PH_DUP
#define PH_DUP 0u
#endif
#define DUPN(k) (((PH_DUP >> (k)) & 1u) ? 2 : 1)
constexpr int N_LAUNCHES = MK_N_LAUNCHES;
struct Args { const float* in[26]; float* out; unsigned char* ws; int ph_lo, ph_hi; };

__global__ void __launch_bounds__(NWAVES * 64, 2) fwd_kernel(Args args) {
    extern __shared__ __attribute__((aligned(16))) unsigned char lds[];
    Frame F;
    F.lds = (LAS unsigned char*)lds;
    F.MISC = (volatile LAS unsigned*)(F.lds + MISC_OFF);
    F.tid = threadIdx.x; F.lane = F.tid & 63; F.wave = __builtin_amdgcn_readfirstlane(F.tid >> 6);
    F.G = gridDim.x; { const int bx = blockIdx.x; F.vcu = (F.G % 8 == 0) ? (bx % 8) * (F.G / 8) + bx / 8 : bx; }
    F.ws = args.ws; F.out = args.out; F.ctl = (gu32*)(args.ws + WS_CTL);
#pragma unroll
    for (int i = 0; i < 26; ++i) F.in[i] = args.in[i];
    for (int u = F.tid; u < (LDS_BYTES - LDSCTL_OFF) / 4; u += NWAVES * 64) ((LAS unsigned*)(F.lds + LDSCTL_OFF))[u] = 0u;
    __syncthreads();
    XcdBarrier bar; bar.bar = (unsigned*)(F.ctl + CW_BAR); bar.x = 0; bar.st = nullptr;
    if (N_LAUNCHES == 1) bar = xcd_barrier_post((unsigned*)(F.ctl + CW_BAR), F.MISC + 8);
#define GRID_BAR() do { if (N_LAUNCHES == 1) xcd_barrier(bar); } while (0)
    const int lo = args.ph_lo, hi = args.ph_hi;
#define IN(k) (lo <= (k) && (k) < hi)
#define BOTH(k) (IN(k) && IN((k) + 1))
    unsigned char* ws = args.ws;
    float* mod = (float*)(ws + WS_MOD);
    LAS unsigned char* ring = F.lds + RING_OFF;
    LAS int* tab = (LAS int*)(F.lds + TAB_OFF); LAS float* tabw = (LAS float*)(F.lds + TAB_OFF + TAB_UNITS * 1024);

#define PHASE(k, ...) do { if (IN(k)) { _Pragma("unroll") for (int rep_ = 0; rep_ < DUPN(k); ++rep_) { __VA_ARGS__; if (rep_ + 1 < DUPN(k)) GRID_BAR(); } if (BOTH(k)) GRID_BAR(); } } while (0)
    PHASE(0, p0_prologue(F));
    PHASE(1, {
        const int nearly = (F.G == 256) ? 96 : 0; unsigned* hc = (unsigned*)(F.ctl + CW_TILE + 12288);
        if ((int)blockIdx.x < F.G - nearly) rows_modulate_ho(F, F.in[I_X], F.in[I_CTX], 0, 0, F.in[I_NMIX], F.G - nearly, nearly != 0, hc);
        pg8::Gemm g{(const bf16*)(ws + WS_XN), (const bf16*)(ws + WS_W_IN), 1024, 1024, 1024, hc, 256u}; pg8::SchedIn S{F.G, (int)blockIdx.x, nearly};
        pg8::EpiInProj E{(bf16*)(ws + WS_G), (bf16*)((unsigned char*)F.out + DO_U)};
        pg8::gemm_phase<pg8::EpiInProj, pg8::SchedIn, false, 2, 2>(ring, g, S, E, tab);
        if (F.G == 256) conv_tail(F, 128, CV_A_END, CV_A_END + 5760, S.cl()); else conv_tail(F, 0, CV_A_END, CV_A_END + 5760); });
    PHASE(2, rows_conv(F));
    PHASE(3, {
        pg8::Gemm g{(const bf16*)(ws + WS_XN), (const bf16*)(ws + WS_W_G), 1024, 128, 128}; pg8::SchedGates S{MT / 256, F.G, (int)blockIdx.x};
        pg8::EpiGates E{(const bf16*)(ws + WS_XN), {ws + WS_LA0, ws + WS_BB0}, F.in[I_GAB], F.in[I_GXB], F.in[I_LAM]};
        pg8::gemm_phase<pg8::EpiGates, pg8::SchedGates, false>(ring, g, S, E, tab);
        if (F.G == 256) conv_tail(F, 128, CV_A_END + 5760, CV_A_END + 8320); else conv_tail(F, 0, CV_A_END + 5760, CV_A_END + 8320); });
    PHASE(4, scan_local(F));
    PHASE(5, scan_carry(F));
    PHASE(6, {
        const int nearly = (F.G == 256) ? 96 : 0; unsigned* hc = (unsigned*)(F.ctl + CW_TILE + 8192);
        if ((int)blockIdx.x < F.G - nearly) scan_final_ho(F, F.G - nearly, nearly != 0, hc);
        pg8::Gemm g{(const bf16*)(ws + WS_XN), (const bf16*)(ws + WS_W_OUT), 1024, 1024, 1024, hc}; pg8::SchedOut S{F.G, (int)blockIdx.x, nearly};
        pg8::EpiResid<false> E{F.in[I_X], F.in[I_CTX], (bf16*)(ws + WS_XB), mod + 2 * 1024, 1.0f};
        pg8::gemm_phase<pg8::EpiResid<false>, pg8::SchedOut, false, 2, 2>(ring, g, S, E, tab);
        if (F.G == 256) conv_tail(F, 96, CV_A_END + 8320, CV_B_END + CV_T8C); else conv_tail(F, 0, CV_A_END + 8320, CV_B_END + CV_T8C); });
    PHASE(7, rows_route(F, MT, 0));
#define MOE_UP(l, HOM) do { pg8::SchedMoe<true> S; S.init((const unsigned*)(F.ctl + CW_CNT + 64 * (l)), F.G, F.vcu); const int* ridx = (const int*)(ws + WS_RIDX); const v4u* route_ = (const v4u*)(ws + WS_ROUTE); \
        { pg8::Unit u; for (int i = 0; i < TAB_UNITS && S.next(i, u); ++i) if (F.tid < 256) { const bool v_ = F.tid < u.x1; const int row_ = v_ ? ridx[(size_t)u.x0 * MT + u.x2 + F.tid] : 0; \
              tab[i * 256 + F.tid] = row_; float w_ = 0.f; if (v_) { const v4u rt_ = route_[row_]; const unsigned wy_ = rt_.y, wz_ = rt_.z; w_ = __uint_as_float(u.pn < 4 ? wy_ : wz_); } tabw[i * 256 + F.tid] = w_; } } \
        __syncthreads(); \
        pg8::Gemm g{ws + WS_XN, ws + WS_W13 + (size_t)(l) * 16 * 1024 * 1024, 1024, 1024, 1024, (unsigned*)(F.ctl + CW_TILE + 4096 * (l))}; pg8::EpiMoe1<(HOM) != 0> E{ws + WS_ACT, tabw}; \
        pg8::gemm_phase<pg8::EpiMoe1<(HOM) != 0>, pg8::SchedMoe<true>, true, 1, (HOM) ? 1 : 0>(ring, g, S, E, tab); \
        if ((l) == 0 && !(HOM)) conv_tail(F, S.total % F.G, CV_B_END, CV_B_END + CV_T10, F.vcu); } while (0)
#define MOE_DOWN(l, FINAL, HOM) do { pg8::SchedMoe<false> S; S.init((const unsigned*)(F.ctl + CW_CNT + 64 * (l)), F.G, F.vcu); if (HOM) S.c = (F.vcu + F.G - (2 * S.total) % F.G) % F.G;     const int* ridx = (const int*)(ws + WS_RIDX); \
        { pg8::Unit u; for (int i = 0; i < TAB_UNITS && S.next(i, u); ++i) if (F.tid < 256) tab[i * 256 + F.tid] = F.tid < u.x1 ? ridx[(size_t)u.x0 * MT + u.x2 + F.tid] : -1; } \
        __syncthreads(); \
        pg8::Gemm g{ws + WS_ACT, ws + WS_W2 + (size_t)(l) * 16 * 1024 * 512, 1024, 512, 1024, (unsigned*)(F.ctl + CW_TILE + 4096 * (l))}; pg8::EpiMoe2<FINAL> E{(bf16*)(ws + WS_XB), F.out, mod + (l) * 9 * 6144 + 5 * 1024, tab}; \
        pg8::gemm_phase<pg8::EpiMoe2<FINAL>, pg8::SchedMoe<false>, false, 1, (HOM) ? 2 : 0>(ring, g, S, E, tab); \
        if ((l) == 0 && !(HOM)) conv_tail(F, S.total % F.G, CV_B_END + CV_T10, CV_B_END + CV_T10 + CV_T11, F.vcu); \
        if ((l) == 0 && (HOM)) conv_tail(F, 0, CV_B_END + CV_T8C, CV_B_END + CV_T10 + CV_T11, F.vcu);     \
        } while (0)
    PHASE(8, { MOE_UP(0, 1); __syncthreads(); MOE_DOWN(0, false, 1); });
    PHASE(9, rows_modulate_xb(F, MT, 1));
    PHASE(10, {
        pg8::Gemm g{ws + WS_XN, ws + WS_W_QKV, 1024, 1024, 1024}; pg8::SchedQKV S{F.G, (int)blockIdx.x};
        { int t_ = F.tid; asm volatile("" : "+v"(t_));
          LAS f32x4* rl = (LAS f32x4*)tab; rl[t_] = ((const f32x4*)(ws + WS_ROPE))[t_]; __syncthreads(); }
        pg8::EpiQKV E{ws + WS_Q, ws + WS_K, ws + WS_V, F.in[I_QN], F.in[I_KN], (const LAS float*)tab};
        pg8::gemm_phase<pg8::EpiQKV, pg8::SchedQKV, false, 1>(ring, g, S, E, tab);
        conv_tail(F, F.G == 256 ? 16 : 0, CV_B_END + CV_T10 + CV_T11, CV_B_END + CV_T10 + CV_T11 + CV_T13); });
    PHASE(11, {
        static_assert(attn8::LDS_BYTES <= RING_BYTES, "attention LDS");
        const attn8::Tensors AT{ws + WS_Q, ws + WS_K, ws + WS_V, ws + WS_O};
        attn8::attn_phase((char*)lds + RING_OFF, AT, (int)F.G, (int)blockIdx.x); });
    PHASE(12, {
        pg8::Gemm g{ws + WS_O, ws + WS_W_O, 1024, 1024, 1024}; pg8::SchedDense S{ML / 256, 4, F.G, (int)blockIdx.x};
        pg8::EpiResid<true> E{nullptr, nullptr, (bf16*)(ws + WS_XB), mod + 9 * 6144 + 2 * 1024, 1.0f / (pg8::W8_SCALE * attn8::OS)};
        pg8::gemm_phase<pg8::EpiResid<true>, pg8::SchedDense, false, 1>(ring, g, S, E, tab); });
    PHASE(13, rows_route(F, ML, 1));
    PHASE(14, { MOE_UP(1, 1); __syncthreads(); MOE_DOWN(1, true, 1); });
#undef IN
#undef BOTH
}

extern "C" void kernel_launch(void* const* d_in, const int* in_sizes, int n_in, void* d_out, int out_size, void* d_ws, size_t ws_size, hipStream_t stream) {
    static int grid = 0;
    if (grid == 0) {
        if (n_in != 26 || in_sizes[0] != ML * D || out_size != ML * D || ws_size < WS_END) { fprintf(stderr, "kernel_launch: unexpected shapes (n_in %d, in0 %d, out %d, ws %zu); nothing launched\n", n_in, n_in > 0 ? in_sizes[0] : -1, out_size, ws_size); grid = -1; return; }
        int dev = 0, cus = 0, per_cu = 0;
        if (hipGetDevice(&dev) != hipSuccess || hipDeviceGetAttribute(&cus, hipDeviceAttributeMultiprocessorCount, dev) != hipSuccess) { grid = -1; return; }
        if (hipFuncSetAttribute((const void*)fwd_kernel, hipFuncAttributeMaxDynamicSharedMemorySize, LDS_BYTES) != hipSuccess) { fprintf(stderr, "kernel_launch: hipFuncSetAttribute failed\n"); grid = -1; return; }
        if (hipOccupancyMaxActiveBlocksPerMultiprocessor(&per_cu, (const void*)fwd_kernel, NWAVES * 64, LDS_BYTES) != hipSuccess || per_cu < 1)
            fprintf(stderr, "kernel_launch: note: occupancy query reports %d workgroups per CU\n", per_cu);
        (void)hipGetLastError();
        grid = cus < 256 ? cus : 256;
    }
    if (grid < 0) return;
    if (hipMemsetAsync((char*)d_ws + WS_CTL, 0, CTL_ZERO_BYTES, stream) != hipSuccess) { fprintf(stderr, "kernel_launch: memset failed\n"); return; }
    Args a{};
    for (int i = 0; i < 26; ++i) a.in[i] = (const float*)d_in[i];
    a.out = (float*)d_out; a.ws = (unsigned char*)d_ws;
    for (int li = 0; li < (N_LAUNCHES == 1 ? 1 : PH_STOP); ++li) {
        a.ph_lo = (N_LAUNCHES == 1) ? 0 : li; a.ph_hi = (N_LAUNCHES == 1) ? PH_STOP : li + 1;
        hipLaunchKernelGGL(fwd_kernel, dim3(grid), dim3(NWAVES * 64), LDS_BYTES, stream, a);
        const hipError_t le = hipPeekAtLastError();
        if (le != hipSuccess) { fprintf(stderr, "kernel_launch: launch %d failed: %s\n", li, hipGetErrorName(le)); break; }
    }
}
```

```cpp
#include <hip/hip_runtime.h>
#include <cstdio>
#include <cstdint>

constexpr int BATCH = 8, SEQ = 4096, D = 1024, CTXL = 256;
constexpr int ML = BATCH * SEQ;
constexpr int MC = BATCH * CTXL;
constexpr int MT = ML + MC;
constexpr int KVL = CTXL + SEQ;
constexpr int NE = 16, FF = 512;
constexpr int NQ = 136;
constexpr float EPS = 1e-6f;
constexpr int NWAVES = 8;

constexpr size_t MiB = 1u << 20;
constexpr size_t WS_CTL = 0, CTL_ZERO_BYTES = 1 * MiB;
constexpr size_t WS_MOD = 1 * MiB;
constexpr size_t WS_ROPE = 1 * MiB + 512 * 1024;
constexpr size_t WS_ROUTE = 2 * MiB;
constexpr size_t WS_RIDX = 3 * MiB;
constexpr size_t WS_W_IN = 8 * MiB, WS_W_G = 12 * MiB, WS_W_OUT = 13 * MiB, WS_W_QKV = 15 * MiB, WS_W_O = 18 * MiB;
constexpr size_t WS_W13 = 20 * MiB, WS_W2 = 84 * MiB;
constexpr size_t WS_CTX = 116 * MiB;
constexpr size_t WS_XN = 124 * MiB;
constexpr size_t WS_G = 192 * MiB;
constexpr size_t WS_LA0 = 260 * MiB, WS_BB0 = 328 * MiB, WS_LA1 = 396 * MiB;
constexpr size_t WS_ACT = 192 * MiB;
constexpr size_t WS_Y = 264 * MiB;
constexpr size_t WS_Q = 192 * MiB, WS_K = 256 * MiB, WS_V = 273 * MiB;
constexpr size_t WS_O = 290 * MiB;
constexpr size_t WS_XB = 396 * MiB;
constexpr size_t WS_END = 464 * MiB;
constexpr size_t DO_U = 0, DO_SUMM = 68 * MiB, DO_CARRY = 88 * MiB;
constexpr int CW_TMO = 0, CW_CODE = 1, CW_CNT = 64  , CW_BAR = 4096, CW_TILE = 65536  ;

constexpr int RING_OFF = 0, RING_BYTES = 131072;
constexpr int LDSCTL_OFF = RING_BYTES, MISC_OFF = LDSCTL_OFF + 320;
constexpr int TAB_OFF = RING_BYTES + 1024, TAB_UNITS = 6;
constexpr int LDS_BYTES = 147456;
static_assert(TAB_OFF + 2 * TAB_UNITS * 1024 <= LDS_BYTES, "LDS map");

#define GAS __attribute__((address_space(1)))
#define LAS __attribute__((address_space(3)))
typedef unsigned short bf16;
typedef unsigned v4u __attribute__((ext_vector_type(4)));
typedef unsigned v2u __attribute__((ext_vector_type(2)));
typedef float f32x4 __attribute__((ext_vector_type(4)));
typedef float f32x2 __attribute__((ext_vector_type(2)));
typedef short bf16x8 __attribute__((ext_vector_type(8)));
typedef GAS unsigned gu32;
#define RLX_AGENT __ATOMIC_RELAXED, __HIP_MEMORY_SCOPE_AGENT
#define LDS_WAIT() asm volatile("s_waitcnt lgkmcnt(0)" ::: "memory")
#define VM_WAIT() asm volatile("s_waitcnt vmcnt(0)" ::: "memory")
__device__ __forceinline__ unsigned f2bf(float f) { unsigned u = __builtin_bit_cast(unsigned, f); return (u + 0x7fffu + ((u >> 16) & 1u)) >> 16; }
__device__ __forceinline__ unsigned pk2(float lo, float hi) { return f2bf(lo) | (f2bf(hi) << 16); }
__device__ __forceinline__ float bflo(unsigned w) { return __builtin_bit_cast(float, w << 16); }
__device__ __forceinline__ float bfhi(unsigned w) { return __builtin_bit_cast(float, w & 0xffff0000u); }
__device__ __forceinline__ float fast_exp2(float x) { return __builtin_amdgcn_exp2f(x); }
__device__ __forceinline__ float fast_rcp(float x) { return __builtin_amdgcn_rcpf(x); }
__device__ __forceinline__ float sigmoid_f(float x) { return fast_rcp(1.0f + fast_exp2(-1.4426950408889634f * x)); }

#define XB_TMO      128
#define XB_XCNT(j)  (256  + 64 * (j))
#define XB_XSUB(j)  (1280 + 64 * (j))
#define XB_XGEN(j)  (2304 + 64 * (j))
#define XB_TOP      3328
#define XB_TOPGEN   3392
#define XCD_BAR_WORDS 3456
#define XB_SPIN_CAP (1u << 18)

__device__ __forceinline__ unsigned xb_ld(unsigned* p)              { return __hip_atomic_load(p, __ATOMIC_RELAXED, __HIP_MEMORY_SCOPE_AGENT); }
__device__ __forceinline__ unsigned xb_add(unsigned* p, unsigned v) { return __hip_atomic_fetch_add(p, v, __ATOMIC_RELAXED, __HIP_MEMORY_SCOPE_AGENT); }
__device__ __forceinline__ unsigned xb_xcc_id() { return (unsigned)__builtin_amdgcn_s_getreg((3 << 11) | 20) & 0xFu; }
#define XB_SPIN(cond, bar) do { unsigned _sp = 0; while (cond) { __builtin_amdgcn_s_sleep(1); \
    if ((++_sp & 255u) == 0u) { if (xb_ld(&(bar)[XB_TMO])) break; if (_sp > XB_SPIN_CAP) { atomicAdd(&(bar)[XB_TMO], 1u); break; } } } } while (0)

struct XcdBarrier { unsigned* bar; unsigned x; volatile LAS unsigned* st; };

__device__ __forceinline__ XcdBarrier xcd_barrier_post(unsigned* bar, volatile LAS unsigned* st) {
    XcdBarrier b; b.bar = bar; b.x = xb_xcc_id(); b.st = st;
    if (threadIdx.x == 0) (void)xb_add(&bar[XB_XCNT(b.x)], 1u);
    return b;
}
__device__ __forceinline__ void xcd_barrier_complete(unsigned* bar, unsigned x, unsigned& nloc, unsigned& nx) {
    const unsigned G = gridDim.x * gridDim.y * gridDim.z;
    unsigned sum, cnt, mine, sp = 0u;
    for (;;) {
        sum = 0u; cnt = 0u; mine = 0u;
#pragma unroll
        for (unsigned j = 0; j < 16; ++j) { const unsigned c = xb_ld(&bar[XB_XCNT(j)]); sum += c; cnt += (c > 0u) ? 1u : 0u; mine = (j == x) ? c : mine; }
        if (sum == G) break;
        __builtin_amdgcn_s_sleep(1);
        if ((++sp & 255u) == 0u) { if (xb_ld(&bar[XB_TMO])) break; if (sp > XB_SPIN_CAP) { atomicAdd(&bar[XB_TMO], 1u); break; } }
    }
    nloc = mine > 0u ? mine : 1u; nx = cnt > 0u ? cnt : 1u;
}
__device__ __forceinline__ void xcd_barrier(const XcdBarrier& b) {
    asm volatile("s_waitcnt vmcnt(0)" ::: "memory");
    __syncthreads();
    if (threadIdx.x == 0) {
        unsigned* bar = b.bar;
        __builtin_amdgcn_s_waitcnt(0);
        unsigned nloc = b.st[0], nx = b.st[1];
        if (nloc == 0u) { xcd_barrier_complete(bar, b.x, nloc, nx); b.st[0] = nloc; b.st[1] = nx; }
        const unsigned old = xb_add(&bar[XB_XSUB(b.x)], 1u);
        const unsigned gen = old / nloc;
        if (old + 1u == (gen + 1u) * nloc) {
            __builtin_amdgcn_fence(__ATOMIC_RELEASE, "agent");
            asm volatile("s_waitcnt vmcnt(0)" ::: "memory");
            const unsigned og = xb_add(&bar[XB_TOP], 1u);
            const unsigned tg = og / nx;
            if (og + 1u == (tg + 1u) * nx) xb_add(&bar[XB_TOPGEN], 1u);
            else XB_SPIN(xb_ld(&bar[XB_TOPGEN]) == tg, bar);
            __builtin_amdgcn_fence(__ATOMIC_ACQUIRE, "agent");
            xb_add(&bar[XB_XGEN(b.x)], 1u);
            asm volatile("s_waitcnt vmcnt(0)" ::: "memory");
        } else {
            XB_SPIN(xb_ld(&bar[XB_XGEN(b.x)]) == gen, bar);
            __builtin_amdgcn_fence(__ATOMIC_ACQUIRE, "agent");
            asm volatile("s_waitcnt vmcnt(0)" ::: "memory");
        }
    }
    __syncthreads();
}
namespace pg8 {
#define PG8_LAS __attribute__((address_space(3)))
typedef unsigned short bf16_t;
typedef short bf16x8 __attribute__((ext_vector_type(8)));
typedef float f32x4 __attribute__((ext_vector_type(4)));
typedef unsigned u32x4 __attribute__((ext_vector_type(4)));
constexpr int BM = 256, BK = 64, HALF = 128, HTB = HALF * BK * 2, STAGE_BYTES = 8 * HTB, NXCD = 8, WGM = 8;

__host__ __device__ __forceinline__ int lds_byte(int r, int c) { const int st = (r >> 4) * 2 + (c >> 5), rr = r & 15, cc = c & 31, ob = rr * 64 + cc * 2; return st * 1024 + (ob ^ (((ob >> 9) & 1) << 5)); }
__host__ __device__ __forceinline__ void stage_rc(int b, int& R, int& C) { const int st = b / 1024, sb = b % 1024, swz = sb ^ (((sb >> 9) & 1) << 5); R = (st >> 1) * 16 + swz / 64; C = (st & 1) * 32 + (swz % 64) / 2; }
__host__ __device__ __forceinline__ int perm32(int rho) { const int n = rho >> 4, i = rho & 15; return 8 * (i >> 2) + 4 * n + (i & 3); }

struct Unit { int pm, pn; int arow, acol, brow; int x0, x1, x2, ord; int brow2, ksplit; };
struct Gemm { const void* A; const void* Bt; int lda, ldb, K; unsigned* hcnt = nullptr; unsigned hneed = 8u; };
typedef int v8i32 __attribute__((ext_vector_type(8)));
struct Frag2 { bf16x8 v[2]; __device__ __forceinline__ bf16x8& operator[](int i) { return v[i]; } __device__ __forceinline__ const bf16x8& operator[](int i) const { return v[i]; } };

__device__ __forceinline__ void tile_of(int L, int nM, int nN, int& pm, int& pn) {
    const int nwg = nM * nN; int wgid = L;
    { const int q = nwg / NXCD, r = nwg % NXCD, xcd = wgid % NXCD, off = wgid / NXCD; wgid = (xcd < r ? xcd * (q + 1) : r * (q + 1) + (xcd - r) * q) + off; }
    const int nig = WGM * nN, gid = wgid / nig, fm = gid * WGM, gsz = (nM - fm) < WGM ? (nM - fm) : WGM;
    pm = fm + ((wgid % nig) % gsz); pn = (wgid % nig) / gsz;
}

__device__ __forceinline__ unsigned cvt_pk_bf16(float lo, float hi) { unsigned r; asm volatile("v_cvt_pk_bf16_f32 %0, %1, %2" : "=v"(r) : "v"(lo), "v"(hi)); return r; }

constexpr unsigned HO_SPIN_CAP = 1u << 22;
__device__ __forceinline__ void ho_publish(unsigned* hcnt, int tile) { (void)__hip_atomic_fetch_add(hcnt + tile * 16, 1u, __ATOMIC_RELAXED, __HIP_MEMORY_SCOPE_AGENT); }
__device__ __forceinline__ void ho_acquire(unsigned* hcnt, int tile, unsigned need) {
    unsigned sp = 0; unsigned* htmo = hcnt - 16;
    while ((unsigned)__builtin_amdgcn_readfirstlane((int)__hip_atomic_load(hcnt + tile * 16, __ATOMIC_RELAXED, __HIP_MEMORY_SCOPE_AGENT)) < need) {
        __builtin_amdgcn_s_sleep(1);
        if ((++sp & 255u) == 0u) { if (__builtin_amdgcn_readfirstlane((int)__hip_atomic_load(htmo, __ATOMIC_RELAXED, __HIP_MEMORY_SCOPE_AGENT))) break;
            if (sp > HO_SPIN_CAP) { (void)__hip_atomic_fetch_add(htmo, 1u, __ATOMIC_RELAXED, __HIP_MEMORY_SCOPE_AGENT); break; } } }
    __builtin_amdgcn_fence(__ATOMIC_ACQUIRE, "agent");
    asm volatile("s_waitcnt vmcnt(0)" ::: "memory");
}
template <class Epi, class Sched, bool GATHER, int ES = 2, int HO = 0>
__device__ __forceinline__ void gemm_phase(PG8_LAS unsigned char* lds, const Gemm g, const Sched& S, const Epi& E, const PG8_LAS int* tab) {
    const int tid = threadIdx.x, wid = __builtin_amdgcn_readfirstlane(tid >> 6), lane = tid & 63, wr = wid >> 2, wc = wid & 3, fr = lane & 15, fq = lane >> 4;
    const int K = g.K, nt = K * ES / (BK * 2), lda = g.lda * ES, ldb = g.ldb * ES;
    unsigned voffA[2], voffB[2]; int Rst[2], Cst[2];
#pragma unroll
    for (int i = 0; i < 2; ++i) { int R, C; stage_rc(tid * 16 + i * 8192, R, C); const int Rb = Epi::PERM ? ((R & ~31) + perm32(R & 31)) : R;
        voffA[i] = (unsigned)(R * lda + C * 2); voffB[i] = (unsigned)(Rb * ldb + C * 2); Rst[i] = R; Cst[i] = C * 2; }
    const size_t kstep = (size_t)(BK * 2);
    const size_t hstepA = GATHER ? (size_t)0 : (size_t)HALF * lda, hstepB = (size_t)HALF * ldb;
    const unsigned ldsw = (unsigned)wid * 1024u;
    const int aoff = lds_byte(wr * 64 + fr, fq * 8), boff = lds_byte(wc * 32 + fr, fq * 8);
#define PG8_SA(b, h) (((b) * 2 + (h)) * HTB)
#define PG8_SB(b, h) ((4 + (b) * 2 + (h)) * HTB)
#define PG8_STAGE(bufoff, gbase, voff) do { _Pragma("unroll") for (int _i = 0; _i < 2; ++_i) \
        __builtin_amdgcn_global_load_lds((const unsigned*)((const char*)(gbase) + (voff)[_i]), (PG8_LAS unsigned*)(lds + (bufoff) + ldsw + _i * 8192), 16, 0, 0); } while (0)
#define PG8_LDA(dst, b, h) do { _Pragma("unroll") for (int m = 0; m < 4; ++m) _Pragma("unroll") for (int k = 0; k < 2; ++k) dst[m][k] = *(const PG8_LAS bf16x8*)(lds + PG8_SA(b, h) + aoff + m * 2048 + k * 1024); } while (0)
#define PG8_LDB(dst, b, h) do { _Pragma("unroll") for (int n = 0; n < 2; ++n) _Pragma("unroll") for (int k = 0; k < 2; ++k) dst[n][k] = *(const PG8_LAS bf16x8*)(lds + PG8_SB(b, h) + boff + n * 2048 + k * 1024); } while (0)
#define PG8_MMA(ai, bj, At, Bt) do { __builtin_amdgcn_s_setprio(1); \
        if constexpr (ES == 2) { _Pragma("unroll") for (int m = 0; m < 4; ++m) _Pragma("unroll") for (int n = 0; n < 2; ++n) _Pragma("unroll") for (int k = 0; k < 2; ++k) \
            acc[ai][bj][m][n] = __builtin_amdgcn_mfma_f32_16x16x32_bf16(Bt[n][k], At[m][k], acc[ai][bj][m][n], 0, 0, 0); } \
        else { asm volatile("s_nop 1"); _Pragma("unroll") for (int m = 0; m < 4; ++m) _Pragma("unroll") for (int n = 0; n < 2; ++n) \
            asm volatile("v_mfma_f32_16x16x128_f8f6f4 %0, %1, %2, %0" : "+v"(acc[ai][bj][m][n]) : "v"(__builtin_bit_cast(v8i32, Bt[n])), "v"(__builtin_bit_cast(v8i32, At[m]))); } \
        __builtin_amdgcn_s_setprio(0); } while (0)
#define PG8_WAIT_V(n) asm volatile("s_waitcnt vmcnt(" #n ")" ::: "memory")
#define PG8_WAIT_L(n) asm volatile("s_waitcnt lgkmcnt(" #n ")" ::: "memory")
#define PG8_BAR __builtin_amdgcn_s_barrier()
#define PG8_SCHED __builtin_amdgcn_sched_barrier(0)
#define PG8_GLOAD(dst, ui_) do { _Pragma("unroll") for (int _h = 0; _h < 2; ++_h) _Pragma("unroll") for (int _i = 0; _i < 2; ++_i) \
        dst[_h][_i] = (unsigned)tab[(ui_) * 256 + _h * 128 + Rst[_i]] * (unsigned)lda + (unsigned)Cst[_i]; } while (0)
    const int sc8 = 0x7f7f7f7f;
    (void)sc8;
    Unit cur, nxt; int ui = 0;
    if (!S.next(0, cur)) return;
    f32x4 acc[2][2][4][2];
#pragma unroll
    for (int a = 0; a < 2; ++a)
#pragma unroll
        for (int b = 0; b < 2; ++b)
#pragma unroll
            for (int m = 0; m < 4; ++m)
#pragma unroll
                for (int n = 0; n < 2; ++n) acc[a][b][m][n] = (f32x4){0.f, 0.f, 0.f, 0.f};
    Frag2 At[4], B0[2], B1[2];
    unsigned gcur[2][2], gnxt[2][2];
    if constexpr (GATHER) { PG8_GLOAD(gcur, 0); } else {
#pragma unroll
        for (int h = 0; h < 2; ++h)
#pragma unroll
            for (int i = 0; i < 2; ++i) { gcur[h][i] = voffA[i]; gnxt[h][i] = voffA[i]; } }
    const char* cA = (const char*)g.A + (size_t)(GATHER ? 0 : cur.arow) * lda + (size_t)cur.acol * ES; const char* cB = (const char*)g.Bt + (size_t)cur.brow * ldb;
    const char* cB2 = cur.ksplit ? (const char*)g.Bt + (size_t)cur.brow2 * ldb - (size_t)cur.ksplit * kstep : cB; int ksp = cur.ksplit ? cur.ksplit : (1 << 30);
    int pend = -1;
    if constexpr (HO == 2) { if (wid == 0) ho_acquire(g.hcnt, cur.pm, g.hneed); __syncthreads(); }
    PG8_STAGE(PG8_SB(0, 0), cB, voffB); PG8_STAGE(PG8_SB(0, 1), cB + hstepB, voffB); PG8_STAGE(PG8_SA(0, 0), cA, gcur[0]); PG8_STAGE(PG8_SA(0, 1), cA + hstepA, gcur[1]);
    if (wr == 1) PG8_BAR;
    PG8_WAIT_V(2); PG8_BAR;
    PG8_STAGE(PG8_SB(1, 0), cB + kstep, voffB); PG8_STAGE(PG8_SA(1, 0), cA + kstep, gcur[0]); PG8_STAGE(PG8_SB(1, 1), cB + hstepB + kstep, voffB);
    PG8_WAIT_V(6); PG8_BAR;
    for (;;) {
        const bool has_next = S.next(ui + 1, nxt);
        if constexpr (HO == 2) { if (has_next && wid == 0) ho_acquire(g.hcnt, nxt.pm, g.hneed); }
        const char* nA = has_next ? (const char*)g.A + (size_t)(GATHER ? 0 : nxt.arow) * lda + (size_t)nxt.acol * ES : cA; const char* nB = has_next ? (const char*)g.Bt + (size_t)nxt.brow * ldb : cB;
        if constexpr (GATHER) { if (has_next) { PG8_GLOAD(gnxt, ui + 1); } else {
#pragma unroll
            for (int h = 0; h < 2; ++h)
#pragma unroll
                for (int i = 0; i < 2; ++i) gnxt[h][i] = gcur[h][i]; } }
#pragma nounroll
        for (int t = 0; t < nt; t += 2) {
            const bool last = (t == nt - 2);
            const char* a1 = cA + (size_t)(t + 1) * kstep;
            const char* a2 = last ? nA : cA + (size_t)(t + 2) * kstep; const char* b2 = last ? nB : (t + 2 >= ksp ? cB2 : cB) + (size_t)(t + 2) * kstep;
            const char* a3 = a2 + kstep; const char* b3 = b2 + kstep;
            unsigned s0[2], s1[2];
#pragma unroll
            for (int i = 0; i < 2; ++i) { s0[i] = (GATHER && last) ? gnxt[0][i] : gcur[0][i]; s1[i] = (GATHER && last) ? gnxt[1][i] : gcur[1][i]; }
            PG8_LDB(B0, 0, 0); PG8_LDB(B1, 0, 1); PG8_SCHED; PG8_LDA(At, 0, 0); PG8_STAGE(PG8_SA(1, 1), a1 + hstepA, gcur[1]);
            PG8_WAIT_V(8); PG8_WAIT_L(0); PG8_BAR; PG8_MMA(0, 0, At, B0); PG8_MMA(0, 1, At, B1); PG8_BAR; PG8_SCHED;
            PG8_LDA(At, 0, 1); PG8_STAGE(PG8_SB(0, 0), b2, voffB); PG8_STAGE(PG8_SB(0, 1), b2 + hstepB, voffB); PG8_STAGE(PG8_SA(0, 0), a2, s0);
            PG8_WAIT_V(8); PG8_WAIT_L(0); PG8_BAR; PG8_MMA(1, 0, At, B0); PG8_MMA(1, 1, At, B1); PG8_BAR; PG8_SCHED;
            PG8_LDB(B0, 1, 0); PG8_LDB(B1, 1, 1); PG8_SCHED; PG8_LDA(At, 1, 0); PG8_STAGE(PG8_SA(0, 1), a2 + hstepA, s1);
            PG8_WAIT_V(8); PG8_WAIT_L(0); PG8_BAR; PG8_MMA(0, 0, At, B0); PG8_MMA(0, 1, At, B1); PG8_BAR; PG8_SCHED;
            PG8_LDA(At, 1, 1); PG8_STAGE(PG8_SB(1, 0), b3, voffB); PG8_STAGE(PG8_SB(1, 1), b3 + hstepB, voffB); PG8_STAGE(PG8_SA(1, 0), a3, s0);
            PG8_WAIT_V(8); PG8_WAIT_L(0); PG8_BAR; PG8_MMA(1, 0, At, B0); PG8_MMA(1, 1, At, B1); PG8_BAR; PG8_SCHED;
        }
        if (wr == 0) PG8_BAR;
        if constexpr (HO == 1) { if (pend >= 0 && tid == 0) ho_publish(g.hcnt, pend); }
        if constexpr (ES == 1) asm volatile("s_nop 15\n\ts_nop 15" ::: "memory");
        E(acc, cur, wr, wc, fr, fq);
        if constexpr (HO == 1) pend = cur.pm;
        if (!has_next) break;
#pragma unroll
        for (int a = 0; a < 2; ++a)
#pragma unroll
            for (int b = 0; b < 2; ++b)
#pragma unroll
                for (int m = 0; m < 4; ++m)
#pragma unroll
                    for (int n = 0; n < 2; ++n) acc[a][b][m][n] = (f32x4){0.f, 0.f, 0.f, 0.f};
        cur = nxt; cA = nA; cB = nB; ++ui;
        cB2 = cur.ksplit ? (const char*)g.Bt + (size_t)cur.brow2 * ldb - (size_t)cur.ksplit * kstep : cB; ksp = cur.ksplit ? cur.ksplit : (1 << 30);
        if constexpr (GATHER) {
#pragma unroll
            for (int h = 0; h < 2; ++h)
#pragma unroll
                for (int i = 0; i < 2; ++i) gcur[h][i] = gnxt[h][i]; }
        if (wr == 1) PG8_BAR;
    }
    PG8_WAIT_V(0);
    PG8_BAR;
    if constexpr (HO == 1) { if (pend >= 0 && tid == 0) ho_publish(g.hcnt, pend); }
#undef PG8_SA
#undef PG8_SB
#undef PG8_STAGE
#undef PG8_LDA
#undef PG8_LDB
#undef PG8_MMA
#undef PG8_WAIT_V
#undef PG8_WAIT_L
#undef PG8_BAR
#undef PG8_SCHED
#undef PG8_GLOAD
}
}
namespace attn8 {
using f32x16 = __attribute__((ext_vector_type(16))) float;
using f32x4 = __attribute__((ext_vector_type(4))) float;
using u32x4 = __attribute__((ext_vector_type(4))) unsigned;
using v8i32 = __attribute__((ext_vector_type(8))) int;
constexpr int NHEAD = 16, SEQ = 4096, KVSEQ = 4352, DMQ = 1024, DMK = 256, NT = KVSEQ / 64;
constexpr float QS = 2.0f * 1.4426950408889634f, KS = 0.5f, VS = 8.0f, PS = 16.0f, OS = 4.0f;
constexpr float CS = 0.125f * 1.4426950408889634f / (QS * KS);
constexpr int THRL = 4;
constexpr int SLOTB = 4096, LDS_BYTES = 16 * SLOTB + 8 * 256 + 8 * 4096;
__host__ __device__ __forceinline__ int crow(int r, int hi) { return (r & 3) + 8 * (r >> 2) + 4 * hi; }
__host__ __device__ __forceinline__ int vpos(int kk) { return 32 * ((kk >> 2) & 1) + (kk & 3) + 4 * ((kk >> 3) & 3) + 16 * (kk >> 5); }
__device__ __forceinline__ void glds16(const void* gsrc, unsigned lds_dst) { unsigned keep;
    asm volatile("s_mov_b32 %0, m0\n\ts_mov_b32 m0, %2\n\ts_nop 0\n\tglobal_load_lds_dwordx4 %1, off\n\ts_mov_b32 m0, %0" : "=&s"(keep) : "v"(gsrc), "s"(lds_dst) : "memory"); }
#define A8_WAIT_BAR(N) asm volatile("s_waitcnt vmcnt(" #N ") lgkmcnt(0)\n\ts_barrier" ::: "memory")
__device__ __forceinline__ unsigned pk4(float a, float b, float c, float d) { unsigned w = 0u; w = (unsigned)__builtin_amdgcn_cvt_pk_fp8_f32(a, b, (int)w, false); w = (unsigned)__builtin_amdgcn_cvt_pk_fp8_f32(c, d, (int)w, true); return w; }
typedef __attribute__((address_space(3))) const unsigned char* lds_cptr;

__device__ __forceinline__ float max3f(float a, float b, float c) { float r; asm("v_max3_f32 %0, %1, %2, %3" : "=v"(r) : "v"(a), "v"(b), "v"(c)); return r; }
__device__ __forceinline__ unsigned pk4a(float a, float b, float c, float d) { unsigned w; asm("v_cvt_pk_fp8_f32 %0, %1, %2\n\tv_cvt_pk_fp8_f32 %0, %3, %4 op_sel:[0,0,1]" : "=&v"(w) : "v"(a), "v"(b), "v"(c), "v"(d)); return w; }
constexpr int NSLOTV = 4;
constexpr int LDS2_K = 0, LDS2_V = 8 * SLOTB, LDS2_WS = LDS2_V + 8 * SLOTB, LDS2_OST = LDS2_WS + 8 * 256, LDS2_BYTES = LDS2_OST + 8 * 4096;
__device__ __forceinline__ void attn_unit(int b, int h, int qb, bool first, bool has_next, int nb, int nh, const unsigned char* Q8, const unsigned char* K8, const unsigned char* Vt8, unsigned char* O8, char* shm) {
    const int tid = threadIdx.x, lane = tid & 63, r32 = lane & 31, hi = lane >> 5; const int wid = __builtin_amdgcn_readfirstlane(tid >> 6);
    const int kvh = h >> 2, q0 = qb * 256;
    const unsigned lds0 = (unsigned)(uintptr_t)shm;
    float* wsf = (float*)(shm + LDS2_WS) + wid * 64;
    const unsigned char* qp = Q8 + (size_t)((size_t)b * SEQ + q0 + wid * 32 + r32) * DMQ + h * 64 + 32 * hi;
    const u32x4 qa = *(const u32x4*)qp, qb4 = *(const u32x4*)(qp + 16);
    const v8i32 q8 = {(int)qa.x, (int)qa.y, (int)qa.z, (int)qa.w, (int)qb4.x, (int)qb4.y, (int)qb4.z, (int)qb4.w};
    const int w4 = wid & 3, drow = w4 * 16 + (lane >> 2), dc = (lane & 3) ^ ((drow >> 2) & 3);
    const bool isk = wid < 4;
    const unsigned char* dsrc = isk ? K8 + ((size_t)b * KVSEQ + drow) * DMK + kvh * 64 + dc * 16 : Vt8 + ((size_t)(b * 4 + kvh) * 64 + drow) * KVSEQ + dc * 16;
    const size_t dstep = isk ? (size_t)64 * DMK : (size_t)64;
    const unsigned ddst = lds0 + (isk ? LDS2_K : LDS2_V) + w4 * 1024;
#define A8_DMA(t, slot) glds16(dsrc + (size_t)(t) * dstep, (unsigned)__builtin_amdgcn_readfirstlane(ddst + (slot)))
    if (first) { A8_DMA(0, 0); A8_DMA(1, SLOTB); A8_DMA(2, 2 * SLOTB); if (isk) { A8_DMA(3, 3 * SLOTB); A8_DMA(4, 4 * SLOTB); A8_DMA(5, 5 * SLOTB); } }
    const int sw = (r32 >> 2) & 3, fo0 = r32 * 64 + (((2 * hi) ^ sw) << 4), fo1 = r32 * 64 + (((2 * hi + 1) ^ sw) << 4);
    const lds_cptr kb = (lds_cptr)shm + LDS2_K, vb = (lds_cptr)shm + LDS2_V;
    typedef const __attribute__((address_space(3))) u32x4* lds_v4;
#define A8_FRAG(dst, base, off) do { const u32x4 a_ = *(lds_v4)((base) + (off) + fo0), b_ = *(lds_v4)((base) + (off) + fo1); \
        dst = (v8i32){(int)a_.x, (int)a_.y, (int)a_.z, (int)a_.w, (int)b_.x, (int)b_.y, (int)b_.z, (int)b_.w}; } while (0)
    constexpr float LP = 4.0f, DB = 55.66f, DTH = 8.0f * (LP + (float)THRL) + DB;
    float mhat = 0.f; f32x16 o0 = f32x16{}, o1 = f32x16{}; f32x4 ls4 = f32x4{};
    f32x16 cb; { const float c_ = 8.0f * LP + DB;
#pragma unroll
      for (int r = 0; r < 16; ++r) cb[r] = c_; }
    constexpr int sc1 = 0, scq = 0;
    const int selv = (((lane >> 4) & 1) == ((lane & 15) >> 3)) ? 0x38383838 : 0; const v8i32 sel = {selv, selv, selv, selv, selv, selv, selv, selv};
    const int qs0 = 4 * (lane >> 4) + 16 * ((lane & 15) >> 3);
    A8_WAIT_BAR(0);
    f32x16 c0, c1;
    v8i32 ka0, ka1, kb0, kb1;
    A8_FRAG(ka0, kb + SLOTB, 0); A8_FRAG(ka1, kb + SLOTB, 2048);
    { v8i32 kf0, kf1; A8_FRAG(kf0, kb, 0); A8_FRAG(kf1, kb, 2048);
      c0 = __builtin_amdgcn_mfma_scale_f32_32x32x64_f8f6f4(kf0, q8, cb, 0, 0, 0, scq, 0, sc1);
      c1 = __builtin_amdgcn_mfma_scale_f32_32x32x64_f8f6f4(kf1, q8, cb, 0, 0, 0, scq, 0, sc1); }
    asm volatile("s_nop 15\n\ts_nop 15\n\ts_nop 15\n\ts_nop 15\n\ts_nop 15\n\ts_nop 15" : "+v"(c0), "+v"(c1));
    v8i32 p8 = {0, 0, 0, 0, 0, 0, 0, 0};
    f32x16 d0, d1;
#define A8_STEP(S0, S1, N0, N1, KC0, KC1, KN0, KN1, t, SOFTMAX, BAR) do { \
        if (BAR) { A8_WAIT_BAR(0);                                                     \
            _Pragma("unroll") for (int i_ = 0; i_ < 4; ++i_) { const int tk_ = (t) + 6 + i_, tv_ = (t) + 3 + i_; \
                if (isk) { if (tk_ < NT) A8_DMA(tk_, (tk_ & 7) * SLOTB); } else { if (tv_ < NT) A8_DMA(tv_, (tv_ & 7) * SLOTB); } } } \
        v8i32 vf0, vf1; \
        { const lds_cptr kp_ = kb + (((t) + 2) & 7) * SLOTB; A8_FRAG(KN0, kp_, 0); A8_FRAG(KN1, kp_, 2048); }     \
        { const lds_cptr vp_ = vb + (((t) == 0 ? 0 : (t) - 1) & 7) * SLOTB; A8_FRAG(vf0, vp_, 0); A8_FRAG(vf1, vp_, 2048); }     \
        __builtin_amdgcn_sched_barrier(0); \
        float rmc; \
        { float a = fmaxf(S0[0], S1[0]), bq = fmaxf(S0[1], S1[1]); \
          _Pragma("unroll") for (int r = 2; r < 16; r += 2) { a = __builtin_fmaxf(__builtin_fmaxf(a, S0[r]), S1[r]); bq = __builtin_fmaxf(__builtin_fmaxf(bq, S0[r + 1]), S1[r + 1]); } \
          rmc = fmaxf(a, bq); } \
        { auto rr = __builtin_amdgcn_permlane32_swap(__float_as_uint(rmc), __float_as_uint(rmc), false, false); rmc = fmaxf(__uint_as_float(rr[0]), __uint_as_float(rr[1])); } \
        __builtin_amdgcn_sched_barrier(0); \
        N0 = __builtin_amdgcn_mfma_scale_f32_32x32x64_f8f6f4(KC0, q8, cb, 0, 0, 0, scq, 0, sc1); \
        N1 = __builtin_amdgcn_mfma_scale_f32_32x32x64_f8f6f4(KC1, q8, cb, 0, 0, 0, scq, 0, sc1); \
        o0 = __builtin_amdgcn_mfma_scale_f32_32x32x64_f8f6f4(p8, vf0, o0, 0, 0, 0, sc1, 0, sc1); \
        o1 = __builtin_amdgcn_mfma_scale_f32_32x32x64_f8f6f4(p8, vf1, o1, 0, 0, 0, sc1, 0, sc1); \
        ls4 = __builtin_amdgcn_mfma_scale_f32_16x16x128_f8f6f4(p8, sel, ls4, 0, 0, 0, sc1, 0, sc1); \
        __builtin_amdgcn_sched_barrier(0); \
        if (SOFTMAX) { \
            bool resc = false; \
            if ((t) == 0 || __any(rmc > DTH)) {                                       \
                const float dl = ((t) == 0) ? (rmc - DB) * 0.125f - LP : fmaxf((rmc - DB) * 0.125f - LP, 0.f); mhat += dl; const float dl8 = 8.0f * dl; \
                _Pragma("unroll") for (int r = 0; r < 16; ++r) { S0[r] -= dl8; S1[r] -= dl8; N0[r] -= dl8; N1[r] -= dl8; cb[r] -= dl8; } \
                const float f = __builtin_amdgcn_exp2f(-dl); if (hi == 0) wsf[r32] = f; resc = true; } \
            _Pragma("unroll") for (int g = 0; g < 4; ++g) { unsigned wa = __builtin_amdgcn_cvt_pk_u8_f32(S0[4 * g], 0, 0u), wb = __builtin_amdgcn_cvt_pk_u8_f32(S1[4 * g], 0, 0u); \
                _Pragma("unroll") for (int j = 1; j < 4; ++j) { wa = __builtin_amdgcn_cvt_pk_u8_f32(S0[4 * g + j], j, wa); wb = __builtin_amdgcn_cvt_pk_u8_f32(S1[4 * g + j], j, wb); } \
                p8[g] = (int)wa; p8[4 + g] = (int)wb; } \
            if (resc) { asm volatile("s_waitcnt lgkmcnt(0)" ::: "memory"); \
                _Pragma("unroll") for (int r = 0; r < 16; ++r) { const float f = wsf[crow(r, hi)]; o0[r] *= f; o1[r] *= f; } \
                _Pragma("unroll") for (int i = 0; i < 4; ++i) ls4[i] *= wsf[qs0 + i]; } \
        } \
    } while (0)
    static_assert(NT % 4 == 0, "groups of four tiles");
#pragma nounroll
    for (int t = 0; t < NT; t += 4) {
        A8_STEP(c0, c1, d0, d1, ka0, ka1, kb0, kb1, t, true, true);
        A8_STEP(d0, d1, c0, c1, kb0, kb1, ka0, ka1, t + 1, true, false);
        A8_STEP(c0, c1, d0, d1, ka0, ka1, kb0, kb1, t + 2, true, false);
        A8_STEP(d0, d1, c0, c1, kb0, kb1, ka0, ka1, t + 3, true, false);
    }
    A8_STEP(c0, c1, d0, d1, ka0, ka1, kb0, kb1, NT, false, true);
#undef A8_STEP
    asm volatile("s_waitcnt lgkmcnt(0)\n\ts_barrier" ::: "memory");
    if (has_next) { const int nkvh = nh >> 2;
        const unsigned char* nsrc = isk ? K8 + ((size_t)nb * KVSEQ + drow) * DMK + nkvh * 64 + dc * 16 : Vt8 + ((size_t)(nb * 4 + nkvh) * 64 + drow) * KVSEQ + dc * 16;
#define A8_DMAN(t, slot) glds16(nsrc + (size_t)(t) * dstep, (unsigned)__builtin_amdgcn_readfirstlane(ddst + (slot)))
        A8_DMAN(0, 0); A8_DMAN(1, SLOTB); A8_DMAN(2, 2 * SLOTB); if (isk) { A8_DMAN(3, 3 * SLOTB); A8_DMAN(4, 4 * SLOTB); A8_DMAN(5, 5 * SLOTB); }
#undef A8_DMAN
    }
    if ((lane & 7) == 0) {
#pragma unroll
        for (int i = 0; i < 4; ++i) wsf[32 + qs0 + i] = ls4[i]; }
    asm volatile("s_waitcnt lgkmcnt(0)" ::: "memory");
    unsigned char* Ow = O8 + (size_t)((size_t)b * SEQ + q0 + wid * 32) * DMQ + h * 64;
    { unsigned char* stg = (unsigned char*)(shm + LDS2_OST) + wid * 4096;
#pragma unroll
      for (int r = 0; r < 16; ++r) { const int orow = crow(r, hi); const float rl = __builtin_amdgcn_rcpf(wsf[32 + orow]) * (OS / VS);
          const float a = o0[r] * rl, c = o1[r] * rl;
          stg[orow * 64 + r32] = (unsigned char)__builtin_amdgcn_cvt_pk_fp8_f32(a, a, 0, false); stg[orow * 64 + 32 + r32] = (unsigned char)__builtin_amdgcn_cvt_pk_fp8_f32(c, c, 0, false); }
      asm volatile("s_waitcnt lgkmcnt(0)" ::: "memory");
#pragma unroll
      for (int i = 0; i < 2; ++i) { const int row = i * 16 + (lane >> 2), ch = lane & 3; const u32x4 v = *(const u32x4*)(stg + row * 64 + ch * 16); *(u32x4*)(Ow + (size_t)row * DMQ + ch * 16) = v; } }
    asm volatile("s_waitcnt lgkmcnt(0)" ::: "memory");
#undef A8_DMA
#undef A8_FRAG
}
struct Tensors { const unsigned char* Q8; const unsigned char* K8; const unsigned char* Vt8; unsigned char* O8; };
__device__ __forceinline__ void attn_phase(char* lds, const Tensors& T, int grid, int block) {
    const int vcu = (grid % 8 == 0) ? (block % 8) * (grid / 8) + block / 8 : block;
    const int n = (grid == 256) ? 8 : (vcu < 2048 ? (2048 - vcu + grid - 1) / grid : 0);
    for (int i = 0; i < n; ++i) {
        const int idx = (grid == 256) ? (vcu >> 5) * 256 + i * 32 + (vcu & 31) : i * grid + vcu;
        const int idn = (grid == 256) ? (vcu >> 5) * 256 + (i + 1) * 32 + (vcu & 31) : (i + 1) * grid + vcu;
        const int b = idx >> 8, r = idx & 255, rn = idn & 255;
        attn_unit(b, (r >> 6) * 4 + ((r >> 4) & 3), r & 15, i == 0, i + 1 < n, idn >> 8, (rn >> 6) * 4 + ((rn >> 4) & 3), T.Q8, T.K8, T.Vt8, T.O8, lds);
    }
}
#undef A8_WAIT_BAR
}
namespace pg8 {
struct SchedDense {
    int nM, nN, G, c;
    __device__ __forceinline__ bool next(int i, Unit& u) const {
        const int L = i * G + c; if (L >= nM * nN) return false;
        tile_of(L, nM, nN, u.pm, u.pn); u.arow = u.pm * BM; u.acol = 0; u.brow = u.pn * BM; u.x0 = 0; u.x1 = 0; u.x2 = 0; u.ord = i; u.brow2 = 0; u.ksplit = 0; return true; }
};
struct SchedOut {
    int G, c, E;
    __device__ __forceinline__ bool next(int i, Unit& u) const {
        u.acol = 0; u.x0 = 0; u.x1 = 0; u.x2 = 0; u.ord = i; u.brow2 = 0; u.ksplit = 0;
        if (E == 0) { const int L = i * G + c; if (L >= (MT / 256) * 4) return false; tile_of(L, MT / 256, 4, u.pm, u.pn); }
        else { const bool early = c >= G - E;
            if (early && i < 2) { const int e = c - (G - E), m = (e >> 3) + (E >> 3) * i; u.pm = 6 * (e & 7) + (m >> 2); u.pn = m & 3; }
            else { const int L = (early ? i - 2 : i) * G + c, nM = MT / 256 - E / 2; if (L >= nM * 4) return false; int pm_; tile_of(L, nM, 4, pm_, u.pn); u.pm = E / 2 + pm_; } }
        u.arow = u.pm * BM; u.brow = u.pn * BM; return true; }
};
__host__ __device__ __forceinline__ int in_gs(int g) { return g == 0 ? 0 : 1 + 27 * g; }
struct SchedIn {
    int G, c, E;
    __device__ __forceinline__ int cl() const { return E ? (c + E) % G : c; }
    __device__ __forceinline__ bool next(int i, Unit& u) const {
        u.acol = 0; u.x0 = 0; u.x1 = 0; u.x2 = 0; u.ord = i; u.brow2 = 0; u.ksplit = 0;
        if (E == 0) { const int L = i * G + c; if (L >= (MT / 256) * 8) return false; tile_of(L, MT / 256, 8, u.pm, u.pn); }
        else { const bool early = c >= G - E;
            if (early && i < 2) { const int e = c - (G - E), m = (e >> 3) + (E >> 3) * i, ep = 3 * (e & 7) + (m >> 3); u.pm = in_gs(ep % 5) + ep / 5; u.pn = m & 7; }
            else { const int L = (early ? i - 2 : i) * G + cl(); if (L >= 112 * 8) return false; int r; tile_of(L, 112, 8, r, u.pn);
                const int g = (r >= 23) + (r >= 45) + (r >= 67) + (r >= 89), base = g == 0 ? 0 : 1 + 22 * g;
                u.pm = in_gs(g) + (g < 4 ? 5 : 4) + (r - base); } }
        u.arow = u.pm * BM; u.brow = u.pn * BM; return true; }
};
struct SchedGates {
    int nM, G, c;
    __device__ __forceinline__ bool next(int i, Unit& u) const {
        const int L = i * G + c; if (L >= nM * 16) return false;
        tile_of(L, nM, 16, u.pm, u.pn); u.arow = u.pm * BM; u.acol = (u.pn >> 1) * 128; u.brow = u.pn * BM; u.x0 = 0; u.x1 = 0; u.x2 = 0; u.ord = i; u.brow2 = 0; u.ksplit = 0; return true; }
};
struct SchedQKV {
    int G, c;
    __device__ __forceinline__ bool next(int i, Unit& u) const {
        const int L = i * G + c; if (L >= 128 * 6 + 16) return false;
        if (L < 768) tile_of(L, 128, 6, u.pm, u.pn); else { const int j = L - 768; u.pm = 128 + (j >> 1); u.pn = 4 + (j & 1); }
        u.arow = u.pm * BM; u.acol = 0; u.brow = u.pn * BM; u.x0 = 0; u.x1 = 0; u.x2 = 0; u.ord = i; u.brow2 = 0; u.ksplit = 0; return true; }
};
template <bool UP>
struct SchedMoe {
    unsigned cnt[24]; int G, c, total;
    __device__ __forceinline__ void init(const unsigned* cw, int G_, int c_) {
        int acc = 0;
#pragma unroll
        for (int j = 0; j < 24; ++j) { cnt[j] = (unsigned)__builtin_amdgcn_readfirstlane((int)__hip_atomic_load(cw + j, __ATOMIC_RELAXED, __HIP_MEMORY_SCOPE_AGENT)); acc += (int)((cnt[j] + 255u) >> 8); }
        total = acc * (UP ? 8 : 4); G = G_; c = c_;
    }
    __device__ __forceinline__ bool next(int i, Unit& u) const {
        const int L = i * G + c; if (L >= total) return false;
        const int tl = UP ? (L >> 3) : (L >> 2), pn = UP ? (L & 7) : (L & 3); int gid = 0, base = 0, acc = 0; unsigned ce = cnt[0];
#pragma unroll
        for (int j = 0; j < 24; ++j) { const int tj = (int)((cnt[j] + 255u) >> 8); if (tl >= acc) { gid = j; base = acc; ce = cnt[j]; } acc += tj; }
        const int grp = gid / 6, pid = gid - 6 * grp, ea = 4 * grp + (pid < 3 ? 0 : pid < 5 ? 1 : 2), eb = 4 * grp + (pid < 3 ? pid + 1 : pid < 5 ? pid - 1 : 3);
        u.pm = tl; u.pn = pn; u.arow = tl * BM; u.acol = 0; u.x0 = gid; u.x2 = (tl - base) * BM; u.x1 = (int)ce - u.x2; u.ord = i;
        if (UP) { u.brow = (pn < 4 ? ea : eb) * 1024 + (pn & 3) * BM; u.brow2 = 0; u.ksplit = 0; }
        else { u.brow = ea * 1024 + pn * BM; u.brow2 = eb * 1024 + pn * BM; u.ksplit = 4; }
        return true;
    }
};

__device__ __forceinline__ unsigned pk4_fp8(float a, float b, float c, float d) { unsigned w = 0u; w = (unsigned)__builtin_amdgcn_cvt_pk_fp8_f32(a, b, (int)w, false); w = (unsigned)__builtin_amdgcn_cvt_pk_fp8_f32(c, d, (int)w, true); return w; }
constexpr float W8_SCALE = 32.0f, ACT8_SCALE = 4.0f, Y8_SCALE = 8.0f, BB8_SCALE = 16.0f, LA8_SCALE = 256.0f;
struct EpiInProj {
    static constexpr bool PERM = true;
    bf16_t* Gb; bf16_t* Ub;
    __device__ __forceinline__ void operator()(const f32x4 (&acc)[2][2][4][2], const Unit& u, int wr, int wc, int fr, int fq) const {
        const bool isg = u.pn < 4; bf16_t* base = isg ? Gb : Ub; const int colt = (isg ? u.pn : u.pn - 4) * BM + wc * 32 + 8 * fq;
#pragma unroll
        for (int ai = 0; ai < 2; ++ai)
#pragma unroll
            for (int m = 0; m < 4; ++m) { bf16_t* rowp = base + (size_t)(u.pm * BM + ai * HALF + wr * 64 + m * 16 + fr) * 1024 + colt;
#pragma unroll
                for (int bj = 0; bj < 2; ++bj) { f32x4 v0 = acc[ai][bj][m][0], v1 = acc[ai][bj][m][1];
                    if (isg) {
                        const f32x4 e0 = (v0 * v0 * (-2.302208198f * 0.044715f) + -2.302208198f) * v0, e1 = (v1 * v1 * (-2.302208198f * 0.044715f) + -2.302208198f) * v1;
                        const f32x4 d0 = (f32x4){__builtin_amdgcn_exp2f(e0[0]), __builtin_amdgcn_exp2f(e0[1]), __builtin_amdgcn_exp2f(e0[2]), __builtin_amdgcn_exp2f(e0[3])} + 1.0f;
                        const f32x4 d1 = (f32x4){__builtin_amdgcn_exp2f(e1[0]), __builtin_amdgcn_exp2f(e1[1]), __builtin_amdgcn_exp2f(e1[2]), __builtin_amdgcn_exp2f(e1[3])} + 1.0f;
                        v0 = v0 * (f32x4){__builtin_amdgcn_rcpf(d0[0]), __builtin_amdgcn_rcpf(d0[1]), __builtin_amdgcn_rcpf(d0[2]), __builtin_amdgcn_rcpf(d0[3])};
                        v1 = v1 * (f32x4){__builtin_amdgcn_rcpf(d1[0]), __builtin_amdgcn_rcpf(d1[1]), __builtin_amdgcn_rcpf(d1[2]), __builtin_amdgcn_rcpf(d1[3])}; }
                    u32x4 w; w.x = cvt_pk_bf16(v0[0], v0[1]); w.y = cvt_pk_bf16(v0[2], v0[3]); w.z = cvt_pk_bf16(v1[0], v1[1]); w.w = cvt_pk_bf16(v1[2], v1[3]);
                    *(u32x4*)(rowp + bj * HALF) = w; } }
    }
};
struct EpiGates {
    static constexpr bool PERM = true;
    const bf16_t* UC; unsigned char* LB[2]; const float* ga_b; const float* gx_b; const float* lam;
    __device__ __forceinline__ void operator()(const f32x4 (&acc)[2][2][4][2], const Unit& u, int wr, int wc, int fr, int fq) const {
        const int d = u.pn & 1, c0 = (u.pn >> 1) * 128 + wc * 32 + 8 * fq;
        typedef float f32x2 __attribute__((ext_vector_type(2)));
        f32x2 ba[4], bx[4], sp2[4];
#pragma unroll
        for (int j = 0; j < 8; ++j) { ba[j >> 1][j & 1] = -1.4426950408889634f * ga_b[d * 1024 + c0 + j]; bx[j >> 1][j & 1] = -1.4426950408889634f * gx_b[d * 1024 + c0 + j]; const float l = lam[d * 1024 + c0 + j];
            const float ex = __expf(-l); const float spv = (ex < 0.05f) ? ex * (1.0f - ex * (0.5f - ex * (0.33333334f - 0.25f * ex))) : __logf(1.0f + ex); const float sp = -8.0f * 1.4426950408889634f * spv;
            sp2[j >> 1][j & 1] = 2.0f * sp; }
        unsigned char* lb = d ? LB[1] : LB[0];
#pragma unroll
        for (int ai = 0; ai < 2; ++ai) {
            u32x4 uva[4];
#pragma unroll
            for (int m = 0; m < 4; ++m) uva[m] = *(const u32x4*)(UC + (size_t)(u.pm * BM + ai * HALF + wr * 64 + m * 16 + fr) * 1024 + c0);
            __builtin_amdgcn_sched_barrier(0);
#pragma unroll
            for (int m = 0; m < 4; ++m) { const size_t off = (size_t)(u.pm * BM + ai * HALF + wr * 64 + m * 16 + fr) * 1024 + c0;
                const u32x4 uv = uva[m];
                const f32x2 uu[4] = {{__builtin_bit_cast(float, uv.x << 16), __builtin_bit_cast(float, uv.x & 0xffff0000u)}, {__builtin_bit_cast(float, uv.y << 16), __builtin_bit_cast(float, uv.y & 0xffff0000u)},
                                     {__builtin_bit_cast(float, uv.z << 16), __builtin_bit_cast(float, uv.z & 0xffff0000u)}, {__builtin_bit_cast(float, uv.w << 16), __builtin_bit_cast(float, uv.w & 0xffff0000u)}};
                float l2[8], bt[8];
#pragma unroll
                for (int jp = 0; jp < 4; ++jp) { const f32x2 aa = {acc[ai][0][m][jp >> 1][2 * (jp & 1)], acc[ai][0][m][jp >> 1][2 * (jp & 1) + 1]}, ax = {acc[ai][1][m][jp >> 1][2 * (jp & 1)], acc[ai][1][m][jp >> 1][2 * (jp & 1) + 1]};
                    const f32x2 za = aa + ba[jp], zx = ax + bx[jp];
                    const f32x2 da = (f32x2){__builtin_amdgcn_exp2f(za.x), __builtin_amdgcn_exp2f(za.y)} + 1.0f, q = (f32x2){__builtin_amdgcn_exp2f(zx.x), __builtin_amdgcn_exp2f(zx.y)} + 1.0f;
                    const f32x2 r = {__builtin_amdgcn_rcpf(da.x), __builtin_amdgcn_rcpf(da.y)};
                    const f32x2 t2 = sp2[jp] * r, lq = t2 * (0.5f * LA8_SCALE);
                    const f32x2 a2 = {__builtin_amdgcn_exp2f(t2.x), __builtin_amdgcn_exp2f(t2.y)};
                    f32x2 w = a2 * -(BB8_SCALE * BB8_SCALE) + (BB8_SCALE * BB8_SCALE); w.x = fmaxf(w.x, 1e-30f); w.y = fmaxf(w.y, 1e-30f);
                    const f32x2 ag = w * (q * q); const f32x2 bv = (w * (f32x2){__builtin_amdgcn_rsqf(ag.x), __builtin_amdgcn_rsqf(ag.y)}) * uu[jp];
                    l2[2 * jp] = lq.x; l2[2 * jp + 1] = lq.y; bt[2 * jp] = __builtin_amdgcn_fmed3f(bv.x, -440.f, 440.f); bt[2 * jp + 1] = __builtin_amdgcn_fmed3f(bv.y, -440.f, 440.f); }
                u32x4 w; w.x = pk4_fp8(l2[0], bt[0], l2[1], bt[1]); w.y = pk4_fp8(l2[2], bt[2], l2[3], bt[3]); w.z = pk4_fp8(l2[4], bt[4], l2[5], bt[5]); w.w = pk4_fp8(l2[6], bt[6], l2[7], bt[7]);
                *(u32x4*)(lb + 2 * off) = w; } }
    }
};
template <bool BASE_BF16>
struct EpiResid {
    static constexpr bool PERM = true;
    const float* baseL; const float* baseC; bf16_t* XB; const float* gate; float ascale;
    __device__ __forceinline__ void operator()(const f32x4 (&acc)[2][2][4][2], const Unit& u, int wr, int wc, int fr, int fq) const {
        const int row0 = u.pm * BM; const bool isl = row0 < ML;
        const float* bs = isl ? baseL + (size_t)row0 * 1024 : baseC + (size_t)(row0 - ML) * 1024; bf16_t* os = XB + (size_t)row0 * 1024;
        const float* gv = gate + (isl ? (row0 >> 12) : 8) * 6144; const int col0 = u.pn * BM + wc * 32 + 8 * fq;
        f32x4 gg[2][2];
#pragma unroll
        for (int bj = 0; bj < 2; ++bj)
#pragma unroll
            for (int n = 0; n < 2; ++n) gg[bj][n] = *(const f32x4*)(gv + col0 + bj * HALF + n * 4) * ascale;
        constexpr int MB = BASE_BF16 ? 4 : 2;
#pragma unroll
        for (int ai = 0; ai < 2; ++ai)
#pragma unroll
            for (int m0 = 0; m0 < 4; m0 += MB) {
                u32x4 wb[MB][2]; f32x4 fb[MB][2][2];
#pragma unroll
                for (int mi = 0; mi < MB; ++mi) { const size_t off = (size_t)(ai * HALF + wr * 64 + (m0 + mi) * 16 + fr) * 1024 + col0;
#pragma unroll
                    for (int bj = 0; bj < 2; ++bj) {
                        if (BASE_BF16) wb[mi][bj] = *(const u32x4*)(os + off + bj * HALF);
                        else { fb[mi][bj][0] = *(const f32x4*)(bs + off + bj * HALF); fb[mi][bj][1] = *(const f32x4*)(bs + off + bj * HALF + 4); } } }
                __builtin_amdgcn_sched_barrier(0);
#pragma unroll
                for (int mi = 0; mi < MB; ++mi) { const int m = m0 + mi; const size_t off = (size_t)(ai * HALF + wr * 64 + m * 16 + fr) * 1024 + col0;
#pragma unroll
                    for (int bj = 0; bj < 2; ++bj) { f32x4 b0, b1;
                        if (BASE_BF16) { const u32x4 w = wb[mi][bj];
                            b0 = (f32x4){__builtin_bit_cast(float, w.x << 16), __builtin_bit_cast(float, w.x & 0xffff0000u), __builtin_bit_cast(float, w.y << 16), __builtin_bit_cast(float, w.y & 0xffff0000u)};
                            b1 = (f32x4){__builtin_bit_cast(float, w.z << 16), __builtin_bit_cast(float, w.z & 0xffff0000u), __builtin_bit_cast(float, w.w << 16), __builtin_bit_cast(float, w.w & 0xffff0000u)}; }
                        else { b0 = fb[mi][bj][0]; b1 = fb[mi][bj][1]; }
                        const f32x4 v0 = b0 + gg[bj][0] * acc[ai][bj][m][0], v1 = b1 + gg[bj][1] * acc[ai][bj][m][1];
                        u32x4 o; o.x = cvt_pk_bf16(v0[0], v0[1]); o.y = cvt_pk_bf16(v0[2], v0[3]); o.z = cvt_pk_bf16(v1[0], v1[1]); o.w = cvt_pk_bf16(v1[2], v1[3]);
                        *(u32x4*)(os + off + bj * HALF) = o; } }
                __builtin_amdgcn_sched_barrier(0); }
    }
};
struct EpiNull { static constexpr bool PERM = true;
    __device__ __forceinline__ void operator()(const f32x4 (&acc)[2][2][4][2], const Unit& u, int wr, int wc, int fr, int fq) const { } };
template <bool WT = false>
struct EpiMoe1 {
    static constexpr bool PERM = true;
    unsigned char* ACT; const PG8_LAS float* tabw;
    __device__ __forceinline__ void operator()(const f32x4 (&acc)[2][2][4][2], const Unit& u, int wr, int wc, int fr, int fq) const {
        const int colt = u.pn * 128 + wc * 32 + 8 * fq;
#pragma unroll
        for (int ai = 0; ai < 2; ++ai)
#pragma unroll
            for (int m = 0; m < 4; ++m) { const int rl = ai * HALF + wr * 64 + m * 16 + fr; unsigned char* rowp = ACT + (size_t)(u.pm * BM + rl) * 1024 + colt; float o[8];
                typedef float f32x2 __attribute__((ext_vector_type(2)));
                const float gw = tabw[u.ord * 256 + rl] * (ACT8_SCALE / (W8_SCALE * W8_SCALE));
#pragma unroll
                for (int jp = 0; jp < 4; ++jp) { const f32x2 a1 = {acc[ai][0][m][jp >> 1][2 * (jp & 1)], acc[ai][0][m][jp >> 1][2 * (jp & 1) + 1]}, a3 = {acc[ai][1][m][jp >> 1][2 * (jp & 1)], acc[ai][1][m][jp >> 1][2 * (jp & 1) + 1]};
                    const f32x2 x = a1 * (-1.4426950408889634f / W8_SCALE); const f32x2 d = (f32x2){__builtin_amdgcn_exp2f(x.x), __builtin_amdgcn_exp2f(x.y)} + 1.0f;
                    const f32x2 sg = (f32x2){__builtin_amdgcn_rcpf(d.x), __builtin_amdgcn_rcpf(d.y)} * gw; const f32x2 v = (a1 * a3) * sg;
                    o[2 * jp] = __builtin_amdgcn_fmed3f(v.x, -440.f, 440.f); o[2 * jp + 1] = __builtin_amdgcn_fmed3f(v.y, -440.f, 440.f); }
                typedef unsigned u32x2 __attribute__((ext_vector_type(2)));
                u32x2 w; w.x = pk4_fp8(o[0], o[1], o[2], o[3]); w.y = pk4_fp8(o[4], o[5], o[6], o[7]);
                if (WT) __hip_atomic_store((__attribute__((address_space(1))) unsigned long long*)rowp, ((unsigned long long)w.y << 32) | (unsigned long long)w.x, __ATOMIC_RELAXED, __HIP_MEMORY_SCOPE_AGENT);
                else *(u32x2*)rowp = w; }
    }
};
template <bool FINAL>
struct EpiMoe2 {
    static constexpr bool PERM = true;
    bf16_t* XB; float* out; const float* gfm; const PG8_LAS int* tab;
    __device__ __forceinline__ void operator()(const f32x4 (&acc)[2][2][4][2], const Unit& u, int wr, int wc, int fr, int fq) const {
        const int col0 = u.pn * BM + wc * 32 + 8 * fq; constexpr float sc = 1.0f / (W8_SCALE * ACT8_SCALE);
#pragma unroll
        for (int ai = 0; ai < 2; ++ai)
#pragma unroll
            for (int m0 = 0; m0 < 4; m0 += 2) {
                int tk[2]; u32x4 xw[2][2]; f32x4 gq[2][2][2];
#pragma unroll
                for (int mi = 0; mi < 2; ++mi) { const int t_ = tab[u.ord * 256 + ai * HALF + wr * 64 + (m0 + mi) * 16 + fr]; tk[mi] = t_; const int tok = t_ < 0 ? 0 : t_;
                    const float* gv = gfm + (tok < ML ? (tok >> 12) : 8) * 6144 + col0; const bf16_t* xp = XB + (size_t)tok * 1024 + col0;
#pragma unroll
                    for (int bj = 0; bj < 2; ++bj) { xw[mi][bj] = *(const u32x4*)(xp + bj * HALF); gq[mi][bj][0] = *(const f32x4*)(gv + bj * HALF); gq[mi][bj][1] = *(const f32x4*)(gv + bj * HALF + 4); } }
                __builtin_amdgcn_sched_barrier(0);
#pragma unroll
                for (int mi = 0; mi < 2; ++mi) { const int m = m0 + mi, tok = tk[mi];
                    if (tok >= 0) { bf16_t* xp = XB + (size_t)tok * 1024 + col0;
#pragma unroll
                        for (int bj = 0; bj < 2; ++bj) { const f32x4 g0 = gq[mi][bj][0] * sc, g1 = gq[mi][bj][1] * sc; const u32x4 w = xw[mi][bj];
                            const f32x4 b0 = {__builtin_bit_cast(float, w.x << 16), __builtin_bit_cast(float, w.x & 0xffff0000u), __builtin_bit_cast(float, w.y << 16), __builtin_bit_cast(float, w.y & 0xffff0000u)};
                            const f32x4 b1 = {__builtin_bit_cast(float, w.z << 16), __builtin_bit_cast(float, w.z & 0xffff0000u), __builtin_bit_cast(float, w.w << 16), __builtin_bit_cast(float, w.w & 0xffff0000u)};
                            const f32x4 v0 = b0 + g0 * acc[ai][bj][m][0], v1 = b1 + g1 * acc[ai][bj][m][1];
                            if (FINAL) { float* op = out + (size_t)tok * 1024 + col0 + bj * HALF; *(f32x4*)op = v0; *(f32x4*)(op + 4) = v1; }
                            else { u32x4 o; o.x = cvt_pk_bf16(v0[0], v0[1]); o.y = cvt_pk_bf16(v0[2], v0[3]); o.z = cvt_pk_bf16(v1[0], v1[1]); o.w = cvt_pk_bf16(v1[2], v1[3]); *(u32x4*)(xp + bj * HALF) = o; } } } }
                __builtin_amdgcn_sched_barrier(0); }
    }
};
struct EpiQKV {
    static constexpr bool PERM = true;
    unsigned char* Q; unsigned char* Kb; unsigned char* Vt; const float* qn; const float* kn; const PG8_LAS float* rope;
    __device__ __forceinline__ void operator()(const f32x4 (&acc)[2][2][4][2], const Unit& u, int wr, int wc, int fr, int fq) const {
        typedef unsigned u32x2 __attribute__((ext_vector_type(2)));
        const int row0 = u.pm * BM; const bool isl = row0 < ML;
        if (u.pn == 5) {
#pragma unroll
            for (int ai = 0; ai < 2; ++ai)
#pragma unroll
                for (int m = 0; m < 4; ++m) { const int row = row0 + ai * HALF + wr * 64 + m * 16 + fr;
                    const int b = isl ? (row >> 12) : ((row - ML) >> 8), key = isl ? CTXL + (row & 4095) : ((row - ML) & 255);
                    unsigned char* base = Vt + (size_t)b * 4 * 64 * KVL + (size_t)(key >> 6) * 64 + attn8::vpos(key & 63);
#pragma unroll
                    for (int bj = 0; bj < 2; ++bj)
#pragma unroll
                        for (int n = 0; n < 2; ++n)
#pragma unroll
                            for (int j = 0; j < 4; ++j) { const int col = bj * HALF + wc * 32 + 8 * fq + 4 * n + j; const float v = acc[ai][bj][m][n][j] * (attn8::VS / W8_SCALE);
                                base[(size_t)col * KVL] = (unsigned char)__builtin_amdgcn_cvt_pk_fp8_f32(v, v, 0, false); } }
            return;
        }
        const bool isq = u.pn < 4; const float* nw = isq ? qn : kn; const float sc = isq ? attn8::QS : attn8::KS;
        f32x4 w1[2], w2[2];
#pragma unroll
        for (int bj = 0; bj < 2; ++bj) { w1[bj] = *(const f32x4*)(nw + 32 * bj + 4 * fq); w2[bj] = *(const f32x4*)(nw + 32 * bj + 16 + 4 * fq); }
#pragma unroll
        for (int ai = 0; ai < 2; ++ai)
#pragma unroll
            for (int m = 0; m < 4; ++m) { const int row = row0 + ai * HALF + wr * 64 + m * 16 + fr;
                f32x4 a1[2], a2[2]; float ss = 0.f;
#pragma unroll
                for (int bj = 0; bj < 2; ++bj) { a1[bj] = acc[ai][bj][m][0] * (1.0f / W8_SCALE); a2[bj] = acc[ai][bj][m][1] * (1.0f / W8_SCALE);
                    ss += (a1[bj][0] * a1[bj][0] + a1[bj][1] * a1[bj][1]) + (a1[bj][2] * a1[bj][2] + a1[bj][3] * a1[bj][3]) + (a2[bj][0] * a2[bj][0] + a2[bj][1] * a2[bj][1]) + (a2[bj][2] * a2[bj][2] + a2[bj][3] * a2[bj][3]); }
                ss += __shfl_xor(ss, 16); ss += __shfl_xor(ss, 32);
                const float rstd = __builtin_amdgcn_rsqf(ss * (1.0f / 64.0f) + EPS) * sc;
                int dest;
                if (isl) { const int t = row & 4095; const int pos[2] = {t >> 6, t & 63};
#pragma unroll
                    for (int bj = 0; bj < 2; ++bj) { const f32x4 cs = *(const PG8_LAS f32x4*)(rope + pos[bj] * 16 + 4 * fq), sn = *(const PG8_LAS f32x4*)(rope + 1024 + pos[bj] * 16 + 4 * fq);
                        const f32x4 y1 = a1[bj] * w1[bj] * rstd, y2 = a2[bj] * w2[bj] * rstd;
                        a1[bj] = y1 * cs - y2 * sn; a2[bj] = y2 * cs + y1 * sn; }
                    dest = isq ? row : (row >> 12) * KVL + CTXL + t;
                } else {
#pragma unroll
                    for (int bj = 0; bj < 2; ++bj) { a1[bj] = a1[bj] * w1[bj] * rstd; a2[bj] = a2[bj] * w2[bj] * rstd; }
                    dest = ((row - ML) >> 8) * KVL + ((row - ML) & 255);
                }
                unsigned char* rowp = isq ? Q + (size_t)dest * 1024 + (u.pn * 4 + wc) * 64 + 8 * fq : Kb + (size_t)dest * 256 + wc * 64 + 8 * fq;
#pragma unroll
                for (int bj = 0; bj < 2; ++bj) { u32x2 w; w.x = pk4_fp8(a1[bj][0], a1[bj][1], a1[bj][2], a1[bj][3]); w.y = pk4_fp8(a2[bj][0], a2[bj][1], a2[bj][2], a2[bj][3]);
                    *(u32x2*)(rowp + bj * 32) = w; } }
    }
};
}
struct Frame {
    LAS unsigned char* lds;
    volatile LAS unsigned* MISC;
    gu32* ctl;
    int tid, lane, wave, vcu, G;
    unsigned char* ws; float* out;
    const float* in[26];
};
enum { I_X = 0, I_C, I_CTX, I_CCTX, I_ADAW, I_ADAB, I_NMIX, I_NFFN, I_LIN, I_LCW, I_LCB, I_GAW, I_GAB, I_GXW, I_GXB, I_LAM, I_LOUT, I_QKV, I_QN, I_KN, I_OW, I_RW, I_RB, I_W1, I_W3, I_W2 };

__device__ __forceinline__ float wave_sum(float v) {
#pragma unroll
    for (int o = 1; o < 64; o <<= 1) v += __shfl_xor(v, o);
    return v;
}
__device__ __forceinline__ int dl_perm(int s) { return 4 * (s >> 3) + (s & 3) + ((s & 4) ? 16 : 0); }

template <bool F8 = false>
__device__ __forceinline__ void tr_item(const float* src, int ldn, int k0, int scol0, void* dstv, int ldk, int drow0, bool rp, LAS float* scr, int lane, float sc = 1.0f) {
    float tv[32];
#pragma unroll
    for (int i = 0; i < 32; ++i) { const int kk = 2 * i + (lane >> 5); tv[i] = __builtin_nontemporal_load(src + (size_t)(k0 + kk) * ldn + scol0 + (lane & 31)); }
#pragma unroll
    for (int i = 0; i < 32; ++i) { const int kk = 2 * i + (lane >> 5); scr[kk * 33 + (lane & 31)] = tv[i]; }
    LDS_WAIT(); asm volatile("" ::: "memory");
    const int c = lane & 7;
#pragma unroll
    for (int j = 0; j < 4; ++j) { const int n = (lane >> 3) + 8 * j; const int sn = rp ? dl_perm(n) : n; const LAS float* s = scr + (8 * c) * 33 + sn;
        if constexpr (F8) { v2u o; o.x = pg8::pk4_fp8(32.0f * s[0 * 33], 32.0f * s[1 * 33], 32.0f * s[2 * 33], 32.0f * s[3 * 33]); o.y = pg8::pk4_fp8(32.0f * s[4 * 33], 32.0f * s[5 * 33], 32.0f * s[6 * 33], 32.0f * s[7 * 33]);
            *(GAS v2u*)((unsigned char*)dstv + (size_t)(drow0 + n) * ldk + k0 + 8 * c) = o; }
        else { bf16* dst = (bf16*)dstv; v4u o; o.x = pk2(sc * s[0 * 33], sc * s[1 * 33]); o.y = pk2(sc * s[2 * 33], sc * s[3 * 33]); o.z = pk2(sc * s[4 * 33], sc * s[5 * 33]); o.w = pk2(sc * s[6 * 33], sc * s[7 * 33]);
            *(GAS v4u*)(dst + (size_t)(drow0 + n) * ldk + k0 + 8 * c) = o; } }
    LDS_WAIT(); asm volatile("" ::: "memory");
}

constexpr int CV_IN = 1024, CV_G = 256, CV_OUT = 512, CV_13 = 8192, CV_2 = 4096, CV_QKV = 768, CV_O = 512;
constexpr int CV_A_END = CV_IN + CV_G + CV_OUT, CV_B_END = CV_A_END + CV_13 + CV_2, CV_END = CV_B_END + CV_QKV + CV_O + CV_13 + CV_2;
__device__ __forceinline__ void conv_items(Frame& F, int lo, int hi, int gwi, int nwg) {
    LAS float* scr = (LAS float*)(F.lds + RING_OFF + 59392 + F.wave * 8704);
    for (int it = lo + gwi; it < hi; it += nwg) {
        int r = it;
        if (r < CV_IN) { const int g = r >> 4, kb = r & 15; tr_item(F.in[I_LIN], 2048, kb * 64, g * 32, (bf16*)(F.ws + WS_W_IN), 1024, g * 32, false, scr, F.lane); continue; } r -= CV_IN;
        if (r < CV_G) { const int un = r >> 4, rem = r & 15, grp = rem >> 1, kb = rem & 1, n = un >> 1, d = un & 1;
            const float* src = (grp < 4 ? F.in[I_GAW] : F.in[I_GXW]) + (size_t)(d * 8 + n) * 16384;
            tr_item(src, 128, kb * 64, (grp & 3) * 32, (bf16*)(F.ws + WS_W_G), 128, un * 256 + grp * 32, false, scr, F.lane, -1.4426950408889634f); continue; } r -= CV_G;
        if (r < CV_OUT) { const int g = r >> 4, kb = r & 15; tr_item(F.in[I_LOUT], 1024, kb * 64, g * 32, (bf16*)(F.ws + WS_W_OUT), 1024, g * 32, false, scr, F.lane); continue; } r -= CV_OUT;
        int layer = 0;
        if (r >= CV_13 + CV_2) { r -= CV_13 + CV_2;
            if (r < CV_QKV) { const int g = r >> 4, kb = r & 15, pn = g >> 3, gi = g & 7; const bool rp = pn < 5;
                const int scol0 = rp ? pn * 256 + (gi & 3) * 64 + (gi >> 2) * 32 : 1280 + gi * 32;
                tr_item<true>(F.in[I_QKV], 1536, kb * 64, scol0, F.ws + WS_W_QKV, 1024, g * 32, rp, scr, F.lane); continue; } r -= CV_QKV;
            if (r < CV_O) { const int g = r >> 4, kb = r & 15; tr_item<true>(F.in[I_OW], 1024, kb * 64, g * 32, F.ws + WS_W_O, 1024, g * 32, false, scr, F.lane); continue; } r -= CV_O;
            layer = 1; }
        if (r < CV_13) { const int le = layer * 16 + (r >> 9), rem = r & 511, g = rem >> 4, kb = rem & 15, pn = g >> 3, gi = g & 7, bj = gi >> 2, sub = gi & 3;
            const float* src = (bj ? F.in[I_W3] : F.in[I_W1]) + (size_t)le * 1024 * 512;
            tr_item<true>(src, 512, kb * 64, pn * 128 + sub * 32, F.ws + WS_W13 + (size_t)le * 1024 * 1024, 1024, g * 32, false, scr, F.lane); continue; } r -= CV_13;
        { const int le = layer * 16 + (r >> 8), rem = r & 255, g = rem >> 3, kb = rem & 7;
            tr_item<true>(F.in[I_W2] + (size_t)le * 512 * 1024, 1024, kb * 64, g * 32, F.ws + WS_W2 + (size_t)le * 1024 * 512, 512, g * 32, false, scr, F.lane); }
    }
}
__device__ __forceinline__ void conv_tail(Frame& F, int b0, int lo, int hi, int me = -1) {
    if (me < 0) me = (int)blockIdx.x;
    if (b0 >= F.G) b0 = 0;
    if (me >= b0) conv_items(F, lo, hi, (me - b0) * NWAVES + F.wave, (F.G - b0) * NWAVES);
}
constexpr int CV_T10 = 3800, CV_T11 = 2200, CV_T13 = 5600, CV_T8C = 3000;

__device__ __forceinline__ void p0_prologue(Frame& F) {
    LAS float* scond = (LAS float*)(F.lds + RING_OFF);
    LAS float* red = (LAS float*)(F.lds + RING_OFF + 40960);
    float* mod = (float*)(F.ws + WS_MOD);
    bool did = false;
    for (int unit = blockIdx.x; unit < 192; unit += F.G) {
        if (!did) { for (int idx = F.tid; idx < 9 * 1024; idx += NWAVES * 64) { const int r = idx >> 10, k = idx & 1023; const float v = r < 8 ? F.in[I_C][r * 1024 + k] : F.in[I_CCTX][k]; scond[idx] = v * sigmoid_f(v); }
            __syncthreads(); did = true; }
        const int l = unit / 96, cg = unit % 96;
        const int ks = F.lane >> 4, cq = F.lane & 15;
        f32x4 acc[9];
#pragma unroll
        for (int r = 0; r < 9; ++r) acc[r] = (f32x4){0.f, 0.f, 0.f, 0.f};
        const float* wp = F.in[I_ADAW] + ((size_t)l * 1024 + F.wave * 128 + ks) * 6144 + cg * 64 + cq * 4;
#pragma unroll 1
        for (int k0 = 0; k0 < 32; k0 += 8) { f32x4 wv[8];
#pragma unroll
            for (int i = 0; i < 8; ++i) wv[i] = __builtin_nontemporal_load((const f32x4*)(wp + (size_t)(k0 + i) * 4 * 6144));
#pragma unroll
            for (int i = 0; i < 8; ++i) { const int k = F.wave * 128 + (k0 + i) * 4 + ks;
#pragma unroll
                for (int r = 0; r < 9; ++r) acc[r] += scond[r * 1024 + k] * wv[i]; } }
#pragma unroll
        for (int r = 0; r < 9; ++r) *(LAS f32x4*)(red + ((F.wave * 4 + ks) * 9 + r) * 64 + cq * 4) = acc[r];
        __syncthreads();
        for (int idx = F.tid; idx < 576; idx += NWAVES * 64) { const int r = idx >> 6, ln = idx & 63; float s = F.in[I_ADAB][l * 6144 + cg * 64 + ln];
#pragma unroll 8
            for (int w = 0; w < 32; ++w) s += red[(w * 9 + r) * 64 + ln];
            mod[(size_t)(l * 9 + r) * 6144 + cg * 64 + ln] = s; }
        __syncthreads();
    }
    __syncthreads();
    { const int rb0 = F.G >= 194 ? 192 : 0; const int gt = ((int)blockIdx.x - rb0) * (NWAVES * 64) + F.tid; if (gt >= 0 && gt < 1024) { const int pos = gt >> 4, i = gt & 15;
        double th = 1.0; for (int k = 0; k < i; ++k) th *= 0.56234132519034908;
        const double t2 = th * th; double sn = th, cs = 1.0, ts = th, tc = 1.0;
        for (int k = 1; k <= 12; ++k) { tc *= -t2 * (1.0 / (double)((2 * k - 1) * (2 * k))); cs += tc; ts *= -t2 * (1.0 / (double)((2 * k) * (2 * k + 1))); sn += ts; }
        double c = 1.0, s2 = 0.0; for (int k = 0; k < pos; ++k) { const double cn = c * cs - s2 * sn; s2 = s2 * cs + c * sn; c = cn; }
        float* rp = (float*)(F.ws + WS_ROPE); rp[gt] = (float)c; rp[1024 + gt] = (float)s2; } }
    conv_items(F, 0, CV_A_END, F.vcu * NWAVES + F.wave, F.G * NWAVES);
    conv_items(F, CV_B_END + CV_T10 + CV_T11 + CV_T13, CV_END, F.vcu * NWAVES + F.wave, F.G * NWAVES);
}

struct RowVec { f32x4 v[4]; };
__device__ __forceinline__ void load_modvec(Frame& F, int l, int mrow, int chunk_shift, const float* nw, RowVec& gsc, RowVec& sh) {
    const float* mod = (const float*)(F.ws + WS_MOD) + (size_t)(l * 9 + mrow) * 6144;
#pragma unroll
    for (int j = 0; j < 4; ++j) { const int col = 4 * F.lane + 256 * j; const f32x4 w = *(const f32x4*)(nw + col), sc = *(const f32x4*)(mod + (chunk_shift + 1) * 1024 + col);
        gsc.v[j] = w * (1.0f + sc); sh.v[j] = *(const f32x4*)(mod + chunk_shift * 1024 + col); }
}
__device__ __forceinline__ void store_bf16_row(bf16* dst, int lane, const RowVec& h) {
#pragma unroll
    for (int j = 0; j < 4; ++j) { v2u o; o.x = pk2(h.v[j][0], h.v[j][1]); o.y = pk2(h.v[j][2], h.v[j][3]); *(GAS v2u*)(dst + 4 * lane + 256 * j) = o; }
}
__device__ __forceinline__ void rms_mod(const RowVec& x, const RowVec& gsc, const RowVec& sh, RowVec& h) {
    float ss = 0.f;
#pragma unroll
    for (int j = 0; j < 4; ++j) ss += (x.v[j][0] * x.v[j][0] + x.v[j][1] * x.v[j][1]) + (x.v[j][2] * x.v[j][2] + x.v[j][3] * x.v[j][3]);
    ss = wave_sum(ss);
    const float rstd = 1.0f / sqrtf(ss * (1.0f / 1024.0f) + EPS);
#pragma unroll
    for (int j = 0; j < 4; ++j) h.v[j] = x.v[j] * rstd * gsc.v[j] + sh.v[j];
}

__device__ __forceinline__ void load_xrow(const float* xL, const float* xC, int row, int lane, RowVec& x) {
    const float* src = row < ML ? xL + (size_t)row * 1024 : xC + (size_t)(row - ML) * 1024;
#pragma unroll
    for (int j = 0; j < 4; ++j) x.v[j] = __builtin_nontemporal_load((const f32x4*)(src + 4 * lane + 256 * j));
}
__device__ __forceinline__ void load_xrow_bf(const bf16* XB, int row, int lane, RowVec& x) {
    const bf16* src = XB + (size_t)row * 1024;
#pragma unroll
    for (int j = 0; j < 4; ++j) { const v2u w = *(const GAS v2u*)(src + 4 * lane + 256 * j); x.v[j] = (f32x4){bflo(w.x), bfhi(w.x), bflo(w.y), bfhi(w.y)}; }
}
__device__ __forceinline__ void rows_modulate(Frame& F, const float* xL, const float* xC, int nrows, int l, int chunk_shift, const float* nw) {
    const int gwv = blockIdx.x * NWAVES + F.wave, NGW = F.G * NWAVES;
    const int r0 = (int)((long)gwv * nrows / NGW), r1 = (int)((long)(gwv + 1) * nrows / NGW);
    bf16* XN = (bf16*)(F.ws + WS_XN);
    int curb = -1; RowVec gsc, sh, xn;
    if (r0 < r1) load_xrow(xL, xC, r0, F.lane, xn);
    for (int row = r0; row < r1; ++row) {
        const int mrow = row < ML ? (row >> 12) : 8;
        if (mrow != curb) { load_modvec(F, l, mrow, chunk_shift, nw, gsc, sh); curb = mrow; }
        RowVec x = xn, h;
        if (row + 1 < r1) load_xrow(xL, xC, row + 1, F.lane, xn);
        rms_mod(x, gsc, sh, h);
        store_bf16_row(XN + (size_t)row * 1024, F.lane, h);
    }
}

__device__ __forceinline__ void rows_modulate_ho(Frame& F, const float* xL, const float* xC, int l, int chunk_shift, const float* nw, int nprod, bool fast, unsigned* hcnt) {
    const int w = blockIdx.x * NWAVES + F.wave, W = nprod * NWAVES;
    bf16* XN = (bf16*)(F.ws + WS_XN);
    int r, rstep, rend;
    if (fast) { const int g = w >> 8; r = pg8::in_gs(g) * 256 + (w & 255); rstep = 256; rend = pg8::in_gs(g + 1) * 256; } else { r = w; rstep = W; rend = MT; }
    int curb = -1, pp1 = -1, pp2 = -1; RowVec gsc, sh, xn;
    if (r < rend) load_xrow(xL, xC, r, F.lane, xn);
    for (; r < rend; r += rstep) {
        const int mrow = r < ML ? (r >> 12) : 8;
        if (mrow != curb) { load_modvec(F, l, mrow, chunk_shift, nw, gsc, sh); curb = mrow; }
        RowVec x = xn, h;
        if (r + rstep < rend) load_xrow(xL, xC, r + rstep, F.lane, xn);
        rms_mod(x, gsc, sh, h);
        asm volatile("" ::: "memory");
        if (pp2 >= 0 && F.lane == 0) pg8::ho_publish(hcnt, pp2);
        bf16* dst = XN + (size_t)r * 1024;
#pragma unroll
        for (int j = 0; j < 4; ++j) { const unsigned lo = pk2(h.v[j][0], h.v[j][1]), hi = pk2(h.v[j][2], h.v[j][3]);
            __hip_atomic_store((GAS unsigned long long*)(dst + 4 * F.lane + 256 * j), ((unsigned long long)hi << 32) | (unsigned long long)lo, __ATOMIC_RELAXED, __HIP_MEMORY_SCOPE_AGENT); }
        pp2 = pp1; pp1 = r >> 8;
    }
    asm volatile("s_waitcnt vmcnt(0)" ::: "memory");
    if (F.lane == 0) { if (pp2 >= 0) pg8::ho_publish(hcnt, pp2); if (pp1 >= 0) pg8::ho_publish(hcnt, pp1); }
}

__device__ __forceinline__ void route_topk(const float (&lg)[16], int& e0, int& e1, float& w0, float& w1);
__device__ __forceinline__ void route_row(const RowVec& h, const LAS float* rw, const float* rb, int lane, int& e0, int& e1, float& w0, float& w1) {
    f32x2 acc2[8];
#pragma unroll
    for (int e = 0; e < 8; ++e) acc2[e] = (f32x2){0.f, 0.f};
#pragma unroll
    for (int j = 0; j < 4; ++j)
#pragma unroll
        for (int i = 0; i < 4; ++i) { const int k = 4 * lane + 256 * j + i; const f32x2 hv2 = {h.v[j][i], h.v[j][i]}; const LAS f32x4* wr = (const LAS f32x4*)(rw + k * 16 + (k >> 2) * 4);
#pragma unroll
            for (int q = 0; q < 4; ++q) { const f32x4 w = wr[q]; acc2[2 * q] = acc2[2 * q] + hv2 * (f32x2){w[0], w[1]}; acc2[2 * q + 1] = acc2[2 * q + 1] + hv2 * (f32x2){w[2], w[3]}; } }
    float acc[16];
#pragma unroll
    for (int e = 0; e < 8; ++e) { acc[2 * e] = acc2[e][0]; acc[2 * e + 1] = acc2[e][1]; }
    float r8[8], r4[4], r2[2], r1v;
    { const bool hi = (lane & 32) != 0;
#pragma unroll
      for (int i = 0; i < 8; ++i) { const float send = hi ? acc[i] : acc[8 + i], keep = hi ? acc[8 + i] : acc[i]; r8[i] = keep + __shfl_xor(send, 32); } }
    { const bool hi = (lane & 16) != 0;
#pragma unroll
      for (int i = 0; i < 4; ++i) { const float send = hi ? r8[i] : r8[4 + i], keep = hi ? r8[4 + i] : r8[i]; r4[i] = keep + __shfl_xor(send, 16); } }
    { const bool hi = (lane & 8) != 0;
#pragma unroll
      for (int i = 0; i < 2; ++i) { const float send = hi ? r4[i] : r4[2 + i], keep = hi ? r4[2 + i] : r4[i]; r2[i] = keep + __shfl_xor(send, 8); } }
    { const bool hi = (lane & 4) != 0; const float send = hi ? r2[0] : r2[1], keep = hi ? r2[1] : r2[0]; r1v = keep + __shfl_xor(send, 4); }
    r1v += __shfl_xor(r1v, 2); r1v += __shfl_xor(r1v, 1);
    float lg[16];
#pragma unroll
    for (int e = 0; e < 16; ++e) lg[e] = __builtin_bit_cast(float, __builtin_amdgcn_readlane(__builtin_bit_cast(int, r1v), 4 * e)) + rb[e];
    route_topk(lg, e0, e1, w0, w1);
}
__device__ __forceinline__ void route_topk(const float (&lg)[16], int& e0, int& e1, float& w0, float& w1) {
    float mx = lg[0];
#pragma unroll
    for (int e = 1; e < 16; ++e) mx = fmaxf(mx, lg[e]);
    float p[16];
#pragma unroll
    for (int e = 0; e < 16; ++e) p[e] = __expf(lg[e] - mx);
    float gs[4];
#pragma unroll
    for (int g = 0; g < 4; ++g) { const float a = fmaxf(p[4 * g], p[4 * g + 1]), b = fminf(p[4 * g], p[4 * g + 1]), c = fmaxf(p[4 * g + 2], p[4 * g + 3]), d = fminf(p[4 * g + 2], p[4 * g + 3]);
        gs[g] = fmaxf(a, c) + fmaxf(fminf(a, c), fmaxf(b, d)); }
    int sel = 0; float best = gs[0];
#pragma unroll
    for (int g = 1; g < 4; ++g) if (gs[g] > best) { best = gs[g]; sel = g; }
    float q[4];
#pragma unroll
    for (int i = 0; i < 4; ++i) q[i] = sel == 0 ? p[i] : sel == 1 ? p[4 + i] : sel == 2 ? p[8 + i] : p[12 + i];
    int i1 = 0; float m1 = q[0];
#pragma unroll
    for (int i = 1; i < 4; ++i) if (q[i] > m1) { m1 = q[i]; i1 = i; }
    int i2 = -1; float m2 = -1.f;
#pragma unroll
    for (int i = 0; i < 4; ++i) if (i != i1 && q[i] > m2) { m2 = q[i]; i2 = i; }
    const float inv = 1.0f / (m1 + m2);
    e0 = sel * 4 + i1; e1 = sel * 4 + i2; w0 = m1 * inv; w1 = m2 * inv;
}

__device__ __forceinline__ void rows_route(Frame& F, int nrows, int l) {
    const bf16* XB = (const bf16*)(F.ws + WS_XB);
    constexpr int HP = 1028;
    LAS float* Wt = (LAS float*)(F.lds + RING_OFF);
    LAS float* Ht = (LAS float*)(F.lds + RING_OFF + 65536);
    LAS float* part = (LAS float*)(F.lds + TAB_OFF);
    LAS float* logit = (LAS float*)(F.lds + TAB_OFF + 8192);
    LAS unsigned char* pe = (LAS unsigned char*)(F.lds + TAB_OFF + 9216);
    LAS unsigned short* pr = (LAS unsigned short*)(F.lds + TAB_OFF + 9216 + 2048);
    static_assert(TAB_OFF + 9216 + 2048 + 3072 <= LDS_BYTES && RING_OFF + 65536 + 16 * 1028 * 4 <= MISC_OFF, "router LDS map");
    { int t0_ = F.tid; asm volatile("" : "+v"(t0_));
      for (int idx = t0_; idx < 1024 * 16 / 4; idx += NWAVES * 64) ((LAS f32x4*)Wt)[idx] = ((const f32x4*)F.in[I_RW])[idx]; }
    const int NGW = F.G * NWAVES;
    const int b0 = (int)((long)(blockIdx.x * NWAVES) * nrows / NGW), b1 = (int)((long)(blockIdx.x * NWAVES + NWAVES) * nrows / NGW);
    unsigned char* XN8 = F.ws + WS_XN; v4u* route = (v4u*)(F.ws + WS_ROUTE);
    const float* nw = F.in[I_NFFN] + l * 1024; const float* rb = F.in[I_RB];
    const int ngroups = (b1 - b0 + 15) >> 4;
    int curb = -1; RowVec gsc, sh;
    v2u xr[2][4];
#define RR_LOAD(g_) do { _Pragma("unroll") for (int q = 0; q < 2; ++q) { const int row_ = b0 + 16 * (g_) + 2 * F.wave + q; const int rc_ = row_ < b1 ? row_ : b1 - 1; \
        _Pragma("unroll") for (int j = 0; j < 4; ++j) xr[q][j] = *(const GAS v2u*)(XB + (size_t)rc_ * 1024 + 4 * F.lane + 256 * j); } } while (0)
    RR_LOAD(0);
    for (int g = 0; g < ngroups; ++g) {
#pragma unroll
        for (int q = 0; q < 2; ++q) { const int rr = 2 * F.wave + q, row = b0 + 16 * g + rr; const bool valid = row < b1;
            RowVec x, h;
#pragma unroll
            for (int j = 0; j < 4; ++j) x.v[j] = (f32x4){bflo(xr[q][j].x), bfhi(xr[q][j].x), bflo(xr[q][j].y), bfhi(xr[q][j].y)};
            const int mrow = (valid ? row : b1 - 1) < ML ? ((valid ? row : b1 - 1) >> 12) : 8;
            if (mrow != curb) { load_modvec(F, l, mrow, 3, nw, gsc, sh); curb = mrow; }
            rms_mod(x, gsc, sh, h);
            if (valid) { unsigned char* d8 = XN8 + (size_t)row * 1024;
#pragma unroll
                for (int j = 0; j < 4; ++j) *(GAS unsigned*)(d8 + 4 * F.lane + 256 * j) = pg8::pk4_fp8(h.v[j][0], h.v[j][1], h.v[j][2], h.v[j][3]); }
#pragma unroll
            for (int j = 0; j < 4; ++j) *(LAS f32x4*)(Ht + rr * HP + 4 * F.lane + 256 * j) = valid ? h.v[j] : (f32x4){0.f, 0.f, 0.f, 0.f}; }
        if (g + 1 < ngroups) RR_LOAD(g + 1);
        __syncthreads();
        { const int r = F.lane & 15, kq = F.lane >> 4; f32x4 acc = {0.f, 0.f, 0.f, 0.f};
          const LAS float* ap = Ht + r * HP + 128 * F.wave + kq; const LAS float* bp = Wt + (128 * F.wave + kq) * 16 + r;
#pragma unroll 8
          for (int s_ = 0; s_ < 32; ++s_) acc = __builtin_amdgcn_mfma_f32_16x16x4f32(ap[4 * s_], bp[64 * s_], acc, 0, 0, 0);
#pragma unroll
          for (int i = 0; i < 4; ++i) part[(F.wave * 16 + 4 * kq + i) * 16 + r] = acc[i]; }
        __syncthreads();
        if (F.tid < 256) { float sacc = rb[F.tid & 15];
#pragma unroll
            for (int w = 0; w < 8; ++w) sacc += part[w * 256 + F.tid];
            logit[F.tid] = sacc; }
        __syncthreads();
        if (F.tid < 16) { const int row = b0 + 16 * g + F.tid;
            if (row < b1) { float lg[16];
#pragma unroll
                for (int e = 0; e < 16; ++e) lg[e] = logit[F.tid * 16 + e];
                int e0, e1; float w0, w1; route_topk(lg, e0, e1, w0, w1);
                const int a0 = e0 & 3, a1 = e1 & 3, lo = a0 < a1 ? a0 : a1, hi_ = a0 < a1 ? a1 : a0, pid = lo == 0 ? hi_ - 1 : lo == 1 ? hi_ + 1 : 5, gid = 6 * (e0 >> 2) + pid;
                const float wa = a0 < a1 ? w0 : w1, wb = a0 < a1 ? w1 : w0;
                v4u o; o.x = (unsigned)gid; o.y = __builtin_bit_cast(unsigned, wa); o.z = __builtin_bit_cast(unsigned, wb); o.w = 0u; route[row] = o;
                pe[row - b0] = (unsigned char)gid; } }
    }
#undef RR_LOAD
    __syncthreads();
    if (F.wave == 0) {
        const int nr = b1 - b0; int run[24];
#pragma unroll
        for (int j = 0; j < 24; ++j) run[j] = 0;
        for (int p0 = 0; p0 < nr; p0 += 64) { const int p = p0 + F.lane; const int e = p < nr ? (int)pe[p] : 255; int myr = 0;
#pragma unroll
            for (int j = 0; j < 24; ++j) { const unsigned long long m = __ballot(e == j); const int below = __popcll(m & ((1ull << F.lane) - 1ull));
                if (e == j) myr = run[j] + below; run[j] += __popcll(m); }
            if (p < nr) pr[p] = (unsigned short)myr; }
        int mycnt = 0;
#pragma unroll
        for (int j = 0; j < 24; ++j) mycnt = (F.lane == j) ? run[j] : mycnt;
        int basev = 0;
        if (F.lane < 24) basev = (int)__hip_atomic_fetch_add((unsigned*)(F.ctl + CW_CNT + 64 * l) + F.lane, (unsigned)mycnt, RLX_AGENT);
        int base[24];
#pragma unroll
        for (int j = 0; j < 24; ++j) base[j] = __builtin_amdgcn_readlane(basev, j);
        LDS_WAIT();
        int* ridx = (int*)(F.ws + WS_RIDX);
        for (int p0 = 0; p0 < nr; p0 += 64) { const int p = p0 + F.lane;
            if (p < nr) { const int e = (int)pe[p]; int bs = 0;
#pragma unroll
                for (int j = 0; j < 24; ++j) bs = (e == j) ? base[j] : bs;
                ridx[(size_t)e * MT + bs + (int)pr[p]] = b0 + p; } }
    }
    __syncthreads();
}

__device__ __forceinline__ void rows_modulate_xb(Frame& F, int nrows, int l) {
    const int gwv = blockIdx.x * NWAVES + F.wave, NGW = F.G * NWAVES;
    const int r0 = (int)((long)gwv * nrows / NGW), r1 = (int)((long)(gwv + 1) * nrows / NGW);
    const bf16* XB = (const bf16*)(F.ws + WS_XB); unsigned char* XN8 = F.ws + WS_XN; const float* nw = F.in[I_NMIX] + l * 1024;
    int curb = -1; RowVec gsc, sh, xn;
    if (r0 < r1) load_xrow_bf(XB, r0, F.lane, xn);
    for (int row = r0; row < r1; ++row) {
        const int mrow = row < ML ? (row >> 12) : 8;
        if (mrow != curb) { load_modvec(F, l, mrow, 0, nw, gsc, sh); curb = mrow; }
        RowVec x = xn, h;
        if (row + 1 < r1) load_xrow_bf(XB, row + 1, F.lane, xn);
        rms_mod(x, gsc, sh, h);
        unsigned char* d8 = XN8 + (size_t)row * 1024;
#pragma unroll
        for (int j = 0; j < 4; ++j) *(GAS unsigned*)(d8 + 4 * F.lane + 256 * j) = pg8::pk4_fp8(h.v[j][0], h.v[j][1], h.v[j][2], h.v[j][3]);
    }
}

__device__ __forceinline__ void rows_conv(Frame& F) {
    const bf16* U = (const bf16*)((unsigned char*)F.out + DO_U); bf16* UC = (bf16*)(F.ws + WS_XN);
    const int cg = F.tid & 127, rsub = F.tid >> 7, c0 = cg * 8;
    float w[4][8], cb[8];
#pragma unroll
    for (int j = 0; j < 8; ++j) { cb[j] = F.in[I_LCB][c0 + j];
#pragma unroll
        for (int k = 0; k < 4; ++k) w[k][j] = F.in[I_LCW][k * 1024 + c0 + j]; }
    for (int run = blockIdx.x * 4 + rsub; run < MT / 16; run += F.G * 4) {
        const int row0 = run * 16; const int t0 = row0 < ML ? (row0 & 4095) : ((row0 - ML) & 255), T = row0 < ML ? 4096 : 256;
        v4u win[19];
#pragma unroll
        for (int i = 0; i < 19; ++i) { const int tt = t0 + i - 2; win[i] = (v4u){0u, 0u, 0u, 0u};
            if (tt >= 0 && tt < T) win[i] = *(const GAS v4u*)(U + (size_t)(row0 + i - 2) * 1024 + c0); }
#pragma unroll
        for (int i = 0; i < 16; ++i) { float acc[8];
#pragma unroll
            for (int j = 0; j < 8; ++j) acc[j] = cb[j];
#pragma unroll
            for (int k = 0; k < 4; ++k) { const v4u uv = win[i + k];
                acc[0] += w[k][0] * bflo(uv.x); acc[1] += w[k][1] * bfhi(uv.x); acc[2] += w[k][2] * bflo(uv.y); acc[3] += w[k][3] * bfhi(uv.y);
                acc[4] += w[k][4] * bflo(uv.z); acc[5] += w[k][5] * bfhi(uv.z); acc[6] += w[k][6] * bflo(uv.w); acc[7] += w[k][7] * bfhi(uv.w); }
            v4u o; o.x = pk2(acc[0], acc[1]); o.y = pk2(acc[2], acc[3]); o.z = pk2(acc[4], acc[5]); o.w = pk2(acc[6], acc[7]);
            *(GAS v4u*)(UC + (size_t)(row0 + i) * 1024 + c0) = o; }
    }
}

__device__ __forceinline__ int scan_q(int d, int pc) { return d == 0 ? pc : (pc < 8 ? 7 - pc : 143 - pc); }
__device__ __forceinline__ int scan_row0(int b, int pc) { return pc < 8 ? ML + b * 256 + pc * 32 : b * 4096 + (pc - 8) * 32; }
__device__ __forceinline__ const unsigned char* scan_lb(Frame& F, int d) { return (const unsigned char*)(F.ws + (d ? WS_BB0 : WS_LA0)); }
#define LB_DEC(w, a0, b0, a1, b1) do { const f32x2 lo_ = __builtin_amdgcn_cvt_pk_f32_fp8((int)(w), false), hi_ = __builtin_amdgcn_cvt_pk_f32_fp8((int)(w), true); \
        a0 = fast_exp2(lo_[0] * (1.0f / pg8::LA8_SCALE)); b0 = lo_[1]; a1 = fast_exp2(hi_[0] * (1.0f / pg8::LA8_SCALE)); b1 = hi_[1]; } while (0)
__device__ __forceinline__ void scan_local(Frame& F) {
    f32x4* summ = (f32x4*)((unsigned char*)F.out + DO_SUMM);
    const int c2 = 2 * F.tid;
    for (int item = blockIdx.x; item < BATCH * NQ; item += F.G) {
        const int b = item / NQ, pc = item % NQ, row0 = scan_row0(b, pc);
#pragma unroll
        for (int d = 0; d < 2; ++d) {
            const unsigned char* lb = scan_lb(F, d) + ((size_t)row0 * 1024 + c2) * 2;
            float P0 = 1.f, P1 = 1.f, H0 = 0.f, H1 = 0.f; unsigned wav[32];
#pragma unroll
            for (int i = 0; i < 32; ++i) wav[i] = *(const GAS unsigned*)(lb + (size_t)i * 2048);
#pragma unroll
            for (int ii = 0; ii < 32; ++ii) { const int i = d ? 31 - ii : ii; float a0, b0, a1, b1; LB_DEC(wav[i], a0, b0, a1, b1);
                H0 = a0 * H0 + b0; H1 = a1 * H1 + b1; P0 *= a0; P1 *= a1; }
            summ[((size_t)((b * 2 + d) * NQ + scan_q(d, pc)) * 1024 + c2) >> 1] = (f32x4){P0, H0, P1, H1};
        }
    }
}
__device__ __forceinline__ void scan_carry(Frame& F) {
    const f32x2* summ = (const f32x2*)((unsigned char*)F.out + DO_SUMM); float* carry = (float*)((unsigned char*)F.out + DO_CARRY);
    LAS f32x2* comp = (LAS f32x2*)(F.lds + RING_OFF);
    for (int u = blockIdx.x; u < 256; u += F.G) {
        const int bd = u >> 4, c = (u & 15) * 64 + F.lane, q0 = F.wave * 17; f32x2 s[17];
#pragma unroll
        for (int k = 0; k < 17; ++k) s[k] = summ[(size_t)(bd * NQ + q0 + k) * 1024 + c];
        float Pc = 1.f, Hc = 0.f;
#pragma unroll
        for (int k = 0; k < 17; ++k) { Hc = s[k][0] * Hc + s[k][1]; Pc *= s[k][0]; }
        comp[F.wave * 64 + F.lane] = (f32x2){Pc, Hc};
        __syncthreads();
        float h = 0.f;
        for (int w = 0; w < F.wave; ++w) { const f32x2 cw = comp[w * 64 + F.lane]; h = cw[0] * h + cw[1]; }
#pragma unroll
        for (int k = 0; k < 17; ++k) { carry[(size_t)(bd * NQ + q0 + k) * 1024 + c] = h; h = s[k][0] * h + s[k][1]; }
        __syncthreads();
    }
}
__device__ __forceinline__ void scan_final(Frame& F) {
    const float* carry = (const float*)((unsigned char*)F.out + DO_CARRY); const bf16* Gb = (const bf16*)(F.ws + WS_G); bf16* YGb = (bf16*)(F.ws + WS_XN);
    const int c2 = 2 * F.tid;
    for (int item = blockIdx.x; item < BATCH * NQ; item += F.G) {
        const int b = item / NQ, pc = item % NQ, row0 = scan_row0(b, pc);
        float hf0[32], hf1[32];
        { const unsigned char* lb = scan_lb(F, 0) + ((size_t)row0 * 1024 + c2) * 2;
          const f32x2 cin = *(const f32x2*)(carry + (size_t)((b * 2 + 0) * NQ + scan_q(0, pc)) * 1024 + c2); float h0 = cin[0], h1 = cin[1];
          unsigned wav[32];
#pragma unroll
          for (int i = 0; i < 32; ++i) wav[i] = *(const GAS unsigned*)(lb + (size_t)i * 2048);
#pragma unroll
          for (int i = 0; i < 32; ++i) { float a0, b0, a1, b1; LB_DEC(wav[i], a0, b0, a1, b1);
              h0 = a0 * h0 + b0; h1 = a1 * h1 + b1; hf0[i] = h0; hf1[i] = h1; } }
        { const unsigned char* lb = scan_lb(F, 1) + ((size_t)row0 * 1024 + c2) * 2; const bf16* gp = Gb + (size_t)row0 * 1024 + c2; bf16* yp = YGb + (size_t)row0 * 1024 + c2;
          const f32x2 cin = *(const f32x2*)(carry + (size_t)((b * 2 + 1) * NQ + scan_q(1, pc)) * 1024 + c2); float h0 = cin[0], h1 = cin[1];
          unsigned wav[32], gv[32];
#pragma unroll
          for (int i = 0; i < 32; ++i) wav[i] = *(const GAS unsigned*)(lb + (size_t)i * 2048);
#pragma unroll
          for (int i = 0; i < 32; ++i) gv[i] = *(const GAS unsigned*)(gp + (size_t)i * 1024);
#pragma unroll
          for (int ii = 0; ii < 32; ++ii) { const int i = 31 - ii; float a0, b0, a1, b1; LB_DEC(wav[i], a0, b0, a1, b1);
              h0 = a0 * h0 + b0; h1 = a1 * h1 + b1;
              const unsigned g = gv[i];
              *(GAS unsigned*)(yp + (size_t)i * 1024) = pk2((hf0[i] + h0) * (bflo(g) * (1.0f / pg8::BB8_SCALE)), (hf1[i] + h1) * (bfhi(g) * (1.0f / pg8::BB8_SCALE))); } }
    }
}

__device__ __forceinline__ int scan_po_panel(int pos, bool reorder) { if (!reorder || pos >= 48) return pos; const int k = pos / 24, j = pos % 24; return 6 * (j & 7) + 3 * k + (j >> 3); }
__device__ __forceinline__ void scan_final_ho(Frame& F, int nprod, bool reorder, unsigned* hcnt) {
    const float* carry = (const float*)((unsigned char*)F.out + DO_CARRY); const bf16* Gb = (const bf16*)(F.ws + WS_G); bf16* YGb = (bf16*)(F.ws + WS_XN);
    const int c2 = 2 * F.tid; int pend = -1;
    for (int t = blockIdx.x; t < BATCH * NQ; t += nprod) {
        asm volatile("" ::: "memory");
        const int panel = scan_po_panel(t >> 3, reorder), b = panel < 128 ? (panel >> 4) : panel - 128, pc = (panel < 128 ? 8 + (panel & 15) * 8 : 0) + (t & 7), row0 = scan_row0(b, pc);
        float hf0[32], hf1[32];
        { const unsigned char* lb = scan_lb(F, 0) + ((size_t)row0 * 1024 + c2) * 2;
          const f32x2 cin = *(const f32x2*)(carry + (size_t)((b * 2 + 0) * NQ + scan_q(0, pc)) * 1024 + c2); float h0 = cin[0], h1 = cin[1];
          unsigned wav[32];
#pragma unroll
          for (int i = 0; i < 32; ++i) wav[i] = *(const GAS unsigned*)(lb + (size_t)i * 2048);
#pragma unroll
          for (int i = 0; i < 32; ++i) { float a0, b0, a1, b1; LB_DEC(wav[i], a0, b0, a1, b1);
              h0 = a0 * h0 + b0; h1 = a1 * h1 + b1; hf0[i] = h0; hf1[i] = h1; } }
        asm volatile("" ::: "memory");
        if (pend >= 0) { __syncthreads(); if (F.tid == 0) pg8::ho_publish(hcnt, pend); }
        { const unsigned char* lb = scan_lb(F, 1) + ((size_t)row0 * 1024 + c2) * 2; const bf16* gp = Gb + (size_t)row0 * 1024 + c2; bf16* yp = YGb + (size_t)row0 * 1024 + c2;
          const f32x2 cin = *(const f32x2*)(carry + (size_t)((b * 2 + 1) * NQ + scan_q(1, pc)) * 1024 + c2); float h0 = cin[0], h1 = cin[1];
          unsigned wav[32], gv[32];
#pragma unroll
          for (int i = 0; i < 32; ++i) wav[i] = *(const GAS unsigned*)(lb + (size_t)i * 2048);
#pragma unroll
          for (int i = 0; i < 32; ++i) gv[i] = *(const GAS unsigned*)(gp + (size_t)i * 1024);
#pragma unroll
          for (int ii = 0; ii < 32; ++ii) { const int i = 31 - ii; float a0, b0, a1, b1; LB_DEC(wav[i], a0, b0, a1, b1);
              h0 = a0 * h0 + b0; h1 = a1 * h1 + b1;
              const unsigned g = gv[i];
              __hip_atomic_store((GAS unsigned*)(yp + (size_t)i * 1024), pk2((hf0[i] + h0) * (bflo(g) * (1.0f / pg8::BB8_SCALE)), (hf1[i] + h1) * (bfhi(g) * (1.0f / pg8::BB8_SCALE))), __ATOMIC_RELAXED, __HIP_MEMORY_SCOPE_AGENT); } }
        pend = panel;
    }
    asm volatile("s_waitcnt vmcnt(0)" ::: "memory");
    __syncthreads();
    if (pend >= 0 && F.tid == 0) pg8::ho_publish(hcnt, pend);
}
#ifndef MK_N_LAUNCHES
#define MK_N_LAUNCHES 1
#endif
constexpr int NPHASE = 15;
#ifndef PH_STOP
#define PH_STOP 15
#endif
#ifndef PH_DUP
#define PH_DUP 0u
#endif
#define DUPN(k) (((PH_DUP >> (k)) & 1u) ? 2 : 1)
constexpr int N_LAUNCHES = MK_N_LAUNCHES;
struct Args { const float* in[26]; float* out; unsigned char* ws; int ph_lo, ph_hi; };

__global__ void __launch_bounds__(NWAVES * 64, 2) fwd_kernel(Args args) {
    extern __shared__ __attribute__((aligned(16))) unsigned char lds[];
    Frame F;
    F.lds = (LAS unsigned char*)lds;
    F.MISC = (volatile LAS unsigned*)(F.lds + MISC_OFF);
    F.tid = threadIdx.x; F.lane = F.tid & 63; F.wave = __builtin_amdgcn_readfirstlane(F.tid >> 6);
    F.G = gridDim.x; { const int bx = blockIdx.x; F.vcu = (F.G % 8 == 0) ? (bx % 8) * (F.G / 8) + bx / 8 : bx; }
    F.ws = args.ws; F.out = args.out; F.ctl = (gu32*)(args.ws + WS_CTL);
#pragma unroll
    for (int i = 0; i < 26; ++i) F.in[i] = args.in[i];
    for (int u = F.tid; u < (LDS_BYTES - LDSCTL_OFF) / 4; u += NWAVES * 64) ((LAS unsigned*)(F.lds + LDSCTL_OFF))[u] = 0u;
    __syncthreads();
    XcdBarrier bar; bar.bar = (unsigned*)(F.ctl + CW_BAR); bar.x = 0; bar.st = nullptr;
    if (N_LAUNCHES == 1) bar = xcd_barrier_post((unsigned*)(F.ctl + CW_BAR), F.MISC + 8);
#define GRID_BAR() do { if (N_LAUNCHES == 1) xcd_barrier(bar); } while (0)
    const int lo = args.ph_lo, hi = args.ph_hi;
#define IN(k) (lo <= (k) && (k) < hi)
#define BOTH(k) (IN(k) && IN((k) + 1))
    unsigned char* ws = args.ws;
    float* mod = (float*)(ws + WS_MOD);
    LAS unsigned char* ring = F.lds + RING_OFF;
    LAS int* tab = (LAS int*)(F.lds + TAB_OFF); LAS float* tabw = (LAS float*)(F.lds + TAB_OFF + TAB_UNITS * 1024);

#define PHASE(k, ...) do { if (IN(k)) { _Pragma("unroll") for (int rep_ = 0; rep_ < DUPN(k); ++rep_) { __VA_ARGS__; if (rep_ + 1 < DUPN(k)) GRID_BAR(); } if (BOTH(k)) GRID_BAR(); } } while (0)
    PHASE(0, p0_prologue(F));
    PHASE(1, {
        const int nearly = (F.G == 256) ? 96 : 0; unsigned* hc = (unsigned*)(F.ctl + CW_TILE + 12288);
        if ((int)blockIdx.x < F.G - nearly) rows_modulate_ho(F, F.in[I_X], F.in[I_CTX], 0, 0, F.in[I_NMIX], F.G - nearly, nearly != 0, hc);
        pg8::Gemm g{(const bf16*)(ws + WS_XN), (const bf16*)(ws + WS_W_IN), 1024, 1024, 1024, hc, 256u}; pg8::SchedIn S{F.G, (int)blockIdx.x, nearly};
        pg8::EpiInProj E{(bf16*)(ws + WS_G), (bf16*)((unsigned char*)F.out + DO_U)};
        pg8::gemm_phase<pg8::EpiInProj, pg8::SchedIn, false, 2, 2>(ring, g, S, E, tab);
        if (F.G == 256) conv_tail(F, 128, CV_A_END, CV_A_END + 5760, S.cl()); else conv_tail(F, 0, CV_A_END, CV_A_END + 5760); });
    PHASE(2, rows_conv(F));
    PHASE(3, {
        pg8::Gemm g{(const bf16*)(ws + WS_XN), (const bf16*)(ws + WS_W_G), 1024, 128, 128}; pg8::SchedGates S{MT / 256, F.G, (int)blockIdx.x};
        pg8::EpiGates E{(const bf16*)(ws + WS_XN), {ws + WS_LA0, ws + WS_BB0}, F.in[I_GAB], F.in[I_GXB], F.in[I_LAM]};
        pg8::gemm_phase<pg8::EpiGates, pg8::SchedGates, false>(ring, g, S, E, tab);
        if (F.G == 256) conv_tail(F, 128, CV_A_END + 5760, CV_A_END + 8320); else conv_tail(F, 0, CV_A_END + 5760, CV_A_END + 8320); });
    PHASE(4, scan_local(F));
    PHASE(5, scan_carry(F));
    PHASE(6, {
        const int nearly = (F.G == 256) ? 96 : 0; unsigned* hc = (unsigned*)(F.ctl + CW_TILE + 8192);
        if ((int)blockIdx.x < F.G - nearly) scan_final_ho(F, F.G - nearly, nearly != 0, hc);
        pg8::Gemm g{(const bf16*)(ws + WS_XN), (const bf16*)(ws + WS_W_OUT), 1024, 1024, 1024, hc}; pg8::SchedOut S{F.G, (int)blockIdx.x, nearly};
        pg8::EpiResid<false> E{F.in[I_X], F.in[I_CTX], (bf16*)(ws + WS_XB), mod + 2 * 1024, 1.0f};
        pg8::gemm_phase<pg8::EpiResid<false>, pg8::SchedOut, false, 2, 2>(ring, g, S, E, tab);
        if (F.G == 256) conv_tail(F, 96, CV_A_END + 8320, CV_B_END + CV_T8C); else conv_tail(F, 0, CV_A_END + 8320, CV_B_END + CV_T8C); });
    PHASE(7, rows_route(F, MT, 0));
#define MOE_UP(l, HOM) do { pg8::SchedMoe<true> S; S.init((const unsigned*)(F.ctl + CW_CNT + 64 * (l)), F.G, F.vcu); const int* ridx = (const int*)(ws + WS_RIDX); const v4u* route_ = (const v4u*)(ws + WS_ROUTE); \
        { pg8::Unit u; for (int i = 0; i < TAB_UNITS && S.next(i, u); ++i) if (F.tid < 256) { const bool v_ = F.tid < u.x1; const int row_ = v_ ? ridx[(size_t)u.x0 * MT + u.x2 + F.tid] : 0; \
              tab[i * 256 + F.tid] = row_; float w_ = 0.f; if (v_) { const v4u rt_ = route_[row_]; const unsigned wy_ = rt_.y, wz_ = rt_.z; w_ = __uint_as_float(u.pn < 4 ? wy_ : wz_); } tabw[i * 256 + F.tid] = w_; } } \
        __syncthreads(); \
        pg8::Gemm g{ws + WS_XN, ws + WS_W13 + (size_t)(l) * 16 * 1024 * 1024, 1024, 1024, 1024, (unsigned*)(F.ctl + CW_TILE + 4096 * (l))}; pg8::EpiMoe1<(HOM) != 0> E{ws + WS_ACT, tabw}; \
        pg8::gemm_phase<pg8::EpiMoe1<(HOM) != 0>, pg8::SchedMoe<true>, true, 1, (HOM) ? 1 : 0>(ring, g, S, E, tab); \
        if ((l) == 0 && !(HOM)) conv_tail(F, S.total % F.G, CV_B_END, CV_B_END + CV_T10, F.vcu); } while (0)
#define MOE_DOWN(l, FINAL, HOM) do { pg8::SchedMoe<false> S; S.init((const unsigned*)(F.ctl + CW_CNT + 64 * (l)), F.G, F.vcu); if (HOM) S.c = (F.vcu + F.G - (2 * S.total) % F.G) % F.G;     const int* ridx = (const int*)(ws + WS_RIDX); \
        { pg8::Unit u; for (int i = 0; i < TAB_UNITS && S.next(i, u); ++i) if (F.tid < 256) tab[i * 256 + F.tid] = F.tid < u.x1 ? ridx[(size_t)u.x0 * MT + u.x2 + F.tid] : -1; } \
        __syncthreads(); \
        pg8::Gemm g{ws + WS_ACT, ws + WS_W2 + (size_t)(l) * 16 * 1024 * 512, 1024, 512, 1024, (unsigned*)(F.ctl + CW_TILE + 4096 * (l))}; pg8::EpiMoe2<FINAL> E{(bf16*)(ws + WS_XB), F.out, mod + (l) * 9 * 6144 + 5 * 1024, tab}; \
        pg8::gemm_phase<pg8::EpiMoe2<FINAL>, pg8::SchedMoe<false>, false, 1, (HOM) ? 2 : 0>(ring, g, S, E, tab); \
        if ((l) == 0 && !(HOM)) conv_tail(F, S.total % F.G, CV_B_END + CV_T10, CV_B_END + CV_T10 + CV_T11, F.vcu); \
        if ((l) == 0 && (HOM)) conv_tail(F, 0, CV_B_END + CV_T8C, CV_B_END + CV_T10 + CV_T11, F.vcu);     \
        } while (0)
    PHASE(8, { MOE_UP(0, 1); __syncthreads(); MOE_DOWN(0, false, 1); });
    PHASE(9, rows_modulate_xb(F, MT, 1));
    PHASE(10, {
        pg8::Gemm g{ws + WS_XN, ws + WS_W_QKV, 1024, 1024, 1024}; pg8::SchedQKV S{F.G, (int)blockIdx.x};
        { int t_ = F.tid; asm volatile("" : "+v"(t_));
          LAS f32x4* rl = (LAS f32x4*)tab; rl[t_] = ((const f32x4*)(ws + WS_ROPE))[t_]; __syncthreads(); }
        pg8::EpiQKV E{ws + WS_Q, ws + WS_K, ws + WS_V, F.in[I_QN], F.in[I_KN], (const LAS float*)tab};
        pg8::gemm_phase<pg8::EpiQKV, pg8::SchedQKV, false, 1>(ring, g, S, E, tab);
        conv_tail(F, F.G == 256 ? 16 : 0, CV_B_END + CV_T10 + CV_T11, CV_B_END + CV_T10 + CV_T11 + CV_T13); });
    PHASE(11, {
        static_assert(attn8::LDS_BYTES <= RING_BYTES, "attention LDS");
        const attn8::Tensors AT{ws + WS_Q, ws + WS_K, ws + WS_V, ws + WS_O};
        attn8::attn_phase((char*)lds + RING_OFF, AT, (int)F.G, (int)blockIdx.x); });
    PHASE(12, {
        pg8::Gemm g{ws + WS_O, ws + WS_W_O, 1024, 1024, 1024}; pg8::SchedDense S{ML / 256, 4, F.G, (int)blockIdx.x};
        pg8::EpiResid<true> E{nullptr, nullptr, (bf16*)(ws + WS_XB), mod + 9 * 6144 + 2 * 1024, 1.0f / (pg8::W8_SCALE * attn8::OS)};
        pg8::gemm_phase<pg8::EpiResid<true>, pg8::SchedDense, false, 1>(ring, g, S, E, tab); });
    PHASE(13, rows_route(F, ML, 1));
    PHASE(14, { MOE_UP(1, 1); __syncthreads(); MOE_DOWN(1, true, 1); });
#undef IN
#undef BOTH
}

extern "C" void kernel_launch(void* const* d_in, const int* in_sizes, int n_in, void* d_out, int out_size, void* d_ws, size_t ws_size, hipStream_t stream) {
    static int grid = 0;
    if (grid == 0) {
        if (n_in != 26 || in_sizes[0] != ML * D || out_size != ML * D || ws_size < WS_END) { fprintf(stderr, "kernel_launch: unexpected shapes (n_in %d, in0 %d, out %d, ws %zu); nothing launched\n", n_in, n_in > 0 ? in_sizes[0] : -1, out_size, ws_size); grid = -1; return; }
        int dev = 0, cus = 0, per_cu = 0;
        if (hipGetDevice(&dev) != hipSuccess || hipDeviceGetAttribute(&cus, hipDeviceAttributeMultiprocessorCount, dev) != hipSuccess) { grid = -1; return; }
        if (hipFuncSetAttribute((const void*)fwd_kernel, hipFuncAttributeMaxDynamicSharedMemorySize, LDS_BYTES) != hipSuccess) { fprintf(stderr, "kernel_launch: hipFuncSetAttribute failed\n"); grid = -1; return; }
        if (hipOccupancyMaxActiveBlocksPerMultiprocessor(&per_cu, (const void*)fwd_kernel, NWAVES * 64, LDS_BYTES) != hipSuccess || per_cu < 1)
            fprintf(stderr, "kernel_launch: note: occupancy query reports %d workgroups per CU\n", per_cu);
        (void)hipGetLastError();
        grid = cus < 256 ? cus : 256;
    }
    if (grid < 0) return;
    if (hipMemsetAsync((char*)d_ws + WS_CTL, 0, CTL_ZERO_BYTES, stream) != hipSuccess) { fprintf(stderr, "kernel_launch: memset failed\n"); return; }
    Args a{};
    for (int i = 0; i < 26; ++i) a.in[i] = (const float*)d_in[i];
    a.out = (float*)d_out; a.ws = (unsigned char*)d_ws;
    for (int li = 0; li < (N_LAUNCHES == 1 ? 1 : PH_STOP); ++li) {
        a.ph_lo = (N_LAUNCHES == 1) ? 0 : li; a.ph_hi = (N_LAUNCHES == 1) ? PH_STOP : li + 1;
        hipLaunchKernelGGL(fwd_kernel, dim3(grid), dim3(NWAVES * 64), LDS_BYTES, stream, a);
        const hipError_t le = hipPeekAtLastError();
        if (le != hipSuccess) { fprintf(stderr, "kernel_launch: launch %d failed: %s\n", li, hipGetErrorName(le)); break; }
    }
}
```

```cpp
#include <hip/hip_runtime.h>
#include <cstdio>
#include <cstdint>

constexpr int BATCH = 8, SEQ = 4096, D = 1024, CTXL = 256;
constexpr int ML = BATCH * SEQ;
constexpr int MC = BATCH * CTXL;
constexpr int MT = ML + MC;
constexpr int KVL = CTXL + SEQ;
constexpr int NE = 16, FF = 512;
constexpr int NQ = 136;
constexpr float EPS = 1e-6f;
constexpr int NWAVES = 8;

constexpr size_t MiB = 1u << 20;
constexpr size_t WS_CTL = 0, CTL_ZERO_BYTES = 1 * MiB;
constexpr size_t WS_MOD = 1 * MiB;
constexpr size_t WS_ROPE = 1 * MiB + 512 * 1024;
constexpr size_t WS_ROUTE = 2 * MiB;
constexpr size_t WS_RIDX = 3 * MiB;
constexpr size_t WS_W_IN = 8 * MiB, WS_W_G = 12 * MiB, WS_W_OUT = 13 * MiB, WS_W_QKV = 15 * MiB, WS_W_O = 18 * MiB;
constexpr size_t WS_W13 = 20 * MiB, WS_W2 = 84 * MiB;
constexpr size_t WS_CTX = 116 * MiB;
constexpr size_t WS_XN = 124 * MiB;
constexpr size_t WS_G = 192 * MiB;
constexpr size_t WS_LA0 = 260 * MiB, WS_BB0 = 328 * MiB, WS_LA1 = 396 * MiB;
constexpr size_t WS_ACT = 192 * MiB;
constexpr size_t WS_Y = 264 * MiB;
constexpr size_t WS_Q = 192 * MiB, WS_K = 256 * MiB, WS_V = 273 * MiB;
constexpr size_t WS_O = 290 * MiB;
constexpr size_t WS_XB = 396 * MiB;
constexpr size_t WS_END = 464 * MiB;
constexpr size_t DO_U = 0, DO_SUMM = 68 * MiB, DO_CARRY = 88 * MiB;
constexpr int CW_TMO = 0, CW_CODE = 1, CW_CNT = 64  , CW_BAR = 4096, CW_TILE = 65536  ;

constexpr int RING_OFF = 0, RING_BYTES = 131072;
constexpr int LDSCTL_OFF = RING_BYTES, MISC_OFF = LDSCTL_OFF + 320;
constexpr int TAB_OFF = RING_BYTES + 1024, TAB_UNITS = 6;
constexpr int LDS_BYTES = 147456;
static_assert(TAB_OFF + 2 * TAB_UNITS * 1024 <= LDS_BYTES, "LDS map");

#define GAS __attribute__((address_space(1)))
#define LAS __attribute__((address_space(3)))
typedef unsigned short bf16;
typedef unsigned v4u __attribute__((ext_vector_type(4)));
typedef unsigned v2u __attribute__((ext_vector_type(2)));
typedef float f32x4 __attribute__((ext_vector_type(4)));
typedef float f32x2 __attribute__((ext_vector_type(2)));
typedef short bf16x8 __attribute__((ext_vector_type(8)));
typedef GAS unsigned gu32;
#define RLX_AGENT __ATOMIC_RELAXED, __HIP_MEMORY_SCOPE_AGENT
#define LDS_WAIT() asm volatile("s_waitcnt lgkmcnt(0)" ::: "memory")
#define VM_WAIT() asm volatile("s_waitcnt vmcnt(0)" ::: "memory")
__device__ __forceinline__ unsigned f2bf(float f) { unsigned u = __builtin_bit_cast(unsigned, f); return (u + 0x7fffu + ((u >> 16) & 1u)) >> 16; }
__device__ __forceinline__ unsigned pk2(float lo, float hi) { return f2bf(lo) | (f2bf(hi) << 16); }
__device__ __forceinline__ float bflo(unsigned w) { return __builtin_bit_cast(float, w << 16); }
__device__ __forceinline__ float bfhi(unsigned w) { return __builtin_bit_cast(float, w & 0xffff0000u); }
__device__ __forceinline__ float fast_exp2(float x) { return __builtin_amdgcn_exp2f(x); }
__device__ __forceinline__ float fast_rcp(float x) { return __builtin_amdgcn_rcpf(x); }
__device__ __forceinline__ float sigmoid_f(float x) { return fast_rcp(1.0f + fast_exp2(-1.4426950408889634f * x)); }

#define XB_TMO      128
#define XB_XCNT(j)  (256  + 64 * (j))
#define XB_XSUB(j)  (1280 + 64 * (j))
#define XB_XGEN(j)  (2304 + 64 * (j))
#define XB_TOP      3328
#define XB_TOPGEN   3392
#define XCD_BAR_WORDS 3456
#define XB_SPIN_CAP (1u << 18)

__device__ __forceinline__ unsigned xb_ld(unsigned* p)              { return __hip_atomic_load(p, __ATOMIC_RELAXED, __HIP_MEMORY_SCOPE_AGENT); }
__device__ __forceinline__ unsigned xb_add(unsigned* p, unsigned v) { return __hip_atomic_fetch_add(p, v, __ATOMIC_RELAXED, __HIP_MEMORY_SCOPE_AGENT); }
__device__ __forceinline__ unsigned xb_xcc_id() { return (unsigned)__builtin_amdgcn_s_getreg((3 << 11) | 20) & 0xFu; }
#define XB_SPIN(cond, bar) do { unsigned _sp = 0; while (cond) { __builtin_amdgcn_s_sleep(1); \
    if ((++_sp & 255u) == 0u) { if (xb_ld(&(bar)[XB_TMO])) break; if (_sp > XB_SPIN_CAP) { atomicAdd(&(bar)[XB_TMO], 1u); break; } } } } while (0)

struct XcdBarrier { unsigned* bar; unsigned x; volatile LAS unsigned* st; };

__device__ __forceinline__ XcdBarrier xcd_barrier_post(unsigned* bar, volatile LAS unsigned* st) {
    XcdBarrier b; b.bar = bar; b.x = xb_xcc_id(); b.st = st;
    if (threadIdx.x == 0) (void)xb_add(&bar[XB_XCNT(b.x)], 1u);
    return b;
}
__device__ __forceinline__ void xcd_barrier_complete(unsigned* bar, unsigned x, unsigned& nloc, unsigned& nx) {
    const unsigned G = gridDim.x * gridDim.y * gridDim.z;
    unsigned sum, cnt, mine, sp = 0u;
    for (;;) {
        sum = 0u; cnt = 0u; mine = 0u;
#pragma unroll
        for (unsigned j = 0; j < 16; ++j) { const unsigned c = xb_ld(&bar[XB_XCNT(j)]); sum += c; cnt += (c > 0u) ? 1u : 0u; mine = (j == x) ? c : mine; }
        if (sum == G) break;
        __builtin_amdgcn_s_sleep(1);
        if ((++sp & 255u) == 0u) { if (xb_ld(&bar[XB_TMO])) break; if (sp > XB_SPIN_CAP) { atomicAdd(&bar[XB_TMO], 1u); break; } }
    }
    nloc = mine > 0u ? mine : 1u; nx = cnt > 0u ? cnt : 1u;
}
__device__ __forceinline__ void xcd_barrier(const XcdBarrier& b) {
    asm volatile("s_waitcnt vmcnt(0)" ::: "memory");
    __syncthreads();
    if (threadIdx.x == 0) {
        unsigned* bar = b.bar;
        __builtin_amdgcn_s_waitcnt(0);
        unsigned nloc = b.st[0], nx = b.st[1];
        if (nloc == 0u) { xcd_barrier_complete(bar, b.x, nloc, nx); b.st[0] = nloc; b.st[1] = nx; }
        const unsigned old = xb_add(&bar[XB_XSUB(b.x)], 1u);
        const unsigned gen = old / nloc;
        if (old + 1u == (gen + 1u) * nloc) {
            __builtin_amdgcn_fence(__ATOMIC_RELEASE, "agent");
            asm volatile("s_waitcnt vmcnt(0)" ::: "memory");
            const unsigned og = xb_add(&bar[XB_TOP], 1u);
            const unsigned tg = og / nx;
            if (og + 1u == (tg + 1u) * nx) xb_add(&bar[XB_TOPGEN], 1u);
            else XB_SPIN(xb_ld(&bar[XB_TOPGEN]) == tg, bar);
            __builtin_amdgcn_fence(__ATOMIC_ACQUIRE, "agent");
            xb_add(&bar[XB_XGEN(b.x)], 1u);
            asm volatile("s_waitcnt vmcnt(0)" ::: "memory");
        } else {
            XB_SPIN(xb_ld(&bar[XB_XGEN(b.x)]) == gen, bar);
            __builtin_amdgcn_fence(__ATOMIC_ACQUIRE, "agent");
            asm volatile("s_waitcnt vmcnt(0)" ::: "memory");
        }
    }
    __syncthreads();
}
namespace pg8 {
#define PG8_LAS __attribute__((address_space(3)))
typedef unsigned short bf16_t;
typedef short bf16x8 __attribute__((ext_vector_type(8)));
typedef float f32x4 __attribute__((ext_vector_type(4)));
typedef unsigned u32x4 __attribute__((ext_vector_type(4)));
constexpr int BM = 256, BK = 64, HALF = 128, HTB = HALF * BK * 2, STAGE_BYTES = 8 * HTB, NXCD = 8, WGM = 8;

__host__ __device__ __forceinline__ int lds_byte(int r, int c) { const int st = (r >> 4) * 2 + (c >> 5), rr = r & 15, cc = c & 31, ob = rr * 64 + cc * 2; return st * 1024 + (ob ^ (((ob >> 9) & 1) << 5)); }
__host__ __device__ __forceinline__ void stage_rc(int b, int& R, int& C) { const int st = b / 1024, sb = b % 1024, swz = sb ^ (((sb >> 9) & 1) << 5); R = (st >> 1) * 16 + swz / 64; C = (st & 1) * 32 + (swz % 64) / 2; }
__host__ __device__ __forceinline__ int perm32(int rho) { const int n = rho >> 4, i = rho & 15; return 8 * (i >> 2) + 4 * n + (i & 3); }

struct Unit { int pm, pn; int arow, acol, brow; int x0, x1, x2, ord; int brow2, ksplit; };
struct Gemm { const void* A; const void* Bt; int lda, ldb, K; unsigned* hcnt = nullptr; unsigned hneed = 8u; };
typedef int v8i32 __attribute__((ext_vector_type(8)));
struct Frag2 { bf16x8 v[2]; __device__ __forceinline__ bf16x8& operator[](int i) { return v[i]; } __device__ __forceinline__ const bf16x8& operator[](int i) const { return v[i]; } };

__device__ __forceinline__ void tile_of(int L, int nM, int nN, int& pm, int& pn) {
    const int nwg = nM * nN; int wgid = L;
    { const int q = nwg / NXCD, r = nwg % NXCD, xcd = wgid % NXCD, off = wgid / NXCD; wgid = (xcd < r ? xcd * (q + 1) : r * (q + 1) + (xcd - r) * q) + off; }
    const int nig = WGM * nN, gid = wgid / nig, fm = gid * WGM, gsz = (nM - fm) < WGM ? (nM - fm) : WGM;
    pm = fm + ((wgid % nig) % gsz); pn = (wgid % nig) / gsz;
}

__device__ __forceinline__ unsigned cvt_pk_bf16(float lo, float hi) { unsigned r; asm volatile("v_cvt_pk_bf16_f32 %0, %1, %2" : "=v"(r) : "v"(lo), "v"(hi)); return r; }

constexpr unsigned HO_SPIN_CAP = 1u << 22;
__device__ __forceinline__ void ho_publish(unsigned* hcnt, int tile) { (void)__hip_atomic_fetch_add(hcnt + tile * 16, 1u, __ATOMIC_RELAXED, __HIP_MEMORY_SCOPE_AGENT); }
__device__ __forceinline__ void ho_acquire(unsigned* hcnt, int tile, unsigned need) {
    unsigned sp = 0; unsigned* htmo = hcnt - 16;
    while ((unsigned)__builtin_amdgcn_readfirstlane((int)__hip_atomic_load(hcnt + tile * 16, __ATOMIC_RELAXED, __HIP_MEMORY_SCOPE_AGENT)) < need) {
        __builtin_amdgcn_s_sleep(1);
        if ((++sp & 255u) == 0u) { if (__builtin_amdgcn_readfirstlane((int)__hip_atomic_load(htmo, __ATOMIC_RELAXED, __HIP_MEMORY_SCOPE_AGENT))) break;
            if (sp > HO_SPIN_CAP) { (void)__hip_atomic_fetch_add(htmo, 1u, __ATOMIC_RELAXED, __HIP_MEMORY_SCOPE_AGENT); break; } } }
    __builtin_amdgcn_fence(__ATOMIC_ACQUIRE, "agent");
    asm volatile("s_waitcnt vmcnt(0)" ::: "memory");
}
template <class Epi, class Sched, bool GATHER, int ES = 2, int HO = 0>
__device__ __forceinline__ void gemm_phase(PG8_LAS unsigned char* lds, const Gemm g, const Sched& S, const Epi& E, const PG8_LAS int* tab) {
    const int tid = threadIdx.x, wid = __builtin_amdgcn_readfirstlane(tid >> 6), lane = tid & 63, wr = wid >> 2, wc = wid & 3, fr = lane & 15, fq = lane >> 4;
    const int K = g.K, nt = K * ES / (BK * 2), lda = g.lda * ES, ldb = g.ldb * ES;
    unsigned voffA[2], voffB[2]; int Rst[2], Cst[2];
#pragma unroll
    for (int i = 0; i < 2; ++i) { int R, C; stage_rc(tid * 16 + i * 8192, R, C); const int Rb = Epi::PERM ? ((R & ~31) + perm32(R & 31)) : R;
        voffA[i] = (unsigned)(R * lda + C * 2); voffB[i] = (unsigned)(Rb * ldb + C * 2); Rst[i] = R; Cst[i] = C * 2; }
    const size_t kstep = (size_t)(BK * 2);
    const size_t hstepA = GATHER ? (size_t)0 : (size_t)HALF * lda, hstepB = (size_t)HALF * ldb;
    const unsigned ldsw = (unsigned)wid * 1024u;
    const int aoff = lds_byte(wr * 64 + fr, fq * 8), boff = lds_byte(wc * 32 + fr, fq * 8);
#define PG8_SA(b, h) (((b) * 2 + (h)) * HTB)
#define PG8_SB(b, h) ((4 + (b) * 2 + (h)) * HTB)
#define PG8_STAGE(bufoff, gbase, voff) do { _Pragma("unroll") for (int _i = 0; _i < 2; ++_i) \
        __builtin_amdgcn_global_load_lds((const unsigned*)((const char*)(gbase) + (voff)[_i]), (PG8_LAS unsigned*)(lds + (bufoff) + ldsw + _i * 8192), 16, 0, 0); } while (0)
#define PG8_LDA(dst, b, h) do { _Pragma("unroll") for (int m = 0; m < 4; ++m) _Pragma("unroll") for (int k = 0; k < 2; ++k) dst[m][k] = *(const PG8_LAS bf16x8*)(lds + PG8_SA(b, h) + aoff + m * 2048 + k * 1024); } while (0)
#define PG8_LDB(dst, b, h) do { _Pragma("unroll") for (int n = 0; n < 2; ++n) _Pragma("unroll") for (int k = 0; k < 2; ++k) dst[n][k] = *(const PG8_LAS bf16x8*)(lds + PG8_SB(b, h) + boff + n * 2048 + k * 1024); } while (0)
#define PG8_MMA(ai, bj, At, Bt) do { __builtin_amdgcn_s_setprio(1); \
        if constexpr (ES == 2) { _Pragma("unroll") for (int m = 0; m < 4; ++m) _Pragma("unroll") for (int n = 0; n < 2; ++n) _Pragma("unroll") for (int k = 0; k < 2; ++k) \
            acc[ai][bj][m][n] = __builtin_amdgcn_mfma_f32_16x16x32_bf16(Bt[n][k], At[m][k], acc[ai][bj][m][n], 0, 0, 0); } \
        else { asm volatile("s_nop 1"); _Pragma("unroll") for (int m = 0; m < 4; ++m) _Pragma("unroll") for (int n = 0; n < 2; ++n) \
            asm volatile("v_mfma_f32_16x16x128_f8f6f4 %0, %1, %2, %0" : "+v"(acc[ai][bj][m][n]) : "v"(__builtin_bit_cast(v8i32, Bt[n])), "v"(__builtin_bit_cast(v8i32, At[m]))); } \
        __builtin_amdgcn_s_setprio(0); } while (0)
#define PG8_WAIT_V(n) asm volatile("s_waitcnt vmcnt(" #n ")" ::: "memory")
#define PG8_WAIT_L(n) asm volatile("s_waitcnt lgkmcnt(" #n ")" ::: "memory")
#define PG8_BAR __builtin_amdgcn_s_barrier()
#define PG8_SCHED __builtin_amdgcn_sched_barrier(0)
#define PG8_GLOAD(dst, ui_) do { _Pragma("unroll") for (int _h = 0; _h < 2; ++_h) _Pragma("unroll") for (int _i = 0; _i < 2; ++_i) \
        dst[_h][_i] = (unsigned)tab[(ui_) * 256 + _h * 128 + Rst[_i]] * (unsigned)lda + (unsigned)Cst[_i]; } while (0)
    const int sc8 = 0x7f7f7f7f;
    (void)sc8;
    Unit cur, nxt; int ui = 0;
    if (!S.next(0, cur)) return;
    f32x4 acc[2][2][4][2];
#pragma unroll
    for (int a = 0; a < 2; ++a)
#pragma unroll
        for (int b = 0; b < 2; ++b)
#pragma unroll
            for (int m = 0; m < 4; ++m)
#pragma unroll
                for (int n = 0; n < 2; ++n) acc[a][b][m][n] = (f32x4){0.f, 0.f, 0.f, 0.f};
    Frag2 At[4], B0[2], B1[2];
    unsigned gcur[2][2], gnxt[2][2];
    if constexpr (GATHER) { PG8_GLOAD(gcur, 0); } else {
#pragma unroll
        for (int h = 0; h < 2; ++h)
#pragma unroll
            for (int i = 0; i < 2; ++i) { gcur[h][i] = voffA[i]; gnxt[h][i] = voffA[i]; } }
    const char* cA = (const char*)g.A + (size_t)(GATHER ? 0 : cur.arow) * lda + (size_t)cur.acol * ES; const char* cB = (const char*)g.Bt + (size_t)cur.brow * ldb;
    const char* cB2 = cur.ksplit ? (const char*)g.Bt + (size_t)cur.brow2 * ldb - (size_t)cur.ksplit * kstep : cB; int ksp = cur.ksplit ? cur.ksplit : (1 << 30);
    int pend = -1;
    if constexpr (HO == 2) { if (wid == 0) ho_acquire(g.hcnt, cur.pm, g.hneed); __syncthreads(); }
    PG8_STAGE(PG8_SB(0, 0), cB, voffB); PG8_STAGE(PG8_SB(0, 1), cB + hstepB, voffB); PG8_STAGE(PG8_SA(0, 0), cA, gcur[0]); PG8_STAGE(PG8_SA(0, 1), cA + hstepA, gcur[1]);
    if (wr == 1) PG8_BAR;
    PG8_WAIT_V(2); PG8_BAR;
    PG8_STAGE(PG8_SB(1, 0), cB + kstep, voffB); PG8_STAGE(PG8_SA(1, 0), cA + kstep, gcur[0]); PG8_STAGE(PG8_SB(1, 1), cB + hstepB + kstep, voffB);
    PG8_WAIT_V(6); PG8_BAR;
    for (;;) {
        const bool has_next = S.next(ui + 1, nxt);
        if constexpr (HO == 2) { if (has_next && wid == 0) ho_acquire(g.hcnt, nxt.pm, g.hneed); }
        const char* nA = has_next ? (const char*)g.A + (size_t)(GATHER ? 0 : nxt.arow) * lda + (size_t)nxt.acol * ES : cA; const char* nB = has_next ? (const char*)g.Bt + (size_t)nxt.brow * ldb : cB;
        if constexpr (GATHER) { if (has_next) { PG8_GLOAD(gnxt, ui + 1); } else {
#pragma unroll
            for (int h = 0; h < 2; ++h)
#pragma unroll
                for (int i = 0; i < 2; ++i) gnxt[h][i] = gcur[h][i]; } }
#pragma nounroll
        for (int t = 0; t < nt; t += 2) {
            const bool last = (t == nt - 2);
            const char* a1 = cA + (size_t)(t + 1) * kstep;
            const char* a2 = last ? nA : cA + (size_t)(t + 2) * kstep; const char* b2 = last ? nB : (t + 2 >= ksp ? cB2 : cB) + (size_t)(t + 2) * kstep;
            const char* a3 = a2 + kstep; const char* b3 = b2 + kstep;
            unsigned s0[2], s1[2];
#pragma unroll
            for (int i = 0; i < 2; ++i) { s0[i] = (GATHER && last) ? gnxt[0][i] : gcur[0][i]; s1[i] = (GATHER && last) ? gnxt[1][i] : gcur[1][i]; }
            PG8_LDB(B0, 0, 0); PG8_LDB(B1, 0, 1); PG8_SCHED; PG8_LDA(At, 0, 0); PG8_STAGE(PG8_SA(1, 1), a1 + hstepA, gcur[1]);
            PG8_WAIT_V(8); PG8_WAIT_L(0); PG8_BAR; PG8_MMA(0, 0, At, B0); PG8_MMA(0, 1, At, B1); PG8_BAR; PG8_SCHED;
            PG8_LDA(At, 0, 1); PG8_STAGE(PG8_SB(0, 0), b2, voffB); PG8_STAGE(PG8_SB(0, 1), b2 + hstepB, voffB); PG8_STAGE(PG8_SA(0, 0), a2, s0);
            PG8_WAIT_V(8); PG8_WAIT_L(0); PG8_BAR; PG8_MMA(1, 0, At, B0); PG8_MMA(1, 1, At, B1); PG8_BAR; PG8_SCHED;
            PG8_LDB(B0, 1, 0); PG8_LDB(B1, 1, 1); PG8_SCHED; PG8_LDA(At, 1, 0); PG8_STAGE(PG8_SA(0, 1), a2 + hstepA, s1);
            PG8_WAIT_V(8); PG8_WAIT_L(0); PG8_BAR; PG8_MMA(0, 0, At, B0); PG8_MMA(0, 1, At, B1); PG8_BAR; PG8_SCHED;
            PG8_LDA(At, 1, 1); PG8_STAGE(PG8_SB(1, 0), b3, voffB); PG8_STAGE(PG8_SB(1, 1), b3 + hstepB, voffB); PG8_STAGE(PG8_SA(1, 0), a3, s0);
            PG8_WAIT_V(8); PG8_WAIT_L(0); PG8_BAR; PG8_MMA(1, 0, At, B0); PG8_MMA(1, 1, At, B1); PG8_BAR; PG8_SCHED;
        }
        if (wr == 0) PG8_BAR;
        if constexpr (HO == 1) { if (pend >= 0 && tid == 0) ho_publish(g.hcnt, pend); }
        if constexpr (ES == 1) asm volatile("s_nop 15\n\ts_nop 15" ::: "memory");
        E(acc, cur, wr, wc, fr, fq);
        if constexpr (HO == 1) pend = cur.pm;
        if (!has_next) break;
#pragma unroll
        for (int a = 0; a < 2; ++a)
#pragma unroll
            for (int b = 0; b < 2; ++b)
#pragma unroll
                for (int m = 0; m < 4; ++m)
#pragma unroll
                    for (int n = 0; n < 2; ++n) acc[a][b][m][n] = (f32x4){0.f, 0.f, 0.f, 0.f};
        cur = nxt; cA = nA; cB = nB; ++ui;
        cB2 = cur.ksplit ? (const char*)g.Bt + (size_t)cur.brow2 * ldb - (size_t)cur.ksplit * kstep : cB; ksp = cur.ksplit ? cur.ksplit : (1 << 30);
        if constexpr (GATHER) {
#pragma unroll
            for (int h = 0; h < 2; ++h)
#pragma unroll
                for (int i = 0; i < 2; ++i) gcur[h][i] = gnxt[h][i]; }
        if (wr == 1) PG8_BAR;
    }
    PG8_WAIT_V(0);
    PG8_BAR;
    if constexpr (HO == 1) { if (pend >= 0 && tid == 0) ho_publish(g.hcnt, pend); }
#undef PG8_SA
#undef PG8_SB
#undef PG8_STAGE
#undef PG8_LDA
#undef PG8_LDB
#undef PG8_MMA
#undef PG8_WAIT_V
#undef PG8_WAIT_L
#undef PG8_BAR
#undef PG8_SCHED
#undef PG8_GLOAD
}
}
namespace attn8 {
using f32x16 = __attribute__((ext_vector_type(16))) float;
using f32x4 = __attribute__((ext_vector_type(4))) float;
using u32x4 = __attribute__((ext_vector_type(4))) unsigned;
using v8i32 = __attribute__((ext_vector_type(8))) int;
constexpr int NHEAD = 16, SEQ = 4096, KVSEQ = 4352, DMQ = 1024, DMK = 256, NT = KVSEQ / 64;
constexpr float QS = 2.0f * 1.4426950408889634f, KS = 0.5f, VS = 8.0f, PS = 16.0f, OS = 4.0f;
constexpr float CS = 0.125f * 1.4426950408889634f / (QS * KS);
constexpr int THRL = 4;
constexpr int SLOTB = 4096, LDS_BYTES = 16 * SLOTB + 8 * 256 + 8 * 4096;
__host__ __device__ __forceinline__ int crow(int r, int hi) { return (r & 3) + 8 * (r >> 2) + 4 * hi; }
__host__ __device__ __forceinline__ int vpos(int kk) { return 32 * ((kk >> 2) & 1) + (kk & 3) + 4 * ((kk >> 3) & 3) + 16 * (kk >> 5); }
__device__ __forceinline__ void glds16(const void* gsrc, unsigned lds_dst) { unsigned keep;
    asm volatile("s_mov_b32 %0, m0\n\ts_mov_b32 m0, %2\n\ts_nop 0\n\tglobal_load_lds_dwordx4 %1, off\n\ts_mov_b32 m0, %0" : "=&s"(keep) : "v"(gsrc), "s"(lds_dst) : "memory"); }
#define A8_WAIT_BAR(N) asm volatile("s_waitcnt vmcnt(" #N ") lgkmcnt(0)\n\ts_barrier" ::: "memory")
__device__ __forceinline__ unsigned pk4(float a, float b, float c, float d) { unsigned w = 0u; w = (unsigned)__builtin_amdgcn_cvt_pk_fp8_f32(a, b, (int)w, false); w = (unsigned)__builtin_amdgcn_cvt_pk_fp8_f32(c, d, (int)w, true); return w; }
typedef __attribute__((address_space(3))) const unsigned char* lds_cptr;

__device__ __forceinline__ float max3f(float a, float b, float c) { float r; asm("v_max3_f32 %0, %1, %2, %3" : "=v"(r) : "v"(a), "v"(b), "v"(c)); return r; }
__device__ __forceinline__ unsigned pk4a(float a, float b, float c, float d) { unsigned w; asm("v_cvt_pk_fp8_f32 %0, %1, %2\n\tv_cvt_pk_fp8_f32 %0, %3, %4 op_sel:[0,0,1]" : "=&v"(w) : "v"(a), "v"(b), "v"(c), "v"(d)); return w; }
constexpr int NSLOTV = 4;
constexpr int LDS2_K = 0, LDS2_V = 8 * SLOTB, LDS2_WS = LDS2_V + 8 * SLOTB, LDS2_OST = LDS2_WS + 8 * 256, LDS2_BYTES = LDS2_OST + 8 * 4096;
__device__ __forceinline__ void attn_unit(int b, int h, int qb, bool first, bool has_next, int nb, int nh, const unsigned char* Q8, const unsigned char* K8, const unsigned char* Vt8, unsigned char* O8, char* shm) {
    const int tid = threadIdx.x, lane = tid & 63, r32 = lane & 31, hi = lane >> 5; const int wid = __builtin_amdgcn_readfirstlane(tid >> 6);
    const int kvh = h >> 2, q0 = qb * 256;
    const unsigned lds0 = (unsigned)(uintptr_t)shm;
    float* wsf = (float*)(shm + LDS2_WS) + wid * 64;
    const unsigned char* qp = Q8 + (size_t)((size_t)b * SEQ + q0 + wid * 32 + r32) * DMQ + h * 64 + 32 * hi;
    const u32x4 qa = *(const u32x4*)qp, qb4 = *(const u32x4*)(qp + 16);
    const v8i32 q8 = {(int)qa.x, (int)qa.y, (int)qa.z, (int)qa.w, (int)qb4.x, (int)qb4.y, (int)qb4.z, (int)qb4.w};
    const int w4 = wid & 3, drow = w4 * 16 + (lane >> 2), dc = (lane & 3) ^ ((drow >> 2) & 3);
    const bool isk = wid < 4;
    const unsigned char* dsrc = isk ? K8 + ((size_t)b * KVSEQ + drow) * DMK + kvh * 64 + dc * 16 : Vt8 + ((size_t)(b * 4 + kvh) * 64 + drow) * KVSEQ + dc * 16;
    const size_t dstep = isk ? (size_t)64 * DMK : (size_t)64;
    const unsigned ddst = lds0 + (isk ? LDS2_K : LDS2_V) + w4 * 1024;
#define A8_DMA(t, slot) glds16(dsrc + (size_t)(t) * dstep, (unsigned)__builtin_amdgcn_readfirstlane(ddst + (slot)))
    if (first) { A8_DMA(0, 0); A8_DMA(1, SLOTB); A8_DMA(2, 2 * SLOTB); if (isk) { A8_DMA(3, 3 * SLOTB); A8_DMA(4, 4 * SLOTB); A8_DMA(5, 5 * SLOTB); } }
    const int sw = (r32 >> 2) & 3, fo0 = r32 * 64 + (((2 * hi) ^ sw) << 4), fo1 = r32 * 64 + (((2 * hi + 1) ^ sw) << 4);
    const lds_cptr kb = (lds_cptr)shm + LDS2_K, vb = (lds_cptr)shm + LDS2_V;
    typedef const __attribute__((address_space(3))) u32x4* lds_v4;
#define A8_FRAG(dst, base, off) do { const u32x4 a_ = *(lds_v4)((base) + (off) + fo0), b_ = *(lds_v4)((base) + (off) + fo1); \
        dst = (v8i32){(int)a_.x, (int)a_.y, (int)a_.z, (int)a_.w, (int)b_.x, (int)b_.y, (int)b_.z, (int)b_.w}; } while (0)
    constexpr float LP = 4.0f, DB = 55.66f, DTH = 8.0f * (LP + (float)THRL) + DB;
    float mhat = 0.f; f32x16 o0 = f32x16{}, o1 = f32x16{}; f32x4 ls4 = f32x4{};
    f32x16 cb; { const float c_ = 8.0f * LP + DB;
#pragma unroll
      for (int r = 0; r < 16; ++r) cb[r] = c_; }
    constexpr int sc1 = 0, scq = 0;
    const int selv = (((lane >> 4) & 1) == ((lane & 15) >> 3)) ? 0x38383838 : 0; const v8i32 sel = {selv, selv, selv, selv, selv, selv, selv, selv};
    const int qs0 = 4 * (lane >> 4) + 16 * ((lane & 15) >> 3);
    A8_WAIT_BAR(0);
    f32x16 c0, c1;
    v8i32 ka0, ka1, kb0, kb1;
    A8_FRAG(ka0, kb + SLOTB, 0); A8_FRAG(ka1, kb + SLOTB, 2048);
    { v8i32 kf0, kf1; A8_FRAG(kf0, kb, 0); A8_FRAG(kf1, kb, 2048);
      c0 = __builtin_amdgcn_mfma_scale_f32_32x32x64_f8f6f4(kf0, q8, cb, 0, 0, 0, scq, 0, sc1);
      c1 = __builtin_amdgcn_mfma_scale_f32_32x32x64_f8f6f4(kf1, q8, cb, 0, 0, 0, scq, 0, sc1); }
    asm volatile("s_nop 15\n\ts_nop 15\n\ts_nop 15\n\ts_nop 15\n\ts_nop 15\n\ts_nop 15" : "+v"(c0), "+v"(c1));
    v8i32 p8 = {0, 0, 0, 0, 0, 0, 0, 0};
    f32x16 d0, d1;
#define A8_STEP(S0, S1, N0, N1, KC0, KC1, KN0, KN1, t, SOFTMAX, BAR) do { \
        if (BAR) { A8_WAIT_BAR(0);                                                     \
            _Pragma("unroll") for (int i_ = 0; i_ < 4; ++i_) { const int tk_ = (t) + 6 + i_, tv_ = (t) + 3 + i_; \
                if (isk) { if (tk_ < NT) A8_DMA(tk_, (tk_ & 7) * SLOTB); } else { if (tv_ < NT) A8_DMA(tv_, (tv_ & 7) * SLOTB); } } } \
        v8i32 vf0, vf1; \
        { const lds_cptr kp_ = kb + (((t) + 2) & 7) * SLOTB; A8_FRAG(KN0, kp_, 0); A8_FRAG(KN1, kp_, 2048); }     \
        { const lds_cptr vp_ = vb + (((t) == 0 ? 0 : (t) - 1) & 7) * SLOTB; A8_FRAG(vf0, vp_, 0); A8_FRAG(vf1, vp_, 2048); }     \
        __builtin_amdgcn_sched_barrier(0); \
        float rmc; \
        { float a = fmaxf(S0[0], S1[0]), bq = fmaxf(S0[1], S1[1]); \
          _Pragma("unroll") for (int r = 2; r < 16; r += 2) { a = __builtin_fmaxf(__builtin_fmaxf(a, S0[r]), S1[r]); bq = __builtin_fmaxf(__builtin_fmaxf(bq, S0[r + 1]), S1[r + 1]); } \
          rmc = fmaxf(a, bq); } \
        { auto rr = __builtin_amdgcn_permlane32_swap(__float_as_uint(rmc), __float_as_uint(rmc), false, false); rmc = fmaxf(__uint_as_float(rr[0]), __uint_as_float(rr[1])); } \
        __builtin_amdgcn_sched_barrier(0); \
        N0 = __builtin_amdgcn_mfma_scale_f32_32x32x64_f8f6f4(KC0, q8, cb, 0, 0, 0, scq, 0, sc1); \
        N1 = __builtin_amdgcn_mfma_scale_f32_32x32x64_f8f6f4(KC1, q8, cb, 0, 0, 0, scq, 0, sc1); \
        o0 = __builtin_amdgcn_mfma_scale_f32_32x32x64_f8f6f4(p8, vf0, o0, 0, 0, 0, sc1, 0, sc1); \
        o1 = __builtin_amdgcn_mfma_scale_f32_32x32x64_f8f6f4(p8, vf1, o1, 0, 0, 0, sc1, 0, sc1); \
        ls4 = __builtin_amdgcn_mfma_scale_f32_16x16x128_f8f6f4(p8, sel, ls4, 0, 0, 0, sc1, 0, sc1); \
        __builtin_amdgcn_sched_barrier(0); \
        if (SOFTMAX) { \
            bool resc = false; \
            if ((t) == 0 || __any(rmc > DTH)) {                                       \
                const float dl = ((t) == 0) ? (rmc - DB) * 0.125f - LP : fmaxf((rmc - DB) * 0.125f - LP, 0.f); mhat += dl; const float dl8 = 8.0f * dl; \
                _Pragma("unroll") for (int r = 0; r < 16; ++r) { S0[r] -= dl8; S1[r] -= dl8; N0[r] -= dl8; N1[r] -= dl8; cb[r] -= dl8; } \
                const float f = __builtin_amdgcn_exp2f(-dl); if (hi == 0) wsf[r32] = f; resc = true; } \
            _Pragma("unroll") for (int g = 0; g < 4; ++g) { unsigned wa = __builtin_amdgcn_cvt_pk_u8_f32(S0[4 * g], 0, 0u), wb = __builtin_amdgcn_cvt_pk_u8_f32(S1[4 * g], 0, 0u); \
                _Pragma("unroll") for (int j = 1; j < 4; ++j) { wa = __builtin_amdgcn_cvt_pk_u8_f32(S0[4 * g + j], j, wa); wb = __builtin_amdgcn_cvt_pk_u8_f32(S1[4 * g + j], j, wb); } \
                p8[g] = (int)wa; p8[4 + g] = (int)wb; } \
            if (resc) { asm volatile("s_waitcnt lgkmcnt(0)" ::: "memory"); \
                _Pragma("unroll") for (int r = 0; r < 16; ++r) { const float f = wsf[crow(r, hi)]; o0[r] *= f; o1[r] *= f; } \
                _Pragma("unroll") for (int i = 0; i < 4; ++i) ls4[i] *= wsf[qs0 + i]; } \
        } \
    } while (0)
    static_assert(NT % 4 == 0, "groups of four tiles");
#pragma nounroll
    for (int t = 0; t < NT; t += 4) {
        A8_STEP(c0, c1, d0, d1, ka0, ka1, kb0, kb1, t, true, true);
        A8_STEP(d0, d1, c0, c1, kb0, kb1, ka0, ka1, t + 1, true, false);
        A8_STEP(c0, c1, d0, d1, ka0, ka1, kb0, kb1, t + 2, true, false);
        A8_STEP(d0, d1, c0, c1, kb0, kb1, ka0, ka1, t + 3, true, false);
    }
    A8_STEP(c0, c1, d0, d1, ka0, ka1, kb0, kb1, NT, false, true);
#undef A8_STEP
    asm volatile("s_waitcnt lgkmcnt(0)\n\ts_barrier" ::: "memory");
    if (has_next) { const int nkvh = nh >> 2;
        const unsigned char* nsrc = isk ? K8 + ((size_t)nb * KVSEQ + drow) * DMK + nkvh * 64 + dc * 16 : Vt8 + ((size_t)(nb * 4 + nkvh) * 64 + drow) * KVSEQ + dc * 16;
#define A8_DMAN(t, slot) glds16(nsrc + (size_t)(t) * dstep, (unsigned)__builtin_amdgcn_readfirstlane(ddst + (slot)))
        A8_DMAN(0, 0); A8_DMAN(1, SLOTB); A8_DMAN(2, 2 * SLOTB); if (isk) { A8_DMAN(3, 3 * SLOTB); A8_DMAN(4, 4 * SLOTB); A8_DMAN(5, 5 * SLOTB); }
#undef A8_DMAN
    }
    if ((lane & 7) == 0) {
#pragma unroll
        for (int i = 0; i < 4; ++i) wsf[32 + qs0 + i] = ls4[i]; }
    asm volatile("s_waitcnt lgkmcnt(0)" ::: "memory");
    unsigned char* Ow = O8 + (size_t)((size_t)b * SEQ + q0 + wid * 32) * DMQ + h * 64;
    { unsigned char* stg = (unsigned char*)(shm + LDS2_OST) + wid * 4096;
#pragma unroll
      for (int r = 0; r < 16; ++r) { const int orow = crow(r, hi); const float rl = __builtin_amdgcn_rcpf(wsf[32 + orow]) * (OS / VS);
          const float a = o0[r] * rl, c = o1[r] * rl;
          stg[orow * 64 + r32] = (unsigned char)__builtin_amdgcn_cvt_pk_fp8_f32(a, a, 0, false); stg[orow * 64 + 32 + r32] = (unsigned char)__builtin_amdgcn_cvt_pk_fp8_f32(c, c, 0, false); }
      asm volatile("s_waitcnt lgkmcnt(0)" ::: "memory");
#pragma unroll
      for (int i = 0; i < 2; ++i) { const int row = i * 16 + (lane >> 2), ch = lane & 3; const u32x4 v = *(const u32x4*)(stg + row * 64 + ch * 16); *(u32x4*)(Ow + (size_t)row * DMQ + ch * 16) = v; } }
    asm volatile("s_waitcnt lgkmcnt(0)" ::: "memory");
#undef A8_DMA
#undef A8_FRAG
}
struct Tensors { const unsigned char* Q8; const unsigned char* K8; const unsigned char* Vt8; unsigned char* O8; };
__device__ __forceinline__ void attn_phase(char* lds, const Tensors& T, int grid, int block) {
    const int vcu = (grid % 8 == 0) ? (block % 8) * (grid / 8) + block / 8 : block;
    const int n = (grid == 256) ? 8 : (vcu < 2048 ? (2048 - vcu + grid - 1) / grid : 0);
    for (int i = 0; i < n; ++i) {
        const int idx = (grid == 256) ? (vcu >> 5) * 256 + i * 32 + (vcu & 31) : i * grid + vcu;
        const int idn = (grid == 256) ? (vcu >> 5) * 256 + (i + 1) * 32 + (vcu & 31) : (i + 1) * grid + vcu;
        const int b = idx >> 8, r = idx & 255, rn = idn & 255;
        attn_unit(b, (r >> 6) * 4 + ((r >> 4) & 3), r & 15, i == 0, i + 1 < n, idn >> 8, (rn >> 6) * 4 + ((rn >> 4) & 3), T.Q8, T.K8, T.Vt8, T.O8, lds);
    }
}
#undef A8_WAIT_BAR
}
namespace pg8 {
struct SchedDense {
    int nM, nN, G, c;
    __device__ __forceinline__ bool next(int i, Unit& u) const {
        const int L = i * G + c; if (L >= nM * nN) return false;
        tile_of(L, nM, nN, u.pm, u.pn); u.arow = u.pm * BM; u.acol = 0; u.brow = u.pn * BM; u.x0 = 0; u.x1 = 0; u.x2 = 0; u.ord = i; u.brow2 = 0; u.ksplit = 0; return true; }
};
struct SchedOut {
    int G, c, E;
    __device__ __forceinline__ bool next(int i, Unit& u) const {
        u.acol = 0; u.x0 = 0; u.x1 = 0; u.x2 = 0; u.ord = i; u.brow2 = 0; u.ksplit = 0;
        if (E == 0) { const int L = i * G + c; if (L >= (MT / 256) * 4) return false; tile_of(L, MT / 256, 4, u.pm, u.pn); }
        else { const bool early = c >= G - E;
            if (early && i < 2) { const int e = c - (G - E), m = (e >> 3) + (E >> 3) * i; u.pm = 6 * (e & 7) + (m >> 2); u.pn = m & 3; }
            else { const int L = (early ? i - 2 : i) * G + c, nM = MT / 256 - E / 2; if (L >= nM * 4) return false; int pm_; tile_of(L, nM, 4, pm_, u.pn); u.pm = E / 2 + pm_; } }
        u.arow = u.pm * BM; u.brow = u.pn * BM; return true; }
};
__host__ __device__ __forceinline__ int in_gs(int g) { return g == 0 ? 0 : 1 + 27 * g; }
struct SchedIn {
    int G, c, E;
    __device__ __forceinline__ int cl() const { return E ? (c + E) % G : c; }
    __device__ __forceinline__ bool next(int i, Unit& u) const {
        u.acol = 0; u.x0 = 0; u.x1 = 0; u.x2 = 0; u.ord = i; u.brow2 = 0; u.ksplit = 0;
        if (E == 0) { const int L = i * G + c; if (L >= (MT / 256) * 8) return false; tile_of(L, MT / 256, 8, u.pm, u.pn); }
        else { const bool early = c >= G - E;
            if (early && i < 2) { const int e = c - (G - E), m = (e >> 3) + (E >> 3) * i, ep = 3 * (e & 7) + (m >> 3); u.pm = in_gs(ep % 5) + ep / 5; u.pn = m & 7; }
            else { const int L = (early ? i - 2 : i) * G + cl(); if (L >= 112 * 8) return false; int r; tile_of(L, 112, 8, r, u.pn);
                const int g = (r >= 23) + (r >= 45) + (r >= 67) + (r >= 89), base = g == 0 ? 0 : 1 + 22 * g;
                u.pm = in_gs(g) + (g < 4 ? 5 : 4) + (r - base); } }
        u.arow = u.pm * BM; u.brow = u.pn * BM; return true; }
};
struct SchedGates {
    int nM, G, c;
    __device__ __forceinline__ bool next(int i, Unit& u) const {
        const int L = i * G + c; if (L >= nM * 16) return false;
        tile_of(L, nM, 16, u.pm, u.pn); u.arow = u.pm * BM; u.acol = (u.pn >> 1) * 128; u.brow = u.pn * BM; u.x0 = 0; u.x1 = 0; u.x2 = 0; u.ord = i; u.brow2 = 0; u.ksplit = 0; return true; }
};
struct SchedQKV {
    int G, c;
    __device__ __forceinline__ bool next(int i, Unit& u) const {
        const int L = i * G + c; if (L >= 128 * 6 + 16) return false;
        if (L < 768) tile_of(L, 128, 6, u.pm, u.pn); else { const int j = L - 768; u.pm = 128 + (j >> 1); u.pn = 4 + (j & 1); }
        u.arow = u.pm * BM; u.acol = 0; u.brow = u.pn * BM; u.x0 = 0; u.x1 = 0; u.x2 = 0; u.ord = i; u.brow2 = 0; u.ksplit = 0; return true; }
};
template <bool UP>
struct SchedMoe {
    unsigned cnt[24]; int G, c, total;
    __device__ __forceinline__ void init(const unsigned* cw, int G_, int c_) {
        int acc = 0;
#pragma unroll
        for (int j = 0; j < 24; ++j) { cnt[j] = (unsigned)__builtin_amdgcn_readfirstlane((int)__hip_atomic_load(cw + j, __ATOMIC_RELAXED, __HIP_MEMORY_SCOPE_AGENT)); acc += (int)((cnt[j] + 255u) >> 8); }
        total = acc * (UP ? 8 : 4); G = G_; c = c_;
    }
    __device__ __forceinline__ bool next(int i, Unit& u) const {
        const int L = i * G + c; if (L >= total) return false;
        const int tl = UP ? (L >> 3) : (L >> 2), pn = UP ? (L & 7) : (L & 3); int gid = 0, base = 0, acc = 0; unsigned ce = cnt[0];
#pragma unroll
        for (int j = 0; j < 24; ++j) { const int tj = (int)((cnt[j] + 255u) >> 8); if (tl >= acc) { gid = j; base = acc; ce = cnt[j]; } acc += tj; }
        const int grp = gid / 6, pid = gid - 6 * grp, ea = 4 * grp + (pid < 3 ? 0 : pid < 5 ? 1 : 2), eb = 4 * grp + (pid < 3 ? pid + 1 : pid < 5 ? pid - 1 : 3);
        u.pm = tl; u.pn = pn; u.arow = tl * BM; u.acol = 0; u.x0 = gid; u.x2 = (tl - base) * BM; u.x1 = (int)ce - u.x2; u.ord = i;
        if (UP) { u.brow = (pn < 4 ? ea : eb) * 1024 + (pn & 3) * BM; u.brow2 = 0; u.ksplit = 0; }
        else { u.brow = ea * 1024 + pn * BM; u.brow2 = eb * 1024 + pn * BM; u.ksplit = 4; }
        return true;
    }
};

__device__ __forceinline__ unsigned pk4_fp8(float a, float b, float c, float d) { unsigned w = 0u; w = (unsigned)__builtin_amdgcn_cvt_pk_fp8_f32(a, b, (int)w, false); w = (unsigned)__builtin_amdgcn_cvt_pk_fp8_f32(c, d, (int)w, true); return w; }
constexpr float W8_SCALE = 32.0f, ACT8_SCALE = 4.0f, Y8_SCALE = 8.0f, BB8_SCALE = 16.0f, LA8_SCALE = 256.0f;
struct EpiInProj {
    static constexpr bool PERM = true;
    bf16_t* Gb; bf16_t* Ub;
    __device__ __forceinline__ void operator()(const f32x4 (&acc)[2][2][4][2], const Unit& u, int wr, int wc, int fr, int fq) const {
        const bool isg = u.pn < 4; bf16_t* base = isg ? Gb : Ub; const int colt = (isg ? u.pn : u.pn - 4) * BM + wc * 32 + 8 * fq;
#pragma unroll
        for (int ai = 0; ai < 2; ++ai)
#pragma unroll
            for (int m = 0; m < 4; ++m) { bf16_t* rowp = base + (size_t)(u.pm * BM + ai * HALF + wr * 64 + m * 16 + fr) * 1024 + colt;
#pragma unroll
                for (int bj = 0; bj < 2; ++bj) { f32x4 v0 = acc[ai][bj][m][0], v1 = acc[ai][bj][m][1];
                    if (isg) {
                        const f32x4 e0 = (v0 * v0 * (-2.302208198f * 0.044715f) + -2.302208198f) * v0, e1 = (v1 * v1 * (-2.302208198f * 0.044715f) + -2.302208198f) * v1;
                        const f32x4 d0 = (f32x4){__builtin_amdgcn_exp2f(e0[0]), __builtin_amdgcn_exp2f(e0[1]), __builtin_amdgcn_exp2f(e0[2]), __builtin_amdgcn_exp2f(e0[3])} + 1.0f;
                        const f32x4 d1 = (f32x4){__builtin_amdgcn_exp2f(e1[0]), __builtin_amdgcn_exp2f(e1[1]), __builtin_amdgcn_exp2f(e1[2]), __builtin_amdgcn_exp2f(e1[3])} + 1.0f;
                        v0 = v0 * (f32x4){__builtin_amdgcn_rcpf(d0[0]), __builtin_amdgcn_rcpf(d0[1]), __builtin_amdgcn_rcpf(d0[2]), __builtin_amdgcn_rcpf(d0[3])};
                        v1 = v1 * (f32x4){__builtin_amdgcn_rcpf(d1[0]), __builtin_amdgcn_rcpf(d1[1]), __builtin_amdgcn_rcpf(d1[2]), __builtin_amdgcn_rcpf(d1[3])}; }
                    u32x4 w; w.x = cvt_pk_bf16(v0[0], v0[1]); w.y = cvt_pk_bf16(v0[2], v0[3]); w.z = cvt_pk_bf16(v1[0], v1[1]); w.w = cvt_pk_bf16(v1[2], v1[3]);
                    *(u32x4*)(rowp + bj * HALF) = w; } }
    }
};
struct EpiGates {
    static constexpr bool PERM = true;
    const bf16_t* UC; unsigned char* LB[2]; const float* ga_b; const float* gx_b; const float* lam;
    __device__ __forceinline__ void operator()(const f32x4 (&acc)[2][2][4][2], const Unit& u, int wr, int wc, int fr, int fq) const {
        const int d = u.pn & 1, c0 = (u.pn >> 1) * 128 + wc * 32 + 8 * fq;
        typedef float f32x2 __attribute__((ext_vector_type(2)));
        f32x2 ba[4], bx[4], sp2[4];
#pragma unroll
        for (int j = 0; j < 8; ++j) { ba[j >> 1][j & 1] = -1.4426950408889634f * ga_b[d * 1024 + c0 + j]; bx[j >> 1][j & 1] = -1.4426950408889634f * gx_b[d * 1024 + c0 + j]; const float l = lam[d * 1024 + c0 + j];
            const float ex = __expf(-l); const float spv = (ex < 0.05f) ? ex * (1.0f - ex * (0.5f - ex * (0.33333334f - 0.25f * ex))) : __logf(1.0f + ex); const float sp = -8.0f * 1.4426950408889634f * spv;
            sp2[j >> 1][j & 1] = 2.0f * sp; }
        unsigned char* lb = d ? LB[1] : LB[0];
#pragma unroll
        for (int ai = 0; ai < 2; ++ai) {
            u32x4 uva[4];
#pragma unroll
            for (int m = 0; m < 4; ++m) uva[m] = *(const u32x4*)(UC + (size_t)(u.pm * BM + ai * HALF + wr * 64 + m * 16 + fr) * 1024 + c0);
            __builtin_amdgcn_sched_barrier(0);
#pragma unroll
            for (int m = 0; m < 4; ++m) { const size_t off = (size_t)(u.pm * BM + ai * HALF + wr * 64 + m * 16 + fr) * 1024 + c0;
                const u32x4 uv = uva[m];
                const f32x2 uu[4] = {{__builtin_bit_cast(float, uv.x << 16), __builtin_bit_cast(float, uv.x & 0xffff0000u)}, {__builtin_bit_cast(float, uv.y << 16), __builtin_bit_cast(float, uv.y & 0xffff0000u)},
                                     {__builtin_bit_cast(float, uv.z << 16), __builtin_bit_cast(float, uv.z & 0xffff0000u)}, {__builtin_bit_cast(float, uv.w << 16), __builtin_bit_cast(float, uv.w & 0xffff0000u)}};
                float l2[8], bt[8];
#pragma unroll
                for (int jp = 0; jp < 4; ++jp) { const f32x2 aa = {acc[ai][0][m][jp >> 1][2 * (jp & 1)], acc[ai][0][m][jp >> 1][2 * (jp & 1) + 1]}, ax = {acc[ai][1][m][jp >> 1][2 * (jp & 1)], acc[ai][1][m][jp >> 1][2 * (jp & 1) + 1]};
                    const f32x2 za = aa + ba[jp], zx = ax + bx[jp];
                    const f32x2 da = (f32x2){__builtin_amdgcn_exp2f(za.x), __builtin_amdgcn_exp2f(za.y)} + 1.0f, q = (f32x2){__builtin_amdgcn_exp2f(zx.x), __builtin_amdgcn_exp2f(zx.y)} + 1.0f;
                    const f32x2 r = {__builtin_amdgcn_rcpf(da.x), __builtin_amdgcn_rcpf(da.y)};
                    const f32x2 t2 = sp2[jp] * r, lq = t2 * (0.5f * LA8_SCALE);
                    const f32x2 a2 = {__builtin_amdgcn_exp2f(t2.x), __builtin_amdgcn_exp2f(t2.y)};
                    f32x2 w = a2 * -(BB8_SCALE * BB8_SCALE) + (BB8_SCALE * BB8_SCALE); w.x = fmaxf(w.x, 1e-30f); w.y = fmaxf(w.y, 1e-30f);
                    const f32x2 ag = w * (q * q); const f32x2 bv = (w * (f32x2){__builtin_amdgcn_rsqf(ag.x), __builtin_amdgcn_rsqf(ag.y)}) * uu[jp];
                    l2[2 * jp] = lq.x; l2[2 * jp + 1] = lq.y; bt[2 * jp] = __builtin_amdgcn_fmed3f(bv.x, -440.f, 440.f); bt[2 * jp + 1] = __builtin_amdgcn_fmed3f(bv.y, -440.f, 440.f); }
                u32x4 w; w.x = pk4_fp8(l2[0], bt[0], l2[1], bt[1]); w.y = pk4_fp8(l2[2], bt[2], l2[3], bt[3]); w.z = pk4_fp8(l2[4], bt[4], l2[5], bt[5]); w.w = pk4_fp8(l2[6], bt[6], l2[7], bt[7]);
                *(u32x4*)(lb + 2 * off) = w; } }
    }
};
template <bool BASE_BF16>
struct EpiResid {
    static constexpr bool PERM = true;
    const float* baseL; const float* baseC; bf16_t* XB; const float* gate; float ascale;
    __device__ __forceinline__ void operator()(const f32x4 (&acc)[2][2][4][2], const Unit& u, int wr, int wc, int fr, int fq) const {
        const int row0 = u.pm * BM; const bool isl = row0 < ML;
        const float* bs = isl ? baseL + (size_t)row0 * 1024 : baseC + (size_t)(row0 - ML) * 1024; bf16_t* os = XB + (size_t)row0 * 1024;
        const float* gv = gate + (isl ? (row0 >> 12) : 8) * 6144; const int col0 = u.pn * BM + wc * 32 + 8 * fq;
        f32x4 gg[2][2];
#pragma unroll
        for (int bj = 0; bj < 2; ++bj)
#pragma unroll
            for (int n = 0; n < 2; ++n) gg[bj][n] = *(const f32x4*)(gv + col0 + bj * HALF + n * 4) * ascale;
        constexpr int MB = BASE_BF16 ? 4 : 2;
#pragma unroll
        for (int ai = 0; ai < 2; ++ai)
#pragma unroll
            for (int m0 = 0; m0 < 4; m0 += MB) {
                u32x4 wb[MB][2]; f32x4 fb[MB][2][2];
#pragma unroll
                for (int mi = 0; mi < MB; ++mi) { const size_t off = (size_t)(ai * HALF + wr * 64 + (m0 + mi) * 16 + fr) * 1024 + col0;
#pragma unroll
                    for (int bj = 0; bj < 2; ++bj) {
                        if (BASE_BF16) wb[mi][bj] = *(const u32x4*)(os + off + bj * HALF);
                        else { fb[mi][bj][0] = *(const f32x4*)(bs + off + bj * HALF); fb[mi][bj][1] = *(const f32x4*)(bs + off + bj * HALF + 4); } } }
                __builtin_amdgcn_sched_barrier(0);
#pragma unroll
                for (int mi = 0; mi < MB; ++mi) { const int m = m0 + mi; const size_t off = (size_t)(ai * HALF + wr * 64 + m * 16 + fr) * 1024 + col0;
#pragma unroll
                    for (int bj = 0; bj < 2; ++bj) { f32x4 b0, b1;
                        if (BASE_BF16) { const u32x4 w = wb[mi][bj];
                            b0 = (f32x4){__builtin_bit_cast(float, w.x << 16), __builtin_bit_cast(float, w.x & 0xffff0000u), __builtin_bit_cast(float, w.y << 16), __builtin_bit_cast(float, w.y & 0xffff0000u)};
                            b1 = (f32x4){__builtin_bit_cast(float, w.z << 16), __builtin_bit_cast(float, w.z & 0xffff0000u), __builtin_bit_cast(float, w.w << 16), __builtin_bit_cast(float, w.w & 0xffff0000u)}; }
                        else { b0 = fb[mi][bj][0]; b1 = fb[mi][bj][1]; }
                        const f32x4 v0 = b0 + gg[bj][0] * acc[ai][bj][m][0], v1 = b1 + gg[bj][1] * acc[ai][bj][m][1];
                        u32x4 o; o.x = cvt_pk_bf16(v0[0], v0[1]); o.y = cvt_pk_bf16(v0[2], v0[3]); o.z = cvt_pk_bf16(v1[0], v1[1]); o.w = cvt_pk_bf16(v1[2], v1[3]);
                        *(u32x4*)(os + off + bj * HALF) = o; } }
                __builtin_amdgcn_sched_barrier(0); }
    }
};
struct EpiNull { static constexpr bool PERM = true;
    __device__ __forceinline__ void operator()(const f32x4 (&acc)[2][2][4][2], const Unit& u, int wr, int wc, int fr, int fq) const { } };
template <bool WT = false>
struct EpiMoe1 {
    static constexpr bool PERM = true;
    unsigned char* ACT; const PG8_LAS float* tabw;
    __device__ __forceinline__ void operator()(const f32x4 (&acc)[2][2][4][2], const Unit& u, int wr, int wc, int fr, int fq) const {
        const int colt = u.pn * 128 + wc * 32 + 8 * fq;
#pragma unroll
        for (int ai = 0; ai < 2; ++ai)
#pragma unroll
            for (int m = 0; m < 4; ++m) { const int rl = ai * HALF + wr * 64 + m * 16 + fr; unsigned char* rowp = ACT + (size_t)(u.pm * BM + rl) * 1024 + colt; float o[8];
                typedef float f32x2 __attribute__((ext_vector_type(2)));
                const float gw = tabw[u.ord * 256 + rl] * (ACT8_SCALE / (W8_SCALE * W8_SCALE));
#pragma unroll
                for (int jp = 0; jp < 4; ++jp) { const f32x2 a1 = {acc[ai][0][m][jp >> 1][2 * (jp & 1)], acc[ai][0][m][jp >> 1][2 * (jp & 1) + 1]}, a3 = {acc[ai][1][m][jp >> 1][2 * (jp & 1)], acc[ai][1][m][jp >> 1][2 * (jp & 1) + 1]};
                    const f32x2 x = a1 * (-1.4426950408889634f / W8_SCALE); const f32x2 d = (f32x2){__builtin_amdgcn_exp2f(x.x), __builtin_amdgcn_exp2f(x.y)} + 1.0f;
                    const f32x2 sg = (f32x2){__builtin_amdgcn_rcpf(d.x), __builtin_amdgcn_rcpf(d.y)} * gw; const f32x2 v = (a1 * a3) * sg;
                    o[2 * jp] = __builtin_amdgcn_fmed3f(v.x, -440.f, 440.f); o[2 * jp + 1] = __builtin_amdgcn_fmed3f(v.y, -440.f, 440.f); }
                typedef unsigned u32x2 __attribute__((ext_vector_type(2)));
                u32x2 w; w.x = pk4_fp8(o[0], o[1], o[2], o[3]); w.y = pk4_fp8(o[4], o[5], o[6], o[7]);
                if (WT) __hip_atomic_store((__attribute__((address_space(1))) unsigned long long*)rowp, ((unsigned long long)w.y << 32) | (unsigned long long)w.x, __ATOMIC_RELAXED, __HIP_MEMORY_SCOPE_AGENT);
                else *(u32x2*)rowp = w; }
    }
};
template <bool FINAL>
struct EpiMoe2 {
    static constexpr bool PERM = true;
    bf16_t* XB; float* out; const float* gfm; const PG8_LAS int* tab;
    __device__ __forceinline__ void operator()(const f32x4 (&acc)[2][2][4][2], const Unit& u, int wr, int wc, int fr, int fq) const {
        const int col0 = u.pn * BM + wc * 32 + 8 * fq; constexpr float sc = 1.0f / (W8_SCALE * ACT8_SCALE);
#pragma unroll
        for (int ai = 0; ai < 2; ++ai)
#pragma unroll
            for (int m0 = 0; m0 < 4; m0 += 2) {
                int tk[2]; u32x4 xw[2][2]; f32x4 gq[2][2][2];
#pragma unroll
                for (int mi = 0; mi < 2; ++mi) { const int t_ = tab[u.ord * 256 + ai * HALF + wr * 64 + (m0 + mi) * 16 + fr]; tk[mi] = t_; const int tok = t_ < 0 ? 0 : t_;
                    const float* gv = gfm + (tok < ML ? (tok >> 12) : 8) * 6144 + col0; const bf16_t* xp = XB + (size_t)tok * 1024 + col0;
#pragma unroll
                    for (int bj = 0; bj < 2; ++bj) { xw[mi][bj] = *(const u32x4*)(xp + bj * HALF); gq[mi][bj][0] = *(const f32x4*)(gv + bj * HALF); gq[mi][bj][1] = *(const f32x4*)(gv + bj * HALF + 4); } }
                __builtin_amdgcn_sched_barrier(0);
#pragma unroll
                for (int mi = 0; mi < 2; ++mi) { const int m = m0 + mi, tok = tk[mi];
                    if (tok >= 0) { bf16_t* xp = XB + (size_t)tok * 1024 + col0;
#pragma unroll
                        for (int bj = 0; bj < 2; ++bj) { const f32x4 g0 = gq[mi][bj][0] * sc, g1 = gq[mi][bj][1] * sc; const u32x4 w = xw[mi][bj];
                            const f32x4 b0 = {__builtin_bit_cast(float, w.x << 16), __builtin_bit_cast(float, w.x & 0xffff0000u), __builtin_bit_cast(float, w.y << 16), __builtin_bit_cast(float, w.y & 0xffff0000u)};
                            const f32x4 b1 = {__builtin_bit_cast(float, w.z << 16), __builtin_bit_cast(float, w.z & 0xffff0000u), __builtin_bit_cast(float, w.w << 16), __builtin_bit_cast(float, w.w & 0xffff0000u)};
                            const f32x4 v0 = b0 + g0 * acc[ai][bj][m][0], v1 = b1 + g1 * acc[ai][bj][m][1];
                            if (FINAL) { float* op = out + (size_t)tok * 1024 + col0 + bj * HALF; __builtin_nontemporal_store(v0, (f32x4*)op); __builtin_nontemporal_store(v1, (f32x4*)(op + 4)); }
                            else { u32x4 o; o.x = cvt_pk_bf16(v0[0], v0[1]); o.y = cvt_pk_bf16(v0[2], v0[3]); o.z = cvt_pk_bf16(v1[0], v1[1]); o.w = cvt_pk_bf16(v1[2], v1[3]); *(u32x4*)(xp + bj * HALF) = o; } } } }
                __builtin_amdgcn_sched_barrier(0); }
    }
};
struct EpiQKV {
    static constexpr bool PERM = true;
    unsigned char* Q; unsigned char* Kb; unsigned char* Vt; const float* qn; const float* kn; const PG8_LAS float* rope;
    __device__ __forceinline__ void operator()(const f32x4 (&acc)[2][2][4][2], const Unit& u, int wr, int wc, int fr, int fq) const {
        typedef unsigned u32x2 __attribute__((ext_vector_type(2)));
        const int row0 = u.pm * BM; const bool isl = row0 < ML;
        if (u.pn == 5) {
#pragma unroll
            for (int ai = 0; ai < 2; ++ai)
#pragma unroll
                for (int m = 0; m < 4; ++m) { const int row = row0 + ai * HALF + wr * 64 + m * 16 + fr;
                    const int b = isl ? (row >> 12) : ((row - ML) >> 8), key = isl ? CTXL + (row & 4095) : ((row - ML) & 255);
                    unsigned char* base = Vt + (size_t)b * 4 * 64 * KVL + (size_t)(key >> 6) * 64 + attn8::vpos(key & 63);
#pragma unroll
                    for (int bj = 0; bj < 2; ++bj)
#pragma unroll
                        for (int n = 0; n < 2; ++n)
#pragma unroll
                            for (int j = 0; j < 4; ++j) { const int col = bj * HALF + wc * 32 + 8 * fq + 4 * n + j; const float v = acc[ai][bj][m][n][j] * (attn8::VS / W8_SCALE);
                                base[(size_t)col * KVL] = (unsigned char)__builtin_amdgcn_cvt_pk_fp8_f32(v, v, 0, false); } }
            return;
        }
        const bool isq = u.pn < 4; const float* nw = isq ? qn : kn; const float sc = isq ? attn8::QS : attn8::KS;
        f32x4 w1[2], w2[2];
#pragma unroll
        for (int bj = 0; bj < 2; ++bj) { w1[bj] = *(const f32x4*)(nw + 32 * bj + 4 * fq); w2[bj] = *(const f32x4*)(nw + 32 * bj + 16 + 4 * fq); }
#pragma unroll
        for (int ai = 0; ai < 2; ++ai)
#pragma unroll
            for (int m = 0; m < 4; ++m) { const int row = row0 + ai * HALF + wr * 64 + m * 16 + fr;
                f32x4 a1[2], a2[2]; float ss = 0.f;
#pragma unroll
                for (int bj = 0; bj < 2; ++bj) { a1[bj] = acc[ai][bj][m][0] * (1.0f / W8_SCALE); a2[bj] = acc[ai][bj][m][1] * (1.0f / W8_SCALE);
                    ss += (a1[bj][0] * a1[bj][0] + a1[bj][1] * a1[bj][1]) + (a1[bj][2] * a1[bj][2] + a1[bj][3] * a1[bj][3]) + (a2[bj][0] * a2[bj][0] + a2[bj][1] * a2[bj][1]) + (a2[bj][2] * a2[bj][2] + a2[bj][3] * a2[bj][3]); }
                ss += __shfl_xor(ss, 16); ss += __shfl_xor(ss, 32);
                const float rstd = __builtin_amdgcn_rsqf(ss * (1.0f / 64.0f) + EPS) * sc;
                int dest;
                if (isl) { const int t = row & 4095; const int pos[2] = {t >> 6, t & 63};
#pragma unroll
                    for (int bj = 0; bj < 2; ++bj) { const f32x4 cs = *(const PG8_LAS f32x4*)(rope + pos[bj] * 16 + 4 * fq), sn = *(const PG8_LAS f32x4*)(rope + 1024 + pos[bj] * 16 + 4 * fq);
                        const f32x4 y1 = a1[bj] * w1[bj] * rstd, y2 = a2[bj] * w2[bj] * rstd;
                        a1[bj] = y1 * cs - y2 * sn; a2[bj] = y2 * cs + y1 * sn; }
                    dest = isq ? row : (row >> 12) * KVL + CTXL + t;
                } else {
#pragma unroll
                    for (int bj = 0; bj < 2; ++bj) { a1[bj] = a1[bj] * w1[bj] * rstd; a2[bj] = a2[bj] * w2[bj] * rstd; }
                    dest = ((row - ML) >> 8) * KVL + ((row - ML) & 255);
                }
                unsigned char* rowp = isq ? Q + (size_t)dest * 1024 + (u.pn * 4 + wc) * 64 + 8 * fq : Kb + (size_t)dest * 256 + wc * 64 + 8 * fq;
#pragma unroll
                for (int bj = 0; bj < 2; ++bj) { u32x2 w; w.x = pk4_fp8(a1[bj][0], a1[bj][1], a1[bj][2], a1[bj][3]); w.y = pk4_fp8(a2[bj][0], a2[bj][1], a2[bj][2], a2[bj][3]);
                    *(u32x2*)(rowp + bj * 32) = w; } }
    }
};
}
struct Frame {
    LAS unsigned char* lds;
    volatile LAS unsigned* MISC;
    gu32* ctl;
    int tid, lane, wave, vcu, G;
    unsigned char* ws; float* out;
    const float* in[26];
};
enum { I_X = 0, I_C, I_CTX, I_CCTX, I_ADAW, I_ADAB, I_NMIX, I_NFFN, I_LIN, I_LCW, I_LCB, I_GAW, I_GAB, I_GXW, I_GXB, I_LAM, I_LOUT, I_QKV, I_QN, I_KN, I_OW, I_RW, I_RB, I_W1, I_W3, I_W2 };

__device__ __forceinline__ float wave_sum(float v) {
#pragma unroll
    for (int o = 1; o < 64; o <<= 1) v += __shfl_xor(v, o);
    return v;
}
__device__ __forceinline__ int dl_perm(int s) { return 4 * (s >> 3) + (s & 3) + ((s & 4) ? 16 : 0); }

template <bool F8 = false>
__device__ __forceinline__ void tr_item(const float* src, int ldn, int k0, int scol0, void* dstv, int ldk, int drow0, bool rp, LAS float* scr, int lane, float sc = 1.0f) {
    float tv[32];
#pragma unroll
    for (int i = 0; i < 32; ++i) { const int kk = 2 * i + (lane >> 5); tv[i] = __builtin_nontemporal_load(src + (size_t)(k0 + kk) * ldn + scol0 + (lane & 31)); }
#pragma unroll
    for (int i = 0; i < 32; ++i) { const int kk = 2 * i + (lane >> 5); scr[kk * 33 + (lane & 31)] = tv[i]; }
    LDS_WAIT(); asm volatile("" ::: "memory");
    const int c = lane & 7;
#pragma unroll
    for (int j = 0; j < 4; ++j) { const int n = (lane >> 3) + 8 * j; const int sn = rp ? dl_perm(n) : n; const LAS float* s = scr + (8 * c) * 33 + sn;
        if constexpr (F8) { v2u o; o.x = pg8::pk4_fp8(32.0f * s[0 * 33], 32.0f * s[1 * 33], 32.0f * s[2 * 33], 32.0f * s[3 * 33]); o.y = pg8::pk4_fp8(32.0f * s[4 * 33], 32.0f * s[5 * 33], 32.0f * s[6 * 33], 32.0f * s[7 * 33]);
            *(GAS v2u*)((unsigned char*)dstv + (size_t)(drow0 + n) * ldk + k0 + 8 * c) = o; }
        else { bf16* dst = (bf16*)dstv; v4u o; o.x = pk2(sc * s[0 * 33], sc * s[1 * 33]); o.y = pk2(sc * s[2 * 33], sc * s[3 * 33]); o.z = pk2(sc * s[4 * 33], sc * s[5 * 33]); o.w = pk2(sc * s[6 * 33], sc * s[7 * 33]);
            *(GAS v4u*)(dst + (size_t)(drow0 + n) * ldk + k0 + 8 * c) = o; } }
    LDS_WAIT(); asm volatile("" ::: "memory");
}

constexpr int CV_IN = 1024, CV_G = 256, CV_OUT = 512, CV_13 = 8192, CV_2 = 4096, CV_QKV = 768, CV_O = 512;
constexpr int CV_A_END = CV_IN + CV_G + CV_OUT, CV_B_END = CV_A_END + CV_13 + CV_2, CV_END = CV_B_END + CV_QKV + CV_O + CV_13 + CV_2;
__device__ __forceinline__ void conv_items(Frame& F, int lo, int hi, int gwi, int nwg) {
    LAS float* scr = (LAS float*)(F.lds + RING_OFF + 59392 + F.wave * 8704);
    for (int it = lo + gwi; it < hi; it += nwg) {
        int r = it;
        if (r < CV_IN) { const int g = r >> 4, kb = r & 15; tr_item(F.in[I_LIN], 2048, kb * 64, g * 32, (bf16*)(F.ws + WS_W_IN), 1024, g * 32, false, scr, F.lane); continue; } r -= CV_IN;
        if (r < CV_G) { const int un = r >> 4, rem = r & 15, grp = rem >> 1, kb = rem & 1, n = un >> 1, d = un & 1;
            const float* src = (grp < 4 ? F.in[I_GAW] : F.in[I_GXW]) + (size_t)(d * 8 + n) * 16384;
            tr_item(src, 128, kb * 64, (grp & 3) * 32, (bf16*)(F.ws + WS_W_G), 128, un * 256 + grp * 32, false, scr, F.lane, -1.4426950408889634f); continue; } r -= CV_G;
        if (r < CV_OUT) { const int g = r >> 4, kb = r & 15; tr_item(F.in[I_LOUT], 1024, kb * 64, g * 32, (bf16*)(F.ws + WS_W_OUT), 1024, g * 32, false, scr, F.lane); continue; } r -= CV_OUT;
        int layer = 0;
        if (r >= CV_13 + CV_2) { r -= CV_13 + CV_2;
            if (r < CV_QKV) { const int g = r >> 4, kb = r & 15, pn = g >> 3, gi = g & 7; const bool rp = pn < 5;
                const int scol0 = rp ? pn * 256 + (gi & 3) * 64 + (gi >> 2) * 32 : 1280 + gi * 32;
                tr_item<true>(F.in[I_QKV], 1536, kb * 64, scol0, F.ws + WS_W_QKV, 1024, g * 32, rp, scr, F.lane); continue; } r -= CV_QKV;
            if (r < CV_O) { const int g = r >> 4, kb = r & 15; tr_item<true>(F.in[I_OW], 1024, kb * 64, g * 32, F.ws + WS_W_O, 1024, g * 32, false, scr, F.lane); continue; } r -= CV_O;
            layer = 1; }
        if (r < CV_13) { const int le = layer * 16 + (r >> 9), rem = r & 511, g = rem >> 4, kb = rem & 15, pn = g >> 3, gi = g & 7, bj = gi >> 2, sub = gi & 3;
            const float* src = (bj ? F.in[I_W3] : F.in[I_W1]) + (size_t)le * 1024 * 512;
            tr_item<true>(src, 512, kb * 64, pn * 128 + sub * 32, F.ws + WS_W13 + (size_t)le * 1024 * 1024, 1024, g * 32, false, scr, F.lane); continue; } r -= CV_13;
        { const int le = layer * 16 + (r >> 8), rem = r & 255, g = rem >> 3, kb = rem & 7;
            tr_item<true>(F.in[I_W2] + (size_t)le * 512 * 1024, 1024, kb * 64, g * 32, F.ws + WS_W2 + (size_t)le * 1024 * 512, 512, g * 32, false, scr, F.lane); }
    }
}
__device__ __forceinline__ void conv_tail(Frame& F, int b0, int lo, int hi, int me = -1) {
    if (me < 0) me = (int)blockIdx.x;
    if (b0 >= F.G) b0 = 0;
    if (me >= b0) conv_items(F, lo, hi, (me - b0) * NWAVES + F.wave, (F.G - b0) * NWAVES);
}
constexpr int CV_T10 = 3800, CV_T11 = 2200, CV_T13 = 5600, CV_T8C = 3000;

__device__ __forceinline__ void p0_prologue(Frame& F) {
    LAS float* scond = (LAS float*)(F.lds + RING_OFF);
    LAS float* red = (LAS float*)(F.lds + RING_OFF + 40960);
    float* mod = (float*)(F.ws + WS_MOD);
    bool did = false;
    for (int unit = blockIdx.x; unit < 192; unit += F.G) {
        if (!did) { for (int idx = F.tid; idx < 9 * 1024; idx += NWAVES * 64) { const int r = idx >> 10, k = idx & 1023; const float v = r < 8 ? F.in[I_C][r * 1024 + k] : F.in[I_CCTX][k]; scond[idx] = v * sigmoid_f(v); }
            __syncthreads(); did = true; }
        const int l = unit / 96, cg = unit % 96;
        const int ks = F.lane >> 4, cq = F.lane & 15;
        f32x4 acc[9];
#pragma unroll
        for (int r = 0; r < 9; ++r) acc[r] = (f32x4){0.f, 0.f, 0.f, 0.f};
        const float* wp = F.in[I_ADAW] + ((size_t)l * 1024 + F.wave * 128 + ks) * 6144 + cg * 64 + cq * 4;
#pragma unroll 1
        for (int k0 = 0; k0 < 32; k0 += 8) { f32x4 wv[8];
#pragma unroll
            for (int i = 0; i < 8; ++i) wv[i] = __builtin_nontemporal_load((const f32x4*)(wp + (size_t)(k0 + i) * 4 * 6144));
#pragma unroll
            for (int i = 0; i < 8; ++i) { const int k = F.wave * 128 + (k0 + i) * 4 + ks;
#pragma unroll
                for (int r = 0; r < 9; ++r) acc[r] += scond[r * 1024 + k] * wv[i]; } }
#pragma unroll
        for (int r = 0; r < 9; ++r) *(LAS f32x4*)(red + ((F.wave * 4 + ks) * 9 + r) * 64 + cq * 4) = acc[r];
        __syncthreads();
        for (int idx = F.tid; idx < 576; idx += NWAVES * 64) { const int r = idx >> 6, ln = idx & 63; float s = F.in[I_ADAB][l * 6144 + cg * 64 + ln];
#pragma unroll 8
            for (int w = 0; w < 32; ++w) s += red[(w * 9 + r) * 64 + ln];
            mod[(size_t)(l * 9 + r) * 6144 + cg * 64 + ln] = s; }
        __syncthreads();
    }
    __syncthreads();
    { const int rb0 = F.G >= 194 ? 192 : 0; const int gt = ((int)blockIdx.x - rb0) * (NWAVES * 64) + F.tid; if (gt >= 0 && gt < 1024) { const int pos = gt >> 4, i = gt & 15;
        double th = 1.0; for (int k = 0; k < i; ++k) th *= 0.56234132519034908;
        const double t2 = th * th; double sn = th, cs = 1.0, ts = th, tc = 1.0;
        for (int k = 1; k <= 12; ++k) { tc *= -t2 * (1.0 / (double)((2 * k - 1) * (2 * k))); cs += tc; ts *= -t2 * (1.0 / (double)((2 * k) * (2 * k + 1))); sn += ts; }
        double c = 1.0, s2 = 0.0; for (int k = 0; k < pos; ++k) { const double cn = c * cs - s2 * sn; s2 = s2 * cs + c * sn; c = cn; }
        float* rp = (float*)(F.ws + WS_ROPE); rp[gt] = (float)c; rp[1024 + gt] = (float)s2; } }
    conv_items(F, 0, CV_A_END, F.vcu * NWAVES + F.wave, F.G * NWAVES);
    conv_items(F, CV_B_END + CV_T10 + CV_T11 + CV_T13, CV_END, F.vcu * NWAVES + F.wave, F.G * NWAVES);
}

struct RowVec { f32x4 v[4]; };
__device__ __forceinline__ void load_modvec(Frame& F, int l, int mrow, int chunk_shift, const float* nw, RowVec& gsc, RowVec& sh) {
    const float* mod = (const float*)(F.ws + WS_MOD) + (size_t)(l * 9 + mrow) * 6144;
#pragma unroll
    for (int j = 0; j < 4; ++j) { const int col = 4 * F.lane + 256 * j; const f32x4 w = *(const f32x4*)(nw + col), sc = *(const f32x4*)(mod + (chunk_shift + 1) * 1024 + col);
        gsc.v[j] = w * (1.0f + sc); sh.v[j] = *(const f32x4*)(mod + chunk_shift * 1024 + col); }
}
__device__ __forceinline__ void store_bf16_row(bf16* dst, int lane, const RowVec& h) {
#pragma unroll
    for (int j = 0; j < 4; ++j) { v2u o; o.x = pk2(h.v[j][0], h.v[j][1]); o.y = pk2(h.v[j][2], h.v[j][3]); *(GAS v2u*)(dst + 4 * lane + 256 * j) = o; }
}
__device__ __forceinline__ void rms_mod(const RowVec& x, const RowVec& gsc, const RowVec& sh, RowVec& h) {
    float ss = 0.f;
#pragma unroll
    for (int j = 0; j < 4; ++j) ss += (x.v[j][0] * x.v[j][0] + x.v[j][1] * x.v[j][1]) + (x.v[j][2] * x.v[j][2] + x.v[j][3] * x.v[j][3]);
    ss = wave_sum(ss);
    const float rstd = 1.0f / sqrtf(ss * (1.0f / 1024.0f) + EPS);
#pragma unroll
    for (int j = 0; j < 4; ++j) h.v[j] = x.v[j] * rstd * gsc.v[j] + sh.v[j];
}

__device__ __forceinline__ void load_xrow(const float* xL, const float* xC, int row, int lane, RowVec& x) {
    const float* src = row < ML ? xL + (size_t)row * 1024 : xC + (size_t)(row - ML) * 1024;
#pragma unroll
    for (int j = 0; j < 4; ++j) x.v[j] = __builtin_nontemporal_load((const f32x4*)(src + 4 * lane + 256 * j));
}
__device__ __forceinline__ void load_xrow_bf(const bf16* XB, int row, int lane, RowVec& x) {
    const bf16* src = XB + (size_t)row * 1024;
#pragma unroll
    for (int j = 0; j < 4; ++j) { const v2u w = *(const GAS v2u*)(src + 4 * lane + 256 * j); x.v[j] = (f32x4){bflo(w.x), bfhi(w.x), bflo(w.y), bfhi(w.y)}; }
}
__device__ __forceinline__ void rows_modulate(Frame& F, const float* xL, const float* xC, int nrows, int l, int chunk_shift, const float* nw) {
    const int gwv = blockIdx.x * NWAVES + F.wave, NGW = F.G * NWAVES;
    const int r0 = (int)((long)gwv * nrows / NGW), r1 = (int)((long)(gwv + 1) * nrows / NGW);
    bf16* XN = (bf16*)(F.ws + WS_XN);
    int curb = -1; RowVec gsc, sh, xn;
    if (r0 < r1) load_xrow(xL, xC, r0, F.lane, xn);
    for (int row = r0; row < r1; ++row) {
        const int mrow = row < ML ? (row >> 12) : 8;
        if (mrow != curb) { load_modvec(F, l, mrow, chunk_shift, nw, gsc, sh); curb = mrow; }
        RowVec x = xn, h;
        if (row + 1 < r1) load_xrow(xL, xC, row + 1, F.lane, xn);
        rms_mod(x, gsc, sh, h);
        store_bf16_row(XN + (size_t)row * 1024, F.lane, h);
    }
}

__device__ __forceinline__ void rows_modulate_ho(Frame& F, const float* xL, const float* xC, int l, int chunk_shift, const float* nw, int nprod, bool fast, unsigned* hcnt) {
    const int w = blockIdx.x * NWAVES + F.wave, W = nprod * NWAVES;
    bf16* XN = (bf16*)(F.ws + WS_XN);
    int r, rstep, rend;
    if (fast) { const int g = w >> 8; r = pg8::in_gs(g) * 256 + (w & 255); rstep = 256; rend = pg8::in_gs(g + 1) * 256; } else { r = w; rstep = W; rend = MT; }
    int curb = -1, pp1 = -1, pp2 = -1; RowVec gsc, sh, xn;
    if (r < rend) load_xrow(xL, xC, r, F.lane, xn);
    for (; r < rend; r += rstep) {
        const int mrow = r < ML ? (r >> 12) : 8;
        if (mrow != curb) { load_modvec(F, l, mrow, chunk_shift, nw, gsc, sh); curb = mrow; }
        RowVec x = xn, h;
        if (r + rstep < rend) load_xrow(xL, xC, r + rstep, F.lane, xn);
        rms_mod(x, gsc, sh, h);
        asm volatile("" ::: "memory");
        if (pp2 >= 0 && F.lane == 0) pg8::ho_publish(hcnt, pp2);
        bf16* dst = XN + (size_t)r * 1024;
#pragma unroll
        for (int j = 0; j < 4; ++j) { const unsigned lo = pk2(h.v[j][0], h.v[j][1]), hi = pk2(h.v[j][2], h.v[j][3]);
            __hip_atomic_store((GAS unsigned long long*)(dst + 4 * F.lane + 256 * j), ((unsigned long long)hi << 32) | (unsigned long long)lo, __ATOMIC_RELAXED, __HIP_MEMORY_SCOPE_AGENT); }
        pp2 = pp1; pp1 = r >> 8;
    }
    asm volatile("s_waitcnt vmcnt(0)" ::: "memory");
    if (F.lane == 0) { if (pp2 >= 0) pg8::ho_publish(hcnt, pp2); if (pp1 >= 0) pg8::ho_publish(hcnt, pp1); }
}

__device__ __forceinline__ void route_topk(const float (&lg)[16], int& e0, int& e1, float& w0, float& w1);
__device__ __forceinline__ void route_row(const RowVec& h, const LAS float* rw, const float* rb, int lane, int& e0, int& e1, float& w0, float& w1) {
    f32x2 acc2[8];
#pragma unroll
    for (int e = 0; e < 8; ++e) acc2[e] = (f32x2){0.f, 0.f};
#pragma unroll
    for (int j = 0; j < 4; ++j)
#pragma unroll
        for (int i = 0; i < 4; ++i) { const int k = 4 * lane + 256 * j + i; const f32x2 hv2 = {h.v[j][i], h.v[j][i]}; const LAS f32x4* wr = (const LAS f32x4*)(rw + k * 16 + (k >> 2) * 4);
#pragma unroll
            for (int q = 0; q < 4; ++q) { const f32x4 w = wr[q]; acc2[2 * q] = acc2[2 * q] + hv2 * (f32x2){w[0], w[1]}; acc2[2 * q + 1] = acc2[2 * q + 1] + hv2 * (f32x2){w[2], w[3]}; } }
    float acc[16];
#pragma unroll
    for (int e = 0; e < 8; ++e) { acc[2 * e] = acc2[e][0]; acc[2 * e + 1] = acc2[e][1]; }
    float r8[8], r4[4], r2[2], r1v;
    { const bool hi = (lane & 32) != 0;
#pragma unroll
      for (int i = 0; i < 8; ++i) { const float send = hi ? acc[i] : acc[8 + i], keep = hi ? acc[8 + i] : acc[i]; r8[i] = keep + __shfl_xor(send, 32); } }
    { const bool hi = (lane & 16) != 0;
#pragma unroll
      for (int i = 0; i < 4; ++i) { const float send = hi ? r8[i] : r8[4 + i], keep = hi ? r8[4 + i] : r8[i]; r4[i] = keep + __shfl_xor(send, 16); } }
    { const bool hi = (lane & 8) != 0;
#pragma unroll
      for (int i = 0; i < 2; ++i) { const float send = hi ? r4[i] : r4[2 + i], keep = hi ? r4[2 + i] : r4[i]; r2[i] = keep + __shfl_xor(send, 8); } }
    { const bool hi = (lane & 4) != 0; const float send = hi ? r2[0] : r2[1], keep = hi ? r2[1] : r2[0]; r1v = keep + __shfl_xor(send, 4); }
    r1v += __shfl_xor(r1v, 2); r1v += __shfl_xor(r1v, 1);
    float lg[16];
#pragma unroll
    for (int e = 0; e < 16; ++e) lg[e] = __builtin_bit_cast(float, __builtin_amdgcn_readlane(__builtin_bit_cast(int, r1v), 4 * e)) + rb[e];
    route_topk(lg, e0, e1, w0, w1);
}
__device__ __forceinline__ void route_topk(const float (&lg)[16], int& e0, int& e1, float& w0, float& w1) {
    float mx = lg[0];
#pragma unroll
    for (int e = 1; e < 16; ++e) mx = fmaxf(mx, lg[e]);
    float p[16];
#pragma unroll
    for (int e = 0; e < 16; ++e) p[e] = __expf(lg[e] - mx);
    float gs[4];
#pragma unroll
    for (int g = 0; g < 4; ++g) { const float a = fmaxf(p[4 * g], p[4 * g + 1]), b = fminf(p[4 * g], p[4 * g + 1]), c = fmaxf(p[4 * g + 2], p[4 * g + 3]), d = fminf(p[4 * g + 2], p[4 * g + 3]);
        gs[g] = fmaxf(a, c) + fmaxf(fminf(a, c), fmaxf(b, d)); }
    int sel = 0; float best = gs[0];
#pragma unroll
    for (int g = 1; g < 4; ++g) if (gs[g] > best) { best = gs[g]; sel = g; }
    float q[4];
#pragma unroll
    for (int i = 0; i < 4; ++i) q[i] = sel == 0 ? p[i] : sel == 1 ? p[4 + i] : sel == 2 ? p[8 + i] : p[12 + i];
    int i1 = 0; float m1 = q[0];
#pragma unroll
    for (int i = 1; i < 4; ++i) if (q[i] > m1) { m1 = q[i]; i1 = i; }
    int i2 = -1; float m2 = -1.f;
#pragma unroll
    for (int i = 0; i < 4; ++i) if (i != i1 && q[i] > m2) { m2 = q[i]; i2 = i; }
    const float inv = 1.0f / (m1 + m2);
    e0 = sel * 4 + i1; e1 = sel * 4 + i2; w0 = m1 * inv; w1 = m2 * inv;
}

__device__ __forceinline__ void rows_route(Frame& F, int nrows, int l) {
    const bf16* XB = (const bf16*)(F.ws + WS_XB);
    constexpr int HP = 1028;
    LAS float* Wt = (LAS float*)(F.lds + RING_OFF);
    LAS float* Ht = (LAS float*)(F.lds + RING_OFF + 65536);
    LAS float* part = (LAS float*)(F.lds + TAB_OFF);
    LAS float* logit = (LAS float*)(F.lds + TAB_OFF + 8192);
    LAS unsigned char* pe = (LAS unsigned char*)(F.lds + TAB_OFF + 9216);
    LAS unsigned short* pr = (LAS unsigned short*)(F.lds + TAB_OFF + 9216 + 2048);
    static_assert(TAB_OFF + 9216 + 2048 + 3072 <= LDS_BYTES && RING_OFF + 65536 + 16 * 1028 * 4 <= MISC_OFF, "router LDS map");
    { int t0_ = F.tid; asm volatile("" : "+v"(t0_));
      for (int idx = t0_; idx < 1024 * 16 / 4; idx += NWAVES * 64) ((LAS f32x4*)Wt)[idx] = ((const f32x4*)F.in[I_RW])[idx]; }
    const int NGW = F.G * NWAVES;
    const int b0 = (int)((long)(blockIdx.x * NWAVES) * nrows / NGW), b1 = (int)((long)(blockIdx.x * NWAVES + NWAVES) * nrows / NGW);
    unsigned char* XN8 = F.ws + WS_XN; v4u* route = (v4u*)(F.ws + WS_ROUTE);
    const float* nw = F.in[I_NFFN] + l * 1024; const float* rb = F.in[I_RB];
    const int ngroups = (b1 - b0 + 15) >> 4;
    int curb = -1; RowVec gsc, sh;
    v2u xr[2][4];
#define RR_LOAD(g_) do { _Pragma("unroll") for (int q = 0; q < 2; ++q) { const int row_ = b0 + 16 * (g_) + 2 * F.wave + q; const int rc_ = row_ < b1 ? row_ : b1 - 1; \
        _Pragma("unroll") for (int j = 0; j < 4; ++j) xr[q][j] = *(const GAS v2u*)(XB + (size_t)rc_ * 1024 + 4 * F.lane + 256 * j); } } while (0)
    RR_LOAD(0);
    for (int g = 0; g < ngroups; ++g) {
#pragma unroll
        for (int q = 0; q < 2; ++q) { const int rr = 2 * F.wave + q, row = b0 + 16 * g + rr; const bool valid = row < b1;
            RowVec x, h;
#pragma unroll
            for (int j = 0; j < 4; ++j) x.v[j] = (f32x4){bflo(xr[q][j].x), bfhi(xr[q][j].x), bflo(xr[q][j].y), bfhi(xr[q][j].y)};
            const int mrow = (valid ? row : b1 - 1) < ML ? ((valid ? row : b1 - 1) >> 12) : 8;
            if (mrow != curb) { load_modvec(F, l, mrow, 3, nw, gsc, sh); curb = mrow; }
            rms_mod(x, gsc, sh, h);
            if (valid) { unsigned char* d8 = XN8 + (size_t)row * 1024;
#pragma unroll
                for (int j = 0; j < 4; ++j) *(GAS unsigned*)(d8 + 4 * F.lane + 256 * j) = pg8::pk4_fp8(h.v[j][0], h.v[j][1], h.v[j][2], h.v[j][3]); }
#pragma unroll
            for (int j = 0; j < 4; ++j) *(LAS f32x4*)(Ht + rr * HP + 4 * F.lane + 256 * j) = valid ? h.v[j] : (f32x4){0.f, 0.f, 0.f, 0.f}; }
        if (g + 1 < ngroups) RR_LOAD(g + 1);
        __syncthreads();
        { const int r = F.lane & 15, kq = F.lane >> 4; f32x4 acc = {0.f, 0.f, 0.f, 0.f};
          const LAS float* ap = Ht + r * HP + 128 * F.wave + kq; const LAS float* bp = Wt + (128 * F.wave + kq) * 16 + r;
#pragma unroll 8
          for (int s_ = 0; s_ < 32; ++s_) acc = __builtin_amdgcn_mfma_f32_16x16x4f32(ap[4 * s_], bp[64 * s_], acc, 0, 0, 0);
#pragma unroll
          for (int i = 0; i < 4; ++i) part[(F.wave * 16 + 4 * kq + i) * 16 + r] = acc[i]; }
        __syncthreads();
        if (F.tid < 256) { float sacc = rb[F.tid & 15];
#pragma unroll
            for (int w = 0; w < 8; ++w) sacc += part[w * 256 + F.tid];
            logit[F.tid] = sacc; }
        __syncthreads();
        if (F.tid < 16) { const int row = b0 + 16 * g + F.tid;
            if (row < b1) { float lg[16];
#pragma unroll
                for (int e = 0; e < 16; ++e) lg[e] = logit[F.tid * 16 + e];
                int e0, e1; float w0, w1; route_topk(lg, e0, e1, w0, w1);
                const int a0 = e0 & 3, a1 = e1 & 3, lo = a0 < a1 ? a0 : a1, hi_ = a0 < a1 ? a1 : a0, pid = lo == 0 ? hi_ - 1 : lo == 1 ? hi_ + 1 : 5, gid = 6 * (e0 >> 2) + pid;
                const float wa = a0 < a1 ? w0 : w1, wb = a0 < a1 ? w1 : w0;
                v4u o; o.x = (unsigned)gid; o.y = __builtin_bit_cast(unsigned, wa); o.z = __builtin_bit_cast(unsigned, wb); o.w = 0u; route[row] = o;
                pe[row - b0] = (unsigned char)gid; } }
    }
#undef RR_LOAD
    __syncthreads();
    if (F.wave == 0) {
        const int nr = b1 - b0; int run[24];
#pragma unroll
        for (int j = 0; j < 24; ++j) run[j] = 0;
        for (int p0 = 0; p0 < nr; p0 += 64) { const int p = p0 + F.lane; const int e = p < nr ? (int)pe[p] : 255; int myr = 0;
#pragma unroll
            for (int j = 0; j < 24; ++j) { const unsigned long long m = __ballot(e == j); const int below = __popcll(m & ((1ull << F.lane) - 1ull));
                if (e == j) myr = run[j] + below; run[j] += __popcll(m); }
            if (p < nr) pr[p] = (unsigned short)myr; }
        int mycnt = 0;
#pragma unroll
        for (int j = 0; j < 24; ++j) mycnt = (F.lane == j) ? run[j] : mycnt;
        int basev = 0;
        if (F.lane < 24) basev = (int)__hip_atomic_fetch_add((unsigned*)(F.ctl + CW_CNT + 64 * l) + F.lane, (unsigned)mycnt, RLX_AGENT);
        int base[24];
#pragma unroll
        for (int j = 0; j < 24; ++j) base[j] = __builtin_amdgcn_readlane(basev, j);
        LDS_WAIT();
        int* ridx = (int*)(F.ws + WS_RIDX);
        for (int p0 = 0; p0 < nr; p0 += 64) { const int p = p0 + F.lane;
            if (p < nr) { const int e = (int)pe[p]; int bs = 0;
#pragma unroll
                for (int j = 0; j < 24; ++j) bs = (e == j) ? base[j] : bs;
                ridx[(size_t)e * MT + bs + (int)pr[p]] = b0 + p; } }
    }
    __syncthreads();
}

__device__ __forceinline__ void rows_modulate_xb(Frame& F, int nrows, int l) {
    const int gwv = blockIdx.x * NWAVES + F.wave, NGW = F.G * NWAVES;
    const int r0 = (int)((long)gwv * nrows / NGW), r1 = (int)((long)(gwv + 1) * nrows / NGW);
    const bf16* XB = (const bf16*)(F.ws + WS_XB); unsigned char* XN8 = F.ws + WS_XN; const float* nw = F.in[I_NMIX] + l * 1024;
    int curb = -1; RowVec gsc, sh, xn;
    if (r0 < r1) load_xrow_bf(XB, r0, F.lane, xn);
    for (int row = r0; row < r1; ++row) {
        const int mrow = row < ML ? (row >> 12) : 8;
        if (mrow != curb) { load_modvec(F, l, mrow, 0, nw, gsc, sh); curb = mrow; }
        RowVec x = xn, h;
        if (row + 1 < r1) load_xrow_bf(XB, row + 1, F.lane, xn);
        rms_mod(x, gsc, sh, h);
        unsigned char* d8 = XN8 + (size_t)row * 1024;
#pragma unroll
        for (int j = 0; j < 4; ++j) *(GAS unsigned*)(d8 + 4 * F.lane + 256 * j) = pg8::pk4_fp8(h.v[j][0], h.v[j][1], h.v[j][2], h.v[j][3]);
    }
}

__device__ __forceinline__ void rows_conv(Frame& F) {
    const bf16* U = (const bf16*)((unsigned char*)F.out + DO_U); bf16* UC = (bf16*)(F.ws + WS_XN);
    const int cg = F.tid & 127, rsub = F.tid >> 7, c0 = cg * 8;
    float w[4][8], cb[8];
#pragma unroll
    for (int j = 0; j < 8; ++j) { cb[j] = F.in[I_LCB][c0 + j];
#pragma unroll
        for (int k = 0; k < 4; ++k) w[k][j] = F.in[I_LCW][k * 1024 + c0 + j]; }
    for (int run = blockIdx.x * 4 + rsub; run < MT / 16; run += F.G * 4) {
        const int row0 = run * 16; const int t0 = row0 < ML ? (row0 & 4095) : ((row0 - ML) & 255), T = row0 < ML ? 4096 : 256;
        v4u win[19];
#pragma unroll
        for (int i = 0; i < 19; ++i) { const int tt = t0 + i - 2; win[i] = (v4u){0u, 0u, 0u, 0u};
            if (tt >= 0 && tt < T) win[i] = *(const GAS v4u*)(U + (size_t)(row0 + i - 2) * 1024 + c0); }
#pragma unroll
        for (int i = 0; i < 16; ++i) { float acc[8];
#pragma unroll
            for (int j = 0; j < 8; ++j) acc[j] = cb[j];
#pragma unroll
            for (int k = 0; k < 4; ++k) { const v4u uv = win[i + k];
                acc[0] += w[k][0] * bflo(uv.x); acc[1] += w[k][1] * bfhi(uv.x); acc[2] += w[k][2] * bflo(uv.y); acc[3] += w[k][3] * bfhi(uv.y);
                acc[4] += w[k][4] * bflo(uv.z); acc[5] += w[k][5] * bfhi(uv.z); acc[6] += w[k][6] * bflo(uv.w); acc[7] += w[k][7] * bfhi(uv.w); }
            v4u o; o.x = pk2(acc[0], acc[1]); o.y = pk2(acc[2], acc[3]); o.z = pk2(acc[4], acc[5]); o.w = pk2(acc[6], acc[7]);
            *(GAS v4u*)(UC + (size_t)(row0 + i) * 1024 + c0) = o; }
    }
}

__device__ __forceinline__ int scan_q(int d, int pc) { return d == 0 ? pc : (pc < 8 ? 7 - pc : 143 - pc); }
__device__ __forceinline__ int scan_row0(int b, int pc) { return pc < 8 ? ML + b * 256 + pc * 32 : b * 4096 + (pc - 8) * 32; }
__device__ __forceinline__ const unsigned char* scan_lb(Frame& F, int d) { return (const unsigned char*)(F.ws + (d ? WS_BB0 : WS_LA0)); }
#define LB_DEC(w, a0, b0, a1, b1) do { const f32x2 lo_ = __builtin_amdgcn_cvt_pk_f32_fp8((int)(w), false), hi_ = __builtin_amdgcn_cvt_pk_f32_fp8((int)(w), true); \
        a0 = fast_exp2(lo_[0] * (1.0f / pg8::LA8_SCALE)); b0 = lo_[1]; a1 = fast_exp2(hi_[0] * (1.0f / pg8::LA8_SCALE)); b1 = hi_[1]; } while (0)
__device__ __forceinline__ void scan_local(Frame& F) {
    f32x4* summ = (f32x4*)((unsigned char*)F.out + DO_SUMM);
    const int c2 = 2 * F.tid;
    for (int item = blockIdx.x; item < BATCH * NQ; item += F.G) {
        const int b = item / NQ, pc = item % NQ, row0 = scan_row0(b, pc);
#pragma unroll
        for (int d = 0; d < 2; ++d) {
            const unsigned char* lb = scan_lb(F, d) + ((size_t)row0 * 1024 + c2) * 2;
            float P0 = 1.f, P1 = 1.f, H0 = 0.f, H1 = 0.f; unsigned wav[32];
#pragma unroll
            for (int i = 0; i < 32; ++i) wav[i] = *(const GAS unsigned*)(lb + (size_t)i * 2048);
#pragma unroll
            for (int ii = 0; ii < 32; ++ii) { const int i = d ? 31 - ii : ii; float a0, b0, a1, b1; LB_DEC(wav[i], a0, b0, a1, b1);
                H0 = a0 * H0 + b0; H1 = a1 * H1 + b1; P0 *= a0; P1 *= a1; }
            summ[((size_t)((b * 2 + d) * NQ + scan_q(d, pc)) * 1024 + c2) >> 1] = (f32x4){P0, H0, P1, H1};
        }
    }
}
__device__ __forceinline__ void scan_carry(Frame& F) {
    const f32x2* summ = (const f32x2*)((unsigned char*)F.out + DO_SUMM); float* carry = (float*)((unsigned char*)F.out + DO_CARRY);
    LAS f32x2* comp = (LAS f32x2*)(F.lds + RING_OFF);
    for (int u = blockIdx.x; u < 256; u += F.G) {
        const int bd = u >> 4, c = (u & 15) * 64 + F.lane, q0 = F.wave * 17; f32x2 s[17];
#pragma unroll
        for (int k = 0; k < 17; ++k) s[k] = summ[(size_t)(bd * NQ + q0 + k) * 1024 + c];
        float Pc = 1.f, Hc = 0.f;
#pragma unroll
        for (int k = 0; k < 17; ++k) { Hc = s[k][0] * Hc + s[k][1]; Pc *= s[k][0]; }
        comp[F.wave * 64 + F.lane] = (f32x2){Pc, Hc};
        __syncthreads();
        float h = 0.f;
        for (int w = 0; w < F.wave; ++w) { const f32x2 cw = comp[w * 64 + F.lane]; h = cw[0] * h + cw[1]; }
#pragma unroll
        for (int k = 0; k < 17; ++k) { carry[(size_t)(bd * NQ + q0 + k) * 1024 + c] = h; h = s[k][0] * h + s[k][1]; }
        __syncthreads();
    }
}
__device__ __forceinline__ void scan_final(Frame& F) {
    const float* carry = (const float*)((unsigned char*)F.out + DO_CARRY); const bf16* Gb = (const bf16*)(F.ws + WS_G); bf16* YGb = (bf16*)(F.ws + WS_XN);
    const int c2 = 2 * F.tid;
    for (int item = blockIdx.x; item < BATCH * NQ; item += F.G) {
        const int b = item / NQ, pc = item % NQ, row0 = scan_row0(b, pc);
        float hf0[32], hf1[32];
        { const unsigned char* lb = scan_lb(F, 0) + ((size_t)row0 * 1024 + c2) * 2;
          const f32x2 cin = *(const f32x2*)(carry + (size_t)((b * 2 + 0) * NQ + scan_q(0, pc)) * 1024 + c2); float h0 = cin[0], h1 = cin[1];
          unsigned wav[32];
#pragma unroll
          for (int i = 0; i < 32; ++i) wav[i] = *(const GAS unsigned*)(lb + (size_t)i * 2048);
#pragma unroll
          for (int i = 0; i < 32; ++i) { float a0, b0, a1, b1; LB_DEC(wav[i], a0, b0, a1, b1);
              h0 = a0 * h0 + b0; h1 = a1 * h1 + b1; hf0[i] = h0; hf1[i] = h1; } }
        { const unsigned char* lb = scan_lb(F, 1) + ((size_t)row0 * 1024 + c2) * 2; const bf16* gp = Gb + (size_t)row0 * 1024 + c2; bf16* yp = YGb + (size_t)row0 * 1024 + c2;
          const f32x2 cin = *(const f32x2*)(carry + (size_t)((b * 2 + 1) * NQ + scan_q(1, pc)) * 1024 + c2); float h0 = cin[0], h1 = cin[1];
          unsigned wav[32], gv[32];
#pragma unroll
          for (int i = 0; i < 32; ++i) wav[i] = *(const GAS unsigned*)(lb + (size_t)i * 2048);
#pragma unroll
          for (int i = 0; i < 32; ++i) gv[i] = *(const GAS unsigned*)(gp + (size_t)i * 1024);
#pragma unroll
          for (int ii = 0; ii < 32; ++ii) { const int i = 31 - ii; float a0, b0, a1, b1; LB_DEC(wav[i], a0, b0, a1, b1);
              h0 = a0 * h0 + b0; h1 = a1 * h1 + b1;
              const unsigned g = gv[i];
              *(GAS unsigned*)(yp + (size_t)i * 1024) = pk2((hf0[i] + h0) * (bflo(g) * (1.0f / pg8::BB8_SCALE)), (hf1[i] + h1) * (bfhi(g) * (1.0f / pg8::BB8_SCALE))); } }
    }
}

__device__ __forceinline__ int scan_po_panel(int pos, bool reorder) { if (!reorder || pos >= 48) return pos; const int k = pos / 24, j = pos % 24; return 6 * (j & 7) + 3 * k + (j >> 3); }
__device__ __forceinline__ void scan_final_ho(Frame& F, int nprod, bool reorder, unsigned* hcnt) {
    const float* carry = (const float*)((unsigned char*)F.out + DO_CARRY); const bf16* Gb = (const bf16*)(F.ws + WS_G); bf16* YGb = (bf16*)(F.ws + WS_XN);
    const int c2 = 2 * F.tid; int pend = -1;
    for (int t = blockIdx.x; t < BATCH * NQ; t += nprod) {
        asm volatile("" ::: "memory");
        const int panel = scan_po_panel(t >> 3, reorder), b = panel < 128 ? (panel >> 4) : panel - 128, pc = (panel < 128 ? 8 + (panel & 15) * 8 : 0) + (t & 7), row0 = scan_row0(b, pc);
        float hf0[32], hf1[32];
        { const unsigned char* lb = scan_lb(F, 0) + ((size_t)row0 * 1024 + c2) * 2;
          const f32x2 cin = *(const f32x2*)(carry + (size_t)((b * 2 + 0) * NQ + scan_q(0, pc)) * 1024 + c2); float h0 = cin[0], h1 = cin[1];
          unsigned wav[32];
#pragma unroll
          for (int i = 0; i < 32; ++i) wav[i] = *(const GAS unsigned*)(lb + (size_t)i * 2048);
#pragma unroll
          for (int i = 0; i < 32; ++i) { float a0, b0, a1, b1; LB_DEC(wav[i], a0, b0, a1, b1);
              h0 = a0 * h0 + b0; h1 = a1 * h1 + b1; hf0[i] = h0; hf1[i] = h1; } }
        asm volatile("" ::: "memory");
        if (pend >= 0) { __syncthreads(); if (F.tid == 0) pg8::ho_publish(hcnt, pend); }
        { const unsigned char* lb = scan_lb(F, 1) + ((size_t)row0 * 1024 + c2) * 2; const bf16* gp = Gb + (size_t)row0 * 1024 + c2; bf16* yp = YGb + (size_t)row0 * 1024 + c2;
          const f32x2 cin = *(const f32x2*)(carry + (size_t)((b * 2 + 1) * NQ + scan_q(1, pc)) * 1024 + c2); float h0 = cin[0], h1 = cin[1];
          unsigned wav[32], gv[32];
#pragma unroll
          for (int i = 0; i < 32; ++i) wav[i] = *(const GAS unsigned*)(lb + (size_t)i * 2048);
#pragma unroll
          for (int i = 0; i < 32; ++i) gv[i] = *(const GAS unsigned*)(gp + (size_t)i * 1024);
#pragma unroll
          for (int ii = 0; ii < 32; ++ii) { const int i = 31 - ii; float a0, b0, a1, b1; LB_DEC(wav[i], a0, b0, a1, b1);
              h0 = a0 * h0 + b0; h1 = a1 * h1 + b1;
              const unsigned g = gv[i];
              __hip_atomic_store((GAS unsigned*)(yp + (size_t)i * 1024), pk2((hf0[i] + h0) * (bflo(g) * (1.0f / pg8::BB8_SCALE)), (hf1[i] + h1) * (bfhi(g) * (1.0f / pg8::BB8_SCALE))), __ATOMIC_RELAXED, __HIP_MEMORY_SCOPE_AGENT); } }
        pend = panel;
    }
    asm volatile("s_waitcnt vmcnt(0)" ::: "memory");
    __syncthreads();
    if (pend >= 0 && F.tid == 0) pg8::ho_publish(hcnt, pend);
}
#ifndef MK_N_LAUNCHES
#define MK_N_LAUNCHES 1
#endif
constexpr int NPHASE = 15;
#ifndef PH_STOP
#define PH_STOP 15
#endif
#ifndef PH_DUP
#define PH_DUP 0u
#endif
#define DUPN(k) (((PH_DUP >> (k)) & 1u) ? 2 : 1)
constexpr int N_LAUNCHES = MK_N_LAUNCHES;
struct Args { const float* in[26]; float* out; unsigned char* ws; int ph_lo, ph_hi; };

__global__ void __launch_bounds__(NWAVES * 64, 2) fwd_kernel(Args args) {
    extern __shared__ __attribute__((aligned(16))) unsigned char lds[];
    Frame F;
    F.lds = (LAS unsigned char*)lds;
    F.MISC = (volatile LAS unsigned*)(F.lds + MISC_OFF);
    F.tid = threadIdx.x; F.lane = F.tid & 63; F.wave = __builtin_amdgcn_readfirstlane(F.tid >> 6);
    F.G = gridDim.x; { const int bx = blockIdx.x; F.vcu = (F.G % 8 == 0) ? (bx % 8) * (F.G / 8) + bx / 8 : bx; }
    F.ws = args.ws; F.out = args.out; F.ctl = (gu32*)(args.ws + WS_CTL);
#pragma unroll
    for (int i = 0; i < 26; ++i) F.in[i] = args.in[i];
    for (int u = F.tid; u < (LDS_BYTES - LDSCTL_OFF) / 4; u += NWAVES * 64) ((LAS unsigned*)(F.lds + LDSCTL_OFF))[u] = 0u;
    __syncthreads();
    XcdBarrier bar; bar.bar = (unsigned*)(F.ctl + CW_BAR); bar.x = 0; bar.st = nullptr;
    if (N_LAUNCHES == 1) bar = xcd_barrier_post((unsigned*)(F.ctl + CW_BAR), F.MISC + 8);
#define GRID_BAR() do { if (N_LAUNCHES == 1) xcd_barrier(bar); } while (0)
    const int lo = args.ph_lo, hi = args.ph_hi;
#define IN(k) (lo <= (k) && (k) < hi)
#define BOTH(k) (IN(k) && IN((k) + 1))
    unsigned char* ws = args.ws;
    float* mod = (float*)(ws + WS_MOD);
    LAS unsigned char* ring = F.lds + RING_OFF;
    LAS int* tab = (LAS int*)(F.lds + TAB_OFF); LAS float* tabw = (LAS float*)(F.lds + TAB_OFF + TAB_UNITS * 1024);

#define PHASE(k, ...) do { if (IN(k)) { _Pragma("unroll") for (int rep_ = 0; rep_ < DUPN(k); ++rep_) { __VA_ARGS__; if (rep_ + 1 < DUPN(k)) GRID_BAR(); } if (BOTH(k)) GRID_BAR(); } } while (0)
    PHASE(0, p0_prologue(F));
    PHASE(1, {
        const int nearly = (F.G == 256) ? 96 : 0; unsigned* hc = (unsigned*)(F.ctl + CW_TILE + 12288);
        if ((int)blockIdx.x < F.G - nearly) rows_modulate_ho(F, F.in[I_X], F.in[I_CTX], 0, 0, F.in[I_NMIX], F.G - nearly, nearly != 0, hc);
        pg8::Gemm g{(const bf16*)(ws + WS_XN), (const bf16*)(ws + WS_W_IN), 1024, 1024, 1024, hc, 256u}; pg8::SchedIn S{F.G, (int)blockIdx.x, nearly};
        pg8::EpiInProj E{(bf16*)(ws + WS_G), (bf16*)((unsigned char*)F.out + DO_U)};
        pg8::gemm_phase<pg8::EpiInProj, pg8::SchedIn, false, 2, 2>(ring, g, S, E, tab);
        if (F.G == 256) conv_tail(F, 128, CV_A_END, CV_A_END + 5760, S.cl()); else conv_tail(F, 0, CV_A_END, CV_A_END + 5760); });
    PHASE(2, rows_conv(F));
    PHASE(3, {
        pg8::Gemm g{(const bf16*)(ws + WS_XN), (const bf16*)(ws + WS_W_G), 1024, 128, 128}; pg8::SchedGates S{MT / 256, F.G, (int)blockIdx.x};
        pg8::EpiGates E{(const bf16*)(ws + WS_XN), {ws + WS_LA0, ws + WS_BB0}, F.in[I_GAB], F.in[I_GXB], F.in[I_LAM]};
        pg8::gemm_phase<pg8::EpiGates, pg8::SchedGates, false>(ring, g, S, E, tab);
        if (F.G == 256) conv_tail(F, 128, CV_A_END + 5760, CV_A_END + 8320); else conv_tail(F, 0, CV_A_END + 5760, CV_A_END + 8320); });
    PHASE(4, scan_local(F));
    PHASE(5, scan_carry(F));
    PHASE(6, {
        const int nearly = (F.G == 256) ? 96 : 0; unsigned* hc = (unsigned*)(F.ctl + CW_TILE + 8192);
        if ((int)blockIdx.x < F.G - nearly) scan_final_ho(F, F.G - nearly, nearly != 0, hc);
        pg8::Gemm g{(const bf16*)(ws + WS_XN), (const bf16*)(ws + WS_W_OUT), 1024, 1024, 1024, hc}; pg8::SchedOut S{F.G, (int)blockIdx.x, nearly};
        pg8::EpiResid<false> E{F.in[I_X], F.in[I_CTX], (bf16*)(ws + WS_XB), mod + 2 * 1024, 1.0f};
        pg8::gemm_phase<pg8::EpiResid<false>, pg8::SchedOut, false, 2, 2>(ring, g, S, E, tab);
        if (F.G == 256) conv_tail(F, 96, CV_A_END + 8320, CV_B_END + CV_T8C); else conv_tail(F, 0, CV_A_END + 8320, CV_B_END + CV_T8C); });
    PHASE(7, rows_route(F, MT, 0));
#define MOE_UP(l, HOM) do { pg8::SchedMoe<true> S; S.init((const unsigned*)(F.ctl + CW_CNT + 64 * (l)), F.G, F.vcu); const int* ridx = (const int*)(ws + WS_RIDX); const v4u* route_ = (const v4u*)(ws + WS_ROUTE); \
        { pg8::Unit u; for (int i = 0; i < TAB_UNITS && S.next(i, u); ++i) if (F.tid < 256) { const bool v_ = F.tid < u.x1; const int row_ = v_ ? ridx[(size_t)u.x0 * MT + u.x2 + F.tid] : 0; \
              tab[i * 256 + F.tid] = row_; float w_ = 0.f; if (v_) { const v4u rt_ = route_[row_]; const unsigned wy_ = rt_.y, wz_ = rt_.z; w_ = __uint_as_float(u.pn < 4 ? wy_ : wz_); } tabw[i * 256 + F.tid] = w_; } } \
        __syncthreads(); \
        pg8::Gemm g{ws + WS_XN, ws + WS_W13 + (size_t)(l) * 16 * 1024 * 1024, 1024, 1024, 1024, (unsigned*)(F.ctl + CW_TILE + 4096 * (l))}; pg8::EpiMoe1<(HOM) != 0> E{ws + WS_ACT, tabw}; \
        pg8::gemm_phase<pg8::EpiMoe1<(HOM) != 0>, pg8::SchedMoe<true>, true, 1, (HOM) ? 1 : 0>(ring, g, S, E, tab); \
        if ((l) == 0 && !(HOM)) conv_tail(F, S.total % F.G, CV_B_END, CV_B_END + CV_T10, F.vcu); } while (0)
#define MOE_DOWN(l, FINAL, HOM) do { pg8::SchedMoe<false> S; S.init((const unsigned*)(F.ctl + CW_CNT + 64 * (l)), F.G, F.vcu); if (HOM) S.c = (F.vcu + F.G - (2 * S.total) % F.G) % F.G;     const int* ridx = (const int*)(ws + WS_RIDX); \
        { pg8::Unit u; for (int i = 0; i < TAB_UNITS && S.next(i, u); ++i) if (F.tid < 256) tab[i * 256 + F.tid] = F.tid < u.x1 ? ridx[(size_t)u.x0 * MT + u.x2 + F.tid] : -1; } \
        __syncthreads(); \
        pg8::Gemm g{ws + WS_ACT, ws + WS_W2 + (size_t)(l) * 16 * 1024 * 512, 1024, 512, 1024, (unsigned*)(F.ctl + CW_TILE + 4096 * (l))}; pg8::EpiMoe2<FINAL> E{(bf16*)(ws + WS_XB), F.out, mod + (l) * 9 * 6144 + 5 * 1024, tab}; \
        pg8::gemm_phase<pg8::EpiMoe2<FINAL>, pg8::SchedMoe<false>, false, 1, (HOM) ? 2 : 0>(ring, g, S, E, tab); \
        if ((l) == 0 && !(HOM)) conv_tail(F, S.total % F.G, CV_B_END + CV_T10, CV_B_END + CV_T10 + CV_T11, F.vcu); \
        if ((l) == 0 && (HOM)) conv_tail(F, 0, CV_B_END + CV_T8C, CV_B_END + CV_T10 + CV_T11, F.vcu);     \
        } while (0)
    PHASE(8, { MOE_UP(0, 1); __syncthreads(); MOE_DOWN(0, false, 1); });
    PHASE(9, rows_modulate_xb(F, MT, 1));
    PHASE(10, {
        pg8::Gemm g{ws + WS_XN, ws + WS_W_QKV, 1024, 1024, 1024}; pg8::SchedQKV S{F.G, (int)blockIdx.x};
        { int t_ = F.tid; asm volatile("" : "+v"(t_));
          LAS f32x4* rl = (LAS f32x4*)tab; rl[t_] = ((const f32x4*)(ws + WS_ROPE))[t_]; __syncthreads(); }
        pg8::EpiQKV E{ws + WS_Q, ws + WS_K, ws + WS_V, F.in[I_QN], F.in[I_KN], (const LAS float*)tab};
        pg8::gemm_phase<pg8::EpiQKV, pg8::SchedQKV, false, 1>(ring, g, S, E, tab);
        conv_tail(F, F.G == 256 ? 16 : 0, CV_B_END + CV_T10 + CV_T11, CV_B_END + CV_T10 + CV_T11 + CV_T13); });
    PHASE(11, {
        static_assert(attn8::LDS_BYTES <= RING_BYTES, "attention LDS");
        const attn8::Tensors AT{ws + WS_Q, ws + WS_K, ws + WS_V, ws + WS_O};
        attn8::attn_phase((char*)lds + RING_OFF, AT, (int)F.G, (int)blockIdx.x); });
    PHASE(12, {
        pg8::Gemm g{ws + WS_O, ws + WS_W_O, 1024, 1024, 1024}; pg8::SchedDense S{ML / 256, 4, F.G, (int)blockIdx.x};
        pg8::EpiResid<true> E{nullptr, nullptr, (bf16*)(ws + WS_XB), mod + 9 * 6144 + 2 * 1024, 1.0f / (pg8::W8_SCALE * attn8::OS)};
        pg8::gemm_phase<pg8::EpiResid<true>, pg8::SchedDense, false, 1>(ring, g, S, E, tab); });
    PHASE(13, rows_route(F, ML, 1));
    PHASE(14, { MOE_UP(1, 1); __syncthreads(); MOE_DOWN(1, true, 1); });
#undef IN
#undef BOTH
}

extern "C" void kernel_launch(void* const* d_in, const int* in_sizes, int n_in, void* d_out, int out_size, void* d_ws, size_t ws_size, hipStream_t stream) {
    static int grid = 0;
    if (grid == 0) {
        if (n_in != 26 || in_sizes[0] != ML * D || out_size != ML * D || ws_size < WS_END) { fprintf(stderr, "kernel_launch: unexpected shapes (n_in %d, in0 %d, out %d, ws %zu); nothing launched\n", n_in, n_in > 0 ? in_sizes[0] : -1, out_size, ws_size); grid = -1; return; }
        int dev = 0, cus = 0, per_cu = 0;
        if (hipGetDevice(&dev) != hipSuccess || hipDeviceGetAttribute(&cus, hipDeviceAttributeMultiprocessorCount, dev) != hipSuccess) { grid = -1; return; }
        if (hipFuncSetAttribute((const void*)fwd_kernel, hipFuncAttributeMaxDynamicSharedMemorySize, LDS_BYTES) != hipSuccess) { fprintf(stderr, "kernel_launch: hipFuncSetAttribute failed\n"); grid = -1; return; }
        if (hipOccupancyMaxActiveBlocksPerMultiprocessor(&per_cu, (const void*)fwd_kernel, NWAVES * 64, LDS_BYTES) != hipSuccess || per_cu < 1)
            fprintf(stderr, "kernel_launch: note: occupancy query reports %d workgroups per CU\n", per_cu);
        (void)hipGetLastError();
        grid = cus < 256 ? cus : 256;
    }
    if (grid < 0) return;
    if (hipMemsetAsync((char*)d_ws + WS_CTL, 0, CTL_ZERO_BYTES, stream) != hipSuccess) { fprintf(stderr, "kernel_launch: memset failed\n"); return; }
    Args a{};
    for (int i = 0; i < 26; ++i) a.in[i] = (const float*)d_in[i];
    a.out = (float*)d_out; a.ws = (unsigned char*)d_ws;
    for (int li = 0; li < (N_LAUNCHES == 1 ? 1 : PH_STOP); ++li) {
        a.ph_lo = (N_LAUNCHES == 1) ? 0 : li; a.ph_hi = (N_LAUNCHES == 1) ? PH_STOP : li + 1;
        hipLaunchKernelGGL(fwd_kernel, dim3(grid), dim3(NWAVES * 64), LDS_BYTES, stream, a);
        const hipError_t le = hipPeekAtLastError();
        if (le != hipSuccess) { fprintf(stderr, "kernel_launch: launch %d failed: %s\n", li, hipGetErrorName(le)); break; }
    }
}
```

```cpp
#include <hip/hip_runtime.h>
#include <cstdio>
#include <cstdint>

constexpr int BATCH = 8, SEQ = 4096, D = 1024, CTXL = 256;
constexpr int ML = BATCH * SEQ;
constexpr int MC = BATCH * CTXL;
constexpr int MT = ML + MC;
constexpr int KVL = CTXL + SEQ;
constexpr int NE = 16, FF = 512;
constexpr int NQ = 136;
constexpr float EPS = 1e-6f;
constexpr int NWAVES = 8;

constexpr size_t MiB = 1u << 20;
constexpr size_t WS_CTL = 0, CTL_ZERO_BYTES = 1 * MiB;
constexpr size_t WS_MOD = 1 * MiB;
constexpr size_t WS_ROPE = 1 * MiB + 512 * 1024;
constexpr size_t WS_ROUTE = 2 * MiB;
constexpr size_t WS_RIDX = 3 * MiB;
constexpr size_t WS_W_IN = 8 * MiB, WS_W_G = 12 * MiB, WS_W_OUT = 13 * MiB, WS_W_QKV = 15 * MiB, WS_W_O = 18 * MiB;
constexpr size_t WS_W13 = 20 * MiB, WS_W2 = 84 * MiB;
constexpr size_t WS_CTX = 116 * MiB;
constexpr size_t WS_XN = 124 * MiB;
constexpr size_t WS_G = 192 * MiB;
constexpr size_t WS_LA0 = 260 * MiB, WS_BB0 = 328 * MiB, WS_LA1 = 396 * MiB;
constexpr size_t WS_ACT = 192 * MiB;
constexpr size_t WS_Y = 264 * MiB;
constexpr size_t WS_Q = 192 * MiB, WS_K = 256 * MiB, WS_V = 273 * MiB;
constexpr size_t WS_O = 290 * MiB;
constexpr size_t WS_XB = 396 * MiB;
constexpr size_t WS_END = 464 * MiB;
constexpr size_t DO_U = 0, DO_SUMM = 68 * MiB, DO_CARRY = 88 * MiB;
constexpr int CW_TMO = 0, CW_CODE = 1, CW_CNT = 64  , CW_BAR = 4096, CW_TILE = 65536  ;

constexpr int RING_OFF = 0, RING_BYTES = 131072;
constexpr int LDSCTL_OFF = RING_BYTES, MISC_OFF = LDSCTL_OFF + 320;
constexpr int TAB_OFF = RING_BYTES + 1024, TAB_UNITS = 6;
constexpr int LDS_BYTES = 147456;
static_assert(TAB_OFF + 2 * TAB_UNITS * 1024 <= LDS_BYTES, "LDS map");

#define GAS __attribute__((address_space(1)))
#define LAS __attribute__((address_space(3)))
typedef unsigned short bf16;
typedef unsigned v4u __attribute__((ext_vector_type(4)));
typedef unsigned v2u __attribute__((ext_vector_type(2)));
typedef float f32x4 __attribute__((ext_vector_type(4)));
typedef float f32x2 __attribute__((ext_vector_type(2)));
typedef short bf16x8 __attribute__((ext_vector_type(8)));
typedef GAS unsigned gu32;
#define RLX_AGENT __ATOMIC_RELAXED, __HIP_MEMORY_SCOPE_AGENT
#define LDS_WAIT() asm volatile("s_waitcnt lgkmcnt(0)" ::: "memory")
#define VM_WAIT() asm volatile("s_waitcnt vmcnt(0)" ::: "memory")
__device__ __forceinline__ unsigned f2bf(float f) { unsigned u = __builtin_bit_cast(unsigned, f); return (u + 0x7fffu + ((u >> 16) & 1u)) >> 16; }
__device__ __forceinline__ unsigned pk2(float lo, float hi) { return f2bf(lo) | (f2bf(hi) << 16); }
__device__ __forceinline__ float bflo(unsigned w) { return __builtin_bit_cast(float, w << 16); }
__device__ __forceinline__ float bfhi(unsigned w) { return __builtin_bit_cast(float, w & 0xffff0000u); }
__device__ __forceinline__ float fast_exp2(float x) { return __builtin_amdgcn_exp2f(x); }
__device__ __forceinline__ float fast_rcp(float x) { return __builtin_amdgcn_rcpf(x); }
__device__ __forceinline__ float sigmoid_f(float x) { return fast_rcp(1.0f + fast_exp2(-1.4426950408889634f * x)); }

#define XB_TMO      128
#define XB_XCNT(j)  (256  + 64 * (j))
#define XB_XSUB(j)  (1280 + 64 * (j))
#define XB_XGEN(j)  (2304 + 64 * (j))
#define XB_TOP      3328
#define XB_TOPGEN   3392
#define XCD_BAR_WORDS 3456
#define XB_SPIN_CAP (1u << 18)

__device__ __forceinline__ unsigned xb_ld(unsigned* p)              { return __hip_atomic_load(p, __ATOMIC_RELAXED, __HIP_MEMORY_SCOPE_AGENT); }
__device__ __forceinline__ unsigned xb_add(unsigned* p, unsigned v) { return __hip_atomic_fetch_add(p, v, __ATOMIC_RELAXED, __HIP_MEMORY_SCOPE_AGENT); }
__device__ __forceinline__ unsigned xb_xcc_id() { return (unsigned)__builtin_amdgcn_s_getreg((3 << 11) | 20) & 0xFu; }
#define XB_SPIN(cond, bar) do { unsigned _sp = 0; while (cond) { __builtin_amdgcn_s_sleep(1); \
    if ((++_sp & 255u) == 0u) { if (xb_ld(&(bar)[XB_TMO])) break; if (_sp > XB_SPIN_CAP) { atomicAdd(&(bar)[XB_TMO], 1u); break; } } } } while (0)

struct XcdBarrier { unsigned* bar; unsigned x; volatile LAS unsigned* st; };

__device__ __forceinline__ XcdBarrier xcd_barrier_post(unsigned* bar, volatile LAS unsigned* st) {
    XcdBarrier b; b.bar = bar; b.x = xb_xcc_id(); b.st = st;
    if (threadIdx.x == 0) (void)xb_add(&bar[XB_XCNT(b.x)], 1u);
    return b;
}
__device__ __forceinline__ void xcd_barrier_complete(unsigned* bar, unsigned x, unsigned& nloc, unsigned& nx) {
    const unsigned G = gridDim.x * gridDim.y * gridDim.z;
    unsigned sum, cnt, mine, sp = 0u;
    for (;;) {
        sum = 0u; cnt = 0u; mine = 0u;
#pragma unroll
        for (unsigned j = 0; j < 16; ++j) { const unsigned c = xb_ld(&bar[XB_XCNT(j)]); sum += c; cnt += (c > 0u) ? 1u : 0u; mine = (j == x) ? c : mine; }
        if (sum == G) break;
        __builtin_amdgcn_s_sleep(1);
        if ((++sp & 255u) == 0u) { if (xb_ld(&bar[XB_TMO])) break; if (sp > XB_SPIN_CAP) { atomicAdd(&bar[XB_TMO], 1u); break; } }
    }
    nloc = mine > 0u ? mine : 1u; nx = cnt > 0u ? cnt : 1u;
}
__device__ __forceinline__ void xcd_barrier(const XcdBarrier& b) {
    asm volatile("s_waitcnt vmcnt(0)" ::: "memory");
    __syncthreads();
    if (threadIdx.x == 0) {
        unsigned* bar = b.bar;
        __builtin_amdgcn_s_waitcnt(0);
        unsigned nloc = b.st[0], nx = b.st[1];
        if (nloc == 0u) { xcd_barrier_complete(bar, b.x, nloc, nx); b.st[0] = nloc; b.st[1] = nx; }
        const unsigned old = xb_add(&bar[XB_XSUB(b.x)], 1u);
        const unsigned gen = old / nloc;
        if (old + 1u == (gen + 1u) * nloc) {
            __builtin_amdgcn_fence(__ATOMIC_RELEASE, "agent");
            asm volatile("s_waitcnt vmcnt(0)" ::: "memory");
            const unsigned og = xb_add(&bar[XB_TOP], 1u);
            const unsigned tg = og / nx;
            if (og + 1u == (tg + 1u) * nx) xb_add(&bar[XB_TOPGEN], 1u);
            else XB_SPIN(xb_ld(&bar[XB_TOPGEN]) == tg, bar);
            __builtin_amdgcn_fence(__ATOMIC_ACQUIRE, "agent");
            xb_add(&bar[XB_XGEN(b.x)], 1u);
            asm volatile("s_waitcnt vmcnt(0)" ::: "memory");
        } else {
            XB_SPIN(xb_ld(&bar[XB_XGEN(b.x)]) == gen, bar);
            __builtin_amdgcn_fence(__ATOMIC_ACQUIRE, "agent");
            asm volatile("s_waitcnt vmcnt(0)" ::: "memory");
        }
    }
    __syncthreads();
}
namespace pg8 {
#define PG8_LAS __attribute__((address_space(3)))
typedef unsigned short bf16_t;
typedef short bf16x8 __attribute__((ext_vector_type(8)));
typedef float f32x4 __attribute__((ext_vector_type(4)));
typedef unsigned u32x4 __attribute__((ext_vector_type(4)));
constexpr int BM = 256, BK = 64, HALF = 128, HTB = HALF * BK * 2, STAGE_BYTES = 8 * HTB, NXCD = 8, WGM = 8;

__host__ __device__ __forceinline__ int lds_byte(int r, int c) { const int st = (r >> 4) * 2 + (c >> 5), rr = r & 15, cc = c & 31, ob = rr * 64 + cc * 2; return st * 1024 + (ob ^ (((ob >> 9) & 1) << 5)); }
__host__ __device__ __forceinline__ void stage_rc(int b, int& R, int& C) { const int st = b / 1024, sb = b % 1024, swz = sb ^ (((sb >> 9) & 1) << 5); R = (st >> 1) * 16 + swz / 64; C = (st & 1) * 32 + (swz % 64) / 2; }
__host__ __device__ __forceinline__ int perm32(int rho) { const int n = rho >> 4, i = rho & 15; return 8 * (i >> 2) + 4 * n + (i & 3); }

struct Unit { int pm, pn; int arow, acol, brow; int x0, x1, x2, ord; int brow2, ksplit; };
struct Gemm { const void* A; const void* Bt; int lda, ldb, K; unsigned* hcnt = nullptr; unsigned hneed = 8u; };
typedef int v8i32 __attribute__((ext_vector_type(8)));
struct Frag2 { bf16x8 v[2]; __device__ __forceinline__ bf16x8& operator[](int i) { return v[i]; } __device__ __forceinline__ const bf16x8& operator[](int i) const { return v[i]; } };

__device__ __forceinline__ void tile_of(int L, int nM, int nN, int& pm, int& pn) {
    const int nwg = nM * nN; int wgid = L;
    { const int q = nwg / NXCD, r = nwg % NXCD, xcd = wgid % NXCD, off = wgid / NXCD; wgid = (xcd < r ? xcd * (q + 1) : r * (q + 1) + (xcd - r) * q) + off; }
    const int nig = WGM * nN, gid = wgid / nig, fm = gid * WGM, gsz = (nM - fm) < WGM ? (nM - fm) : WGM;
    pm = fm + ((wgid % nig) % gsz); pn = (wgid % nig) / gsz;
}

__device__ __forceinline__ unsigned cvt_pk_bf16(float lo, float hi) { unsigned r; asm volatile("v_cvt_pk_bf16_f32 %0, %1, %2" : "=v"(r) : "v"(lo), "v"(hi)); return r; }

constexpr unsigned HO_SPIN_CAP = 1u << 22;
__device__ __forceinline__ void ho_publish(unsigned* hcnt, int tile) { (void)__hip_atomic_fetch_add(hcnt + tile * 16, 1u, __ATOMIC_RELAXED, __HIP_MEMORY_SCOPE_AGENT); }
__device__ __forceinline__ void ho_acquire(unsigned* hcnt, int tile, unsigned need) {
    unsigned sp = 0; unsigned* htmo = hcnt - 16;
    while ((unsigned)__builtin_amdgcn_readfirstlane((int)__hip_atomic_load(hcnt + tile * 16, __ATOMIC_RELAXED, __HIP_MEMORY_SCOPE_AGENT)) < need) {
        __builtin_amdgcn_s_sleep(1);
        if ((++sp & 255u) == 0u) { if (__builtin_amdgcn_readfirstlane((int)__hip_atomic_load(htmo, __ATOMIC_RELAXED, __HIP_MEMORY_SCOPE_AGENT))) break;
            if (sp > HO_SPIN_CAP) { (void)__hip_atomic_fetch_add(htmo, 1u, __ATOMIC_RELAXED, __HIP_MEMORY_SCOPE_AGENT); break; } } }
    __builtin_amdgcn_fence(__ATOMIC_ACQUIRE, "agent");
    asm volatile("s_waitcnt vmcnt(0)" ::: "memory");
}
template <class Epi, class Sched, bool GATHER, int ES = 2, int HO = 0>
__device__ __forceinline__ void gemm_phase(PG8_LAS unsigned char* lds, const Gemm g, const Sched& S, const Epi& E, const PG8_LAS int* tab) {
    const int tid = threadIdx.x, wid = __builtin_amdgcn_readfirstlane(tid >> 6), lane = tid & 63, wr = wid >> 2, wc = wid & 3, fr = lane & 15, fq = lane >> 4;
    const int K = g.K, nt = K * ES / (BK * 2), lda = g.lda * ES, ldb = g.ldb * ES;
    unsigned voffA[2], voffB[2]; int Rst[2], Cst[2];
#pragma unroll
    for (int i = 0; i < 2; ++i) { int R, C; stage_rc(tid * 16 + i * 8192, R, C); const int Rb = Epi::PERM ? ((R & ~31) + perm32(R & 31)) : R;
        voffA[i] = (unsigned)(R * lda + C * 2); voffB[i] = (unsigned)(Rb * ldb + C * 2); Rst[i] = R; Cst[i] = C * 2; }
    const size_t kstep = (size_t)(BK * 2);
    const size_t hstepA = GATHER ? (size_t)0 : (size_t)HALF * lda, hstepB = (size_t)HALF * ldb;
    const unsigned ldsw = (unsigned)wid * 1024u;
    const int aoff = lds_byte(wr * 64 + fr, fq * 8), boff = lds_byte(wc * 32 + fr, fq * 8);
#define PG8_SA(b, h) (((b) * 2 + (h)) * HTB)
#define PG8_SB(b, h) ((4 + (b) * 2 + (h)) * HTB)
#define PG8_STAGE(bufoff, gbase, voff) do { _Pragma("unroll") for (int _i = 0; _i < 2; ++_i) \
        __builtin_amdgcn_global_load_lds((const unsigned*)((const char*)(gbase) + (voff)[_i]), (PG8_LAS unsigned*)(lds + (bufoff) + ldsw + _i * 8192), 16, 0, 0); } while (0)
#define PG8_LDA(dst, b, h) do { _Pragma("unroll") for (int m = 0; m < 4; ++m) _Pragma("unroll") for (int k = 0; k < 2; ++k) dst[m][k] = *(const PG8_LAS bf16x8*)(lds + PG8_SA(b, h) + aoff + m * 2048 + k * 1024); } while (0)
#define PG8_LDB(dst, b, h) do { _Pragma("unroll") for (int n = 0; n < 2; ++n) _Pragma("unroll") for (int k = 0; k < 2; ++k) dst[n][k] = *(const PG8_LAS bf16x8*)(lds + PG8_SB(b, h) + boff + n * 2048 + k * 1024); } while (0)
#define PG8_MMA(ai, bj, At, Bt) do { __builtin_amdgcn_s_setprio(1); \
        if constexpr (ES == 2) { _Pragma("unroll") for (int m = 0; m < 4; ++m) _Pragma("unroll") for (int n = 0; n < 2; ++n) _Pragma("unroll") for (int k = 0; k < 2; ++k) \
            acc[ai][bj][m][n] = __builtin_amdgcn_mfma_f32_16x16x32_bf16(Bt[n][k], At[m][k], acc[ai][bj][m][n], 0, 0, 0); } \
        else { asm volatile("s_nop 1"); _Pragma("unroll") for (int m = 0; m < 4; ++m) _Pragma("unroll") for (int n = 0; n < 2; ++n) \
            asm volatile("v_mfma_f32_16x16x128_f8f6f4 %0, %1, %2, %0" : "+v"(acc[ai][bj][m][n]) : "v"(__builtin_bit_cast(v8i32, Bt[n])), "v"(__builtin_bit_cast(v8i32, At[m]))); } \
        __builtin_amdgcn_s_setprio(0); } while (0)
#define PG8_WAIT_V(n) asm volatile("s_waitcnt vmcnt(" #n ")" ::: "memory")
#define PG8_WAIT_L(n) asm volatile("s_waitcnt lgkmcnt(" #n ")" ::: "memory")
#define PG8_BAR __builtin_amdgcn_s_barrier()
#define PG8_SCHED __builtin_amdgcn_sched_barrier(0)
#define PG8_GLOAD(dst, ui_) do { _Pragma("unroll") for (int _h = 0; _h < 2; ++_h) _Pragma("unroll") for (int _i = 0; _i < 2; ++_i) \
        dst[_h][_i] = (unsigned)tab[(ui_) * 256 + _h * 128 + Rst[_i]] * (unsigned)lda + (unsigned)Cst[_i]; } while (0)
    const int sc8 = 0x7f7f7f7f;
    (void)sc8;
    Unit cur, nxt; int ui = 0;
    if (!S.next(0, cur)) return;
    f32x4 acc[2][2][4][2];
#pragma unroll
    for (int a = 0; a < 2; ++a)
#pragma unroll
        for (int b = 0; b < 2; ++b)
#pragma unroll
            for (int m = 0; m < 4; ++m)
#pragma unroll
                for (int n = 0; n < 2; ++n) acc[a][b][m][n] = (f32x4){0.f, 0.f, 0.f, 0.f};
    Frag2 At[4], B0[2], B1[2];
    unsigned gcur[2][2], gnxt[2][2];
    if constexpr (GATHER) { PG8_GLOAD(gcur, 0); } else {
#pragma unroll
        for (int h = 0; h < 2; ++h)
#pragma unroll
            for (int i = 0; i < 2; ++i) { gcur[h][i] = voffA[i]; gnxt[h][i] = voffA[i]; } }
    const char* cA = (const char*)g.A + (size_t)(GATHER ? 0 : cur.arow) * lda + (size_t)cur.acol * ES; const char* cB = (const char*)g.Bt + (size_t)cur.brow * ldb;
    const char* cB2 = cur.ksplit ? (const char*)g.Bt + (size_t)cur.brow2 * ldb - (size_t)cur.ksplit * kstep : cB; int ksp = cur.ksplit ? cur.ksplit : (1 << 30);
    int pend = -1;
    if constexpr (HO == 2) { if (wid == 0) ho_acquire(g.hcnt, cur.pm, g.hneed); __syncthreads(); }
    PG8_STAGE(PG8_SB(0, 0), cB, voffB); PG8_STAGE(PG8_SB(0, 1), cB + hstepB, voffB); PG8_STAGE(PG8_SA(0, 0), cA, gcur[0]); PG8_STAGE(PG8_SA(0, 1), cA + hstepA, gcur[1]);
    if (wr == 1) PG8_BAR;
    PG8_WAIT_V(2); PG8_BAR;
    PG8_STAGE(PG8_SB(1, 0), cB + kstep, voffB); PG8_STAGE(PG8_SA(1, 0), cA + kstep, gcur[0]); PG8_STAGE(PG8_SB(1, 1), cB + hstepB + kstep, voffB);
    PG8_WAIT_V(6); PG8_BAR;
    for (;;) {
        const bool has_next = S.next(ui + 1, nxt);
        if constexpr (HO == 2) { if (has_next && wid == 0) ho_acquire(g.hcnt, nxt.pm, g.hneed); }
        const char* nA = has_next ? (const char*)g.A + (size_t)(GATHER ? 0 : nxt.arow) * lda + (size_t)nxt.acol * ES : cA; const char* nB = has_next ? (const char*)g.Bt + (size_t)nxt.brow * ldb : cB;
        if constexpr (GATHER) { if (has_next) { PG8_GLOAD(gnxt, ui + 1); } else {
#pragma unroll
            for (int h = 0; h < 2; ++h)
#pragma unroll
                for (int i = 0; i < 2; ++i) gnxt[h][i] = gcur[h][i]; } }
#pragma nounroll
        for (int t = 0; t < nt; t += 2) {
            const bool last = (t == nt - 2);
            const char* a1 = cA + (size_t)(t + 1) * kstep;
            const char* a2 = last ? nA : cA + (size_t)(t + 2) * kstep; const char* b2 = last ? nB : (t + 2 >= ksp ? cB2 : cB) + (size_t)(t + 2) * kstep;
            const char* a3 = a2 + kstep; const char* b3 = b2 + kstep;
            unsigned s0[2], s1[2];
#pragma unroll
            for (int i = 0; i < 2; ++i) { s0[i] = (GATHER && last) ? gnxt[0][i] : gcur[0][i]; s1[i] = (GATHER && last) ? gnxt[1][i] : gcur[1][i]; }
            PG8_LDB(B0, 0, 0); PG8_LDB(B1, 0, 1); PG8_SCHED; PG8_LDA(At, 0, 0); PG8_STAGE(PG8_SA(1, 1), a1 + hstepA, gcur[1]);
            PG8_WAIT_V(8); PG8_WAIT_L(0); PG8_BAR; PG8_MMA(0, 0, At, B0); PG8_MMA(0, 1, At, B1); PG8_BAR; PG8_SCHED;
            PG8_LDA(At, 0, 1); PG8_STAGE(PG8_SB(0, 0), b2, voffB); PG8_STAGE(PG8_SB(0, 1), b2 + hstepB, voffB); PG8_STAGE(PG8_SA(0, 0), a2, s0);
            PG8_WAIT_V(8); PG8_WAIT_L(0); PG8_BAR; PG8_MMA(1, 0, At, B0); PG8_MMA(1, 1, At, B1); PG8_BAR; PG8_SCHED;
            PG8_LDB(B0, 1, 0); PG8_LDB(B1, 1, 1); PG8_SCHED; PG8_LDA(At, 1, 0); PG8_STAGE(PG8_SA(0, 1), a2 + hstepA, s1);
            PG8_WAIT_V(8); PG8_WAIT_L(0); PG8_BAR; PG8_MMA(0, 0, At, B0); PG8_MMA(0, 1, At, B1); PG8_BAR; PG8_SCHED;
            PG8_LDA(At, 1, 1); PG8_STAGE(PG8_SB(1, 0), b3, voffB); PG8_STAGE(PG8_SB(1, 1), b3 + hstepB, voffB); PG8_STAGE(PG8_SA(1, 0), a3, s0);
            PG8_WAIT_V(8); PG8_WAIT_L(0); PG8_BAR; PG8_MMA(1, 0, At, B0); PG8_MMA(1, 1, At, B1); PG8_BAR; PG8_SCHED;
        }
        if (wr == 0) PG8_BAR;
        if constexpr (HO == 1) { if (pend >= 0 && tid == 0) ho_publish(g.hcnt, pend); }
        if constexpr (ES == 1) asm volatile("s_nop 15\n\ts_nop 15" ::: "memory");
        E(acc, cur, wr, wc, fr, fq);
        if constexpr (HO == 1) pend = cur.pm;
        if (!has_next) break;
#pragma unroll
        for (int a = 0; a < 2; ++a)
#pragma unroll
            for (int b = 0; b < 2; ++b)
#pragma unroll
                for (int m = 0; m < 4; ++m)
#pragma unroll
                    for (int n = 0; n < 2; ++n) acc[a][b][m][n] = (f32x4){0.f, 0.f, 0.f, 0.f};
        cur = nxt; cA = nA; cB = nB; ++ui;
        cB2 = cur.ksplit ? (const char*)g.Bt + (size_t)cur.brow2 * ldb - (size_t)cur.ksplit * kstep : cB; ksp = cur.ksplit ? cur.ksplit : (1 << 30);
        if constexpr (GATHER) {
#pragma unroll
            for (int h = 0; h < 2; ++h)
#pragma unroll
                for (int i = 0; i < 2; ++i) gcur[h][i] = gnxt[h][i]; }
        if (wr == 1) PG8_BAR;
    }
    PG8_WAIT_V(0);
    PG8_BAR;
    if constexpr (HO == 1) { if (pend >= 0 && tid == 0) ho_publish(g.hcnt, pend); }
#undef PG8_SA
#undef PG8_SB
#undef PG8_STAGE
#undef PG8_LDA
#undef PG8_LDB
#undef PG8_MMA
#undef PG8_WAIT_V
#undef PG8_WAIT_L
#undef PG8_BAR
#undef PG8_SCHED
#undef PG8_GLOAD
}
}
namespace attn8 {
using f32x16 = __attribute__((ext_vector_type(16))) float;
using f32x4 = __attribute__((ext_vector_type(4))) float;
using u32x4 = __attribute__((ext_vector_type(4))) unsigned;
using v8i32 = __attribute__((ext_vector_type(8))) int;
constexpr int NHEAD = 16, SEQ = 4096, KVSEQ = 4352, DMQ = 1024, DMK = 256, NT = KVSEQ / 64;
constexpr float QS = 2.0f * 1.4426950408889634f, KS = 0.5f, VS = 8.0f, PS = 16.0f, OS = 4.0f;
constexpr float CS = 0.125f * 1.4426950408889634f / (QS * KS);
constexpr int THRL = 4;
constexpr int SLOTB = 4096, LDS_BYTES = 16 * SLOTB + 8 * 256 + 8 * 4096;
__host__ __device__ __forceinline__ int crow(int r, int hi) { return (r & 3) + 8 * (r >> 2) + 4 * hi; }
__host__ __device__ __forceinline__ int vpos(int kk) { return 32 * ((kk >> 2) & 1) + (kk & 3) + 4 * ((kk >> 3) & 3) + 16 * (kk >> 5); }
__device__ __forceinline__ void glds16(const void* gsrc, unsigned lds_dst) { unsigned keep;
    asm volatile("s_mov_b32 %0, m0\n\ts_mov_b32 m0, %2\n\ts_nop 0\n\tglobal_load_lds_dwordx4 %1, off\n\ts_mov_b32 m0, %0" : "=&s"(keep) : "v"(gsrc), "s"(lds_dst) : "memory"); }
#define A8_WAIT_BAR(N) asm volatile("s_waitcnt vmcnt(" #N ") lgkmcnt(0)\n\ts_barrier" ::: "memory")
__device__ __forceinline__ unsigned pk4(float a, float b, float c, float d) { unsigned w = 0u; w = (unsigned)__builtin_amdgcn_cvt_pk_fp8_f32(a, b, (int)w, false); w = (unsigned)__builtin_amdgcn_cvt_pk_fp8_f32(c, d, (int)w, true); return w; }
typedef __attribute__((address_space(3))) const unsigned char* lds_cptr;

__device__ __forceinline__ float max3f(float a, float b, float c) { float r; asm("v_max3_f32 %0, %1, %2, %3" : "=v"(r) : "v"(a), "v"(b), "v"(c)); return r; }
__device__ __forceinline__ unsigned pk4a(float a, float b, float c, float d) { unsigned w; asm("v_cvt_pk_fp8_f32 %0, %1, %2\n\tv_cvt_pk_fp8_f32 %0, %3, %4 op_sel:[0,0,1]" : "=&v"(w) : "v"(a), "v"(b), "v"(c), "v"(d)); return w; }
constexpr int NSLOTV = 4;
constexpr int LDS2_K = 0, LDS2_V = 8 * SLOTB, LDS2_WS = LDS2_V + 8 * SLOTB, LDS2_OST = LDS2_WS + 8 * 256, LDS2_BYTES = LDS2_OST + 8 * 4096;
__device__ __forceinline__ void attn_unit(int b, int h, int qb, bool first, bool has_next, int nb, int nh, const unsigned char* Q8, const unsigned char* K8, const unsigned char* Vt8, unsigned char* O8, char* shm) {
    const int tid = threadIdx.x, lane = tid & 63, r32 = lane & 31, hi = lane >> 5; const int wid = __builtin_amdgcn_readfirstlane(tid >> 6);
    const int kvh = h >> 2, q0 = qb * 256;
    const unsigned lds0 = (unsigned)(uintptr_t)shm;
    float* wsf = (float*)(shm + LDS2_WS) + wid * 64;
    const unsigned char* qp = Q8 + (size_t)((size_t)b * SEQ + q0 + wid * 32 + r32) * DMQ + h * 64 + 32 * hi;
    const u32x4 qa = *(const u32x4*)qp, qb4 = *(const u32x4*)(qp + 16);
    const v8i32 q8 = {(int)qa.x, (int)qa.y, (int)qa.z, (int)qa.w, (int)qb4.x, (int)qb4.y, (int)qb4.z, (int)qb4.w};
    const int w4 = wid & 3, drow = w4 * 16 + (lane >> 2), dc = (lane & 3) ^ ((drow >> 2) & 3);
    const bool isk = wid < 4;
    const unsigned char* dsrc = isk ? K8 + ((size_t)b * KVSEQ + drow) * DMK + kvh * 64 + dc * 16 : Vt8 + ((size_t)(b * 4 + kvh) * 64 + drow) * KVSEQ + dc * 16;
    const size_t dstep = isk ? (size_t)64 * DMK : (size_t)64;
    const unsigned ddst = lds0 + (isk ? LDS2_K : LDS2_V) + w4 * 1024;
#define A8_DMA(t, slot) glds16(dsrc + (size_t)(t) * dstep, (unsigned)__builtin_amdgcn_readfirstlane(ddst + (slot)))
    if (first) { A8_DMA(0, 0); A8_DMA(1, SLOTB); A8_DMA(2, 2 * SLOTB); if (isk) { A8_DMA(3, 3 * SLOTB); A8_DMA(4, 4 * SLOTB); A8_DMA(5, 5 * SLOTB); } }
    const int sw = (r32 >> 2) & 3, fo0 = r32 * 64 + (((2 * hi) ^ sw) << 4), fo1 = r32 * 64 + (((2 * hi + 1) ^ sw) << 4);
    const lds_cptr kb = (lds_cptr)shm + LDS2_K, vb = (lds_cptr)shm + LDS2_V;
    typedef const __attribute__((address_space(3))) u32x4* lds_v4;
#define A8_FRAG(dst, base, off) do { const u32x4 a_ = *(lds_v4)((base) + (off) + fo0), b_ = *(lds_v4)((base) + (off) + fo1); \
        dst = (v8i32){(int)a_.x, (int)a_.y, (int)a_.z, (int)a_.w, (int)b_.x, (int)b_.y, (int)b_.z, (int)b_.w}; } while (0)
    constexpr float LP = 4.0f, DB = 55.66f, DTH = 8.0f * (LP + (float)THRL) + DB;
    float mhat = 0.f; f32x16 o0 = f32x16{}, o1 = f32x16{}; f32x4 ls4 = f32x4{};
    f32x16 cb; { const float c_ = 8.0f * LP + DB;
#pragma unroll
      for (int r = 0; r < 16; ++r) cb[r] = c_; }
    constexpr int sc1 = 0, scq = 0;
    const int selv = (((lane >> 4) & 1) == ((lane & 15) >> 3)) ? 0x38383838 : 0; const v8i32 sel = {selv, selv, selv, selv, selv, selv, selv, selv};
    const int qs0 = 4 * (lane >> 4) + 16 * ((lane & 15) >> 3);
    A8_WAIT_BAR(0);
    f32x16 c0, c1;
    v8i32 ka0, ka1, kb0, kb1;
    A8_FRAG(ka0, kb + SLOTB, 0); A8_FRAG(ka1, kb + SLOTB, 2048);
    { v8i32 kf0, kf1; A8_FRAG(kf0, kb, 0); A8_FRAG(kf1, kb, 2048);
      c0 = __builtin_amdgcn_mfma_scale_f32_32x32x64_f8f6f4(kf0, q8, cb, 0, 0, 0, scq, 0, sc1);
      c1 = __builtin_amdgcn_mfma_scale_f32_32x32x64_f8f6f4(kf1, q8, cb, 0, 0, 0, scq, 0, sc1); }
    asm volatile("s_nop 15\n\ts_nop 15\n\ts_nop 15\n\ts_nop 15\n\ts_nop 15\n\ts_nop 15" : "+v"(c0), "+v"(c1));
    v8i32 p8 = {0, 0, 0, 0, 0, 0, 0, 0};
    f32x16 d0, d1;
#define A8_STEP(S0, S1, N0, N1, KC0, KC1, KN0, KN1, t, SOFTMAX, BAR) do { \
        if (BAR) { A8_WAIT_BAR(0);                                                     \
            _Pragma("unroll") for (int i_ = 0; i_ < 4; ++i_) { const int tk_ = (t) + 6 + i_, tv_ = (t) + 3 + i_; \
                if (isk) { if (tk_ < NT) A8_DMA(tk_, (tk_ & 7) * SLOTB); } else { if (tv_ < NT) A8_DMA(tv_, (tv_ & 7) * SLOTB); } } } \
        v8i32 vf0, vf1; \
        { const lds_cptr kp_ = kb + (((t) + 2) & 7) * SLOTB; A8_FRAG(KN0, kp_, 0); A8_FRAG(KN1, kp_, 2048); }     \
        { const lds_cptr vp_ = vb + (((t) == 0 ? 0 : (t) - 1) & 7) * SLOTB; A8_FRAG(vf0, vp_, 0); A8_FRAG(vf1, vp_, 2048); }     \
        __builtin_amdgcn_sched_barrier(0); \
        float rmc; \
        { float a = fmaxf(S0[0], S1[0]), bq = fmaxf(S0[1], S1[1]); \
          _Pragma("unroll") for (int r = 2; r < 16; r += 2) { a = __builtin_fmaxf(__builtin_fmaxf(a, S0[r]), S1[r]); bq = __builtin_fmaxf(__builtin_fmaxf(bq, S0[r + 1]), S1[r + 1]); } \
          rmc = fmaxf(a, bq); } \
        { auto rr = __builtin_amdgcn_permlane32_swap(__float_as_uint(rmc), __float_as_uint(rmc), false, false); rmc = fmaxf(__uint_as_float(rr[0]), __uint_as_float(rr[1])); } \
        __builtin_amdgcn_sched_barrier(0); \
        N0 = __builtin_amdgcn_mfma_scale_f32_32x32x64_f8f6f4(KC0, q8, cb, 0, 0, 0, scq, 0, sc1); \
        N1 = __builtin_amdgcn_mfma_scale_f32_32x32x64_f8f6f4(KC1, q8, cb, 0, 0, 0, scq, 0, sc1); \
        o0 = __builtin_amdgcn_mfma_scale_f32_32x32x64_f8f6f4(p8, vf0, o0, 0, 0, 0, sc1, 0, sc1); \
        o1 = __builtin_amdgcn_mfma_scale_f32_32x32x64_f8f6f4(p8, vf1, o1, 0, 0, 0, sc1, 0, sc1); \
        ls4 = __builtin_amdgcn_mfma_scale_f32_16x16x128_f8f6f4(p8, sel, ls4, 0, 0, 0, sc1, 0, sc1); \
        __builtin_amdgcn_sched_barrier(0); \
        if (SOFTMAX) { \
            bool resc = false; \
            if ((t) == 0 || __any(rmc > DTH)) {                                       \
                const float dl = ((t) == 0) ? (rmc - DB) * 0.125f - LP : fmaxf((rmc - DB) * 0.125f - LP, 0.f); mhat += dl; const float dl8 = 8.0f * dl; \
                _Pragma("unroll") for (int r = 0; r < 16; ++r) { S0[r] -= dl8; S1[r] -= dl8; N0[r] -= dl8; N1[r] -= dl8; cb[r] -= dl8; } \
                const float f = __builtin_amdgcn_exp2f(-dl); if (hi == 0) wsf[r32] = f; resc = true; } \
            _Pragma("unroll") for (int g = 0; g < 4; ++g) { unsigned wa = __builtin_amdgcn_cvt_pk_u8_f32(S0[4 * g], 0, 0u), wb = __builtin_amdgcn_cvt_pk_u8_f32(S1[4 * g], 0, 0u); \
                _Pragma("unroll") for (int j = 1; j < 4; ++j) { wa = __builtin_amdgcn_cvt_pk_u8_f32(S0[4 * g + j], j, wa); wb = __builtin_amdgcn_cvt_pk_u8_f32(S1[4 * g + j], j, wb); } \
                p8[g] = (int)wa; p8[4 + g] = (int)wb; } \
            if (resc) { asm volatile("s_waitcnt lgkmcnt(0)" ::: "memory"); \
                _Pragma("unroll") for (int r = 0; r < 16; ++r) { const float f = wsf[crow(r, hi)]; o0[r] *= f; o1[r] *= f; } \
                _Pragma("unroll") for (int i = 0; i < 4; ++i) ls4[i] *= wsf[qs0 + i]; } \
        } \
    } while (0)
    static_assert(NT % 4 == 0, "groups of four tiles");
#pragma nounroll
    for (int t = 0; t < NT; t += 4) {
        A8_STEP(c0, c1, d0, d1, ka0, ka1, kb0, kb1, t, true, true);
        A8_STEP(d0, d1, c0, c1, kb0, kb1, ka0, ka1, t + 1, true, false);
        A8_STEP(c0, c1, d0, d1, ka0, ka1, kb0, kb1, t + 2, true, false);
        A8_STEP(d0, d1, c0, c1, kb0, kb1, ka0, ka1, t + 3, true, false);
    }
    A8_STEP(c0, c1, d0, d1, ka0, ka1, kb0, kb1, NT, false, true);
#undef A8_STEP
    asm volatile("s_waitcnt lgkmcnt(0)\n\ts_barrier" ::: "memory");
    if (has_next) { const int nkvh = nh >> 2;
        const unsigned char* nsrc = isk ? K8 + ((size_t)nb * KVSEQ + drow) * DMK + nkvh * 64 + dc * 16 : Vt8 + ((size_t)(nb * 4 + nkvh) * 64 + drow) * KVSEQ + dc * 16;
#define A8_DMAN(t, slot) glds16(nsrc + (size_t)(t) * dstep, (unsigned)__builtin_amdgcn_readfirstlane(ddst + (slot)))
        A8_DMAN(0, 0); A8_DMAN(1, SLOTB); A8_DMAN(2, 2 * SLOTB); if (isk) { A8_DMAN(3, 3 * SLOTB); A8_DMAN(4, 4 * SLOTB); A8_DMAN(5, 5 * SLOTB); }
#undef A8_DMAN
    }
    if ((lane & 7) == 0) {
#pragma unroll
        for (int i = 0; i < 4; ++i) wsf[32 + qs0 + i] = ls4[i]; }
    asm volatile("s_waitcnt lgkmcnt(0)" ::: "memory");
    unsigned char* Ow = O8 + (size_t)((size_t)b * SEQ + q0 + wid * 32) * DMQ + h * 64;
    { unsigned char* stg = (unsigned char*)(shm + LDS2_OST) + wid * 4096;
#pragma unroll
      for (int r = 0; r < 16; ++r) { const int orow = crow(r, hi); const float rl = __builtin_amdgcn_rcpf(wsf[32 + orow]) * (OS / VS);
          const float a = o0[r] * rl, c = o1[r] * rl;
          stg[orow * 64 + r32] = (unsigned char)__builtin_amdgcn_cvt_pk_fp8_f32(a, a, 0, false); stg[orow * 64 + 32 + r32] = (unsigned char)__builtin_amdgcn_cvt_pk_fp8_f32(c, c, 0, false); }
      asm volatile("s_waitcnt lgkmcnt(0)" ::: "memory");
#pragma unroll
      for (int i = 0; i < 2; ++i) { const int row = i * 16 + (lane >> 2), ch = lane & 3; const u32x4 v = *(const u32x4*)(stg + row * 64 + ch * 16); *(u32x4*)(Ow + (size_t)row * DMQ + ch * 16) = v; } }
    asm volatile("s_waitcnt lgkmcnt(0)" ::: "memory");
#undef A8_DMA
#undef A8_FRAG
}
struct Tensors { const unsigned char* Q8; const unsigned char* K8; const unsigned char* Vt8; unsigned char* O8; };
__device__ __forceinline__ void attn_phase(char* lds, const Tensors& T, int grid, int block) {
    const int vcu = (grid % 8 == 0) ? (block % 8) * (grid / 8) + block / 8 : block;
    const int n = (grid == 256) ? 8 : (vcu < 2048 ? (2048 - vcu + grid - 1) / grid : 0);
    for (int i = 0; i < n; ++i) {
        const int idx = (grid == 256) ? (vcu >> 5) * 256 + i * 32 + (vcu & 31) : i * grid + vcu;
        const int idn = (grid == 256) ? (vcu >> 5) * 256 + (i + 1) * 32 + (vcu & 31) : (i + 1) * grid + vcu;
        const int b = idx >> 8, r = idx & 255, rn = idn & 255;
        attn_unit(b, (r >> 6) * 4 + ((r >> 4) & 3), r & 15, i == 0, i + 1 < n, idn >> 8, (rn >> 6) * 4 + ((rn >> 4) & 3), T.Q8, T.K8, T.Vt8, T.O8, lds);
    }
}
#undef A8_WAIT_BAR
}
namespace pg8 {
struct SchedDense {
    int nM, nN, G, c;
    __device__ __forceinline__ bool next(int i, Unit& u) const {
        const int L = i * G + c; if (L >= nM * nN) return false;
        tile_of(L, nM, nN, u.pm, u.pn); u.arow = u.pm * BM; u.acol = 0; u.brow = u.pn * BM; u.x0 = 0; u.x1 = 0; u.x2 = 0; u.ord = i; u.brow2 = 0; u.ksplit = 0; return true; }
};
struct SchedOut {
    int G, c, E;
    __device__ __forceinline__ bool next(int i, Unit& u) const {
        u.acol = 0; u.x0 = 0; u.x1 = 0; u.x2 = 0; u.ord = i; u.brow2 = 0; u.ksplit = 0;
        if (E == 0) { const int L = i * G + c; if (L >= (MT / 256) * 4) return false; tile_of(L, MT / 256, 4, u.pm, u.pn); }
        else { const bool early = c >= G - E;
            if (early && i < 2) { const int e = c - (G - E), m = (e >> 3) + (E >> 3) * i; u.pm = 6 * (e & 7) + (m >> 2); u.pn = m & 3; }
            else { const int L = (early ? i - 2 : i) * G + c, nM = MT / 256 - E / 2; if (L >= nM * 4) return false; int pm_; tile_of(L, nM, 4, pm_, u.pn); u.pm = E / 2 + pm_; } }
        u.arow = u.pm * BM; u.brow = u.pn * BM; return true; }
};
__host__ __device__ __forceinline__ int in_gs(int g) { return g == 0 ? 0 : 1 + 27 * g; }
struct SchedIn {
    int G, c, E;
    __device__ __forceinline__ int cl() const { return E ? (c + E) % G : c; }
    __device__ __forceinline__ bool next(int i, Unit& u) const {
        u.acol = 0; u.x0 = 0; u.x1 = 0; u.x2 = 0; u.ord = i; u.brow2 = 0; u.ksplit = 0;
        if (E == 0) { const int L = i * G + c; if (L >= (MT / 256) * 8) return false; tile_of(L, MT / 256, 8, u.pm, u.pn); }
        else { const bool early = c >= G - E;
            if (early && i < 2) { const int e = c - (G - E), m = (e >> 3) + (E >> 3) * i, ep = 3 * (e & 7) + (m >> 3); u.pm = in_gs(ep % 5) + ep / 5; u.pn = m & 7; }
            else { const int L = (early ? i - 2 : i) * G + cl(); if (L >= 112 * 8) return false; int r; tile_of(L, 112, 8, r, u.pn);
                const int g = (r >= 23) + (r >= 45) + (r >= 67) + (r >= 89), base = g == 0 ? 0 : 1 + 22 * g;
                u.pm = in_gs(g) + (g < 4 ? 5 : 4) + (r - base); } }
        u.arow = u.pm * BM; u.brow = u.pn * BM; return true; }
};
struct SchedGates {
    int nM, G, c;
    __device__ __forceinline__ bool next(int i, Unit& u) const {
        const int L = i * G + c; if (L >= nM * 16) return false;
        tile_of(L, nM, 16, u.pm, u.pn); u.arow = u.pm * BM; u.acol = (u.pn >> 1) * 128; u.brow = u.pn * BM; u.x0 = 0; u.x1 = 0; u.x2 = 0; u.ord = i; u.brow2 = 0; u.ksplit = 0; return true; }
};
struct SchedQKV {
    int G, c;
    __device__ __forceinline__ bool next(int i, Unit& u) const {
        const int L = i * G + c; if (L >= 128 * 6 + 16) return false;
        if (L < 768) tile_of(L, 128, 6, u.pm, u.pn); else { const int j = L - 768; u.pm = 128 + (j >> 1); u.pn = 4 + (j & 1); }
        u.arow = u.pm * BM; u.acol = 0; u.brow = u.pn * BM; u.x0 = 0; u.x1 = 0; u.x2 = 0; u.ord = i; u.brow2 = 0; u.ksplit = 0; return true; }
};
template <bool UP>
struct SchedMoe {
    unsigned cnt[24]; int G, c, total;
    __device__ __forceinline__ void init(const unsigned* cw, int G_, int c_) {
        int acc = 0;
#pragma unroll
        for (int j = 0; j < 24; ++j) { cnt[j] = (unsigned)__builtin_amdgcn_readfirstlane((int)__hip_atomic_load(cw + j, __ATOMIC_RELAXED, __HIP_MEMORY_SCOPE_AGENT)); acc += (int)((cnt[j] + 255u) >> 8); }
        total = acc * (UP ? 8 : 4); G = G_; c = c_;
    }
    __device__ __forceinline__ bool next(int i, Unit& u) const {
        const int L = i * G + c; if (L >= total) return false;
        const int tl = UP ? (L >> 3) : (L >> 2), pn = UP ? (L & 7) : (L & 3); int gid = 0, base = 0, acc = 0; unsigned ce = cnt[0];
#pragma unroll
        for (int j = 0; j < 24; ++j) { const int tj = (int)((cnt[j] + 255u) >> 8); if (tl >= acc) { gid = j; base = acc; ce = cnt[j]; } acc += tj; }
        const int grp = gid / 6, pid = gid - 6 * grp, ea = 4 * grp + (pid < 3 ? 0 : pid < 5 ? 1 : 2), eb = 4 * grp + (pid < 3 ? pid + 1 : pid < 5 ? pid - 1 : 3);
        u.pm = tl; u.pn = pn; u.arow = tl * BM; u.acol = 0; u.x0 = gid; u.x2 = (tl - base) * BM; u.x1 = (int)ce - u.x2; u.ord = i;
        if (UP) { u.brow = (pn < 4 ? ea : eb) * 1024 + (pn & 3) * BM; u.brow2 = 0; u.ksplit = 0; }
        else { u.brow = ea * 1024 + pn * BM; u.brow2 = eb * 1024 + pn * BM; u.ksplit = 4; }
        return true;
    }
};

__device__ __forceinline__ unsigned pk4_fp8(float a, float b, float c, float d) { unsigned w = 0u; w = (unsigned)__builtin_amdgcn_cvt_pk_fp8_f32(a, b, (int)w, false); w = (unsigned)__builtin_amdgcn_cvt_pk_fp8_f32(c, d, (int)w, true); return w; }
constexpr float W8_SCALE = 32.0f, ACT8_SCALE = 4.0f, Y8_SCALE = 8.0f, BB8_SCALE = 16.0f, LA8_SCALE = 256.0f;
struct EpiInProj {
    static constexpr bool PERM = true;
    bf16_t* Gb; bf16_t* Ub;
    __device__ __forceinline__ void operator()(const f32x4 (&acc)[2][2][4][2], const Unit& u, int wr, int wc, int fr, int fq) const {
        const bool isg = u.pn < 4; bf16_t* base = isg ? Gb : Ub; const int colt = (isg ? u.pn : u.pn - 4) * BM + wc * 32 + 8 * fq;
#pragma unroll
        for (int ai = 0; ai < 2; ++ai)
#pragma unroll
            for (int m = 0; m < 4; ++m) { bf16_t* rowp = base + (size_t)(u.pm * BM + ai * HALF + wr * 64 + m * 16 + fr) * 1024 + colt;
#pragma unroll
                for (int bj = 0; bj < 2; ++bj) { f32x4 v0 = acc[ai][bj][m][0], v1 = acc[ai][bj][m][1];
                    if (isg) {
                        const f32x4 e0 = (v0 * v0 * (-2.302208198f * 0.044715f) + -2.302208198f) * v0, e1 = (v1 * v1 * (-2.302208198f * 0.044715f) + -2.302208198f) * v1;
                        const f32x4 d0 = (f32x4){__builtin_amdgcn_exp2f(e0[0]), __builtin_amdgcn_exp2f(e0[1]), __builtin_amdgcn_exp2f(e0[2]), __builtin_amdgcn_exp2f(e0[3])} + 1.0f;
                        const f32x4 d1 = (f32x4){__builtin_amdgcn_exp2f(e1[0]), __builtin_amdgcn_exp2f(e1[1]), __builtin_amdgcn_exp2f(e1[2]), __builtin_amdgcn_exp2f(e1[3])} + 1.0f;
                        v0 = v0 * (f32x4){__builtin_amdgcn_rcpf(d0[0]), __builtin_amdgcn_rcpf(d0[1]), __builtin_amdgcn_rcpf(d0[2]), __builtin_amdgcn_rcpf(d0[3])};
                        v1 = v1 * (f32x4){__builtin_amdgcn_rcpf(d1[0]), __builtin_amdgcn_rcpf(d1[1]), __builtin_amdgcn_rcpf(d1[2]), __builtin_amdgcn_rcpf(d1[3])}; }
                    u32x4 w; w.x = cvt_pk_bf16(v0[0], v0[1]); w.y = cvt_pk_bf16(v0[2], v0[3]); w.z = cvt_pk_bf16(v1[0], v1[1]); w.w = cvt_pk_bf16(v1[2], v1[3]);
                    *(u32x4*)(rowp + bj * HALF) = w; } }
    }
};
struct EpiGates {
    static constexpr bool PERM = true;
    const bf16_t* UC; unsigned char* LB[2]; const float* ga_b; const float* gx_b; const float* lam;
    __device__ __forceinline__ void operator()(const f32x4 (&acc)[2][2][4][2], const Unit& u, int wr, int wc, int fr, int fq) const {
        const int d = u.pn & 1, c0 = (u.pn >> 1) * 128 + wc * 32 + 8 * fq;
        typedef float f32x2 __attribute__((ext_vector_type(2)));
        f32x2 ba[4], bx[4], sp2[4];
#pragma unroll
        for (int j = 0; j < 8; ++j) { ba[j >> 1][j & 1] = -1.4426950408889634f * ga_b[d * 1024 + c0 + j]; bx[j >> 1][j & 1] = -1.4426950408889634f * gx_b[d * 1024 + c0 + j]; const float l = lam[d * 1024 + c0 + j];
            const float ex = __expf(-l); const float spv = (ex < 0.05f) ? ex * (1.0f - ex * (0.5f - ex * (0.33333334f - 0.25f * ex))) : __logf(1.0f + ex); const float sp = -8.0f * 1.4426950408889634f * spv;
            sp2[j >> 1][j & 1] = 2.0f * sp; }
        unsigned char* lb = d ? LB[1] : LB[0];
#pragma unroll
        for (int ai = 0; ai < 2; ++ai) {
            u32x4 uva[4];
#pragma unroll
            for (int m = 0; m < 4; ++m) uva[m] = *(const u32x4*)(UC + (size_t)(u.pm * BM + ai * HALF + wr * 64 + m * 16 + fr) * 1024 + c0);
            __builtin_amdgcn_sched_barrier(0);
#pragma unroll
            for (int m = 0; m < 4; ++m) { const size_t off = (size_t)(u.pm * BM + ai * HALF + wr * 64 + m * 16 + fr) * 1024 + c0;
                const u32x4 uv = uva[m];
                const f32x2 uu[4] = {{__builtin_bit_cast(float, uv.x << 16), __builtin_bit_cast(float, uv.x & 0xffff0000u)}, {__builtin_bit_cast(float, uv.y << 16), __builtin_bit_cast(float, uv.y & 0xffff0000u)},
                                     {__builtin_bit_cast(float, uv.z << 16), __builtin_bit_cast(float, uv.z & 0xffff0000u)}, {__builtin_bit_cast(float, uv.w << 16), __builtin_bit_cast(float, uv.w & 0xffff0000u)}};
                float l2[8], bt[8];
#pragma unroll
                for (int jp = 0; jp < 4; ++jp) { const f32x2 aa = {acc[ai][0][m][jp >> 1][2 * (jp & 1)], acc[ai][0][m][jp >> 1][2 * (jp & 1) + 1]}, ax = {acc[ai][1][m][jp >> 1][2 * (jp & 1)], acc[ai][1][m][jp >> 1][2 * (jp & 1) + 1]};
                    const f32x2 za = aa + ba[jp], zx = ax + bx[jp];
                    const f32x2 da = (f32x2){__builtin_amdgcn_exp2f(za.x), __builtin_amdgcn_exp2f(za.y)} + 1.0f, q = (f32x2){__builtin_amdgcn_exp2f(zx.x), __builtin_amdgcn_exp2f(zx.y)} + 1.0f;
                    const f32x2 r = {__builtin_amdgcn_rcpf(da.x), __builtin_amdgcn_rcpf(da.y)};
                    const f32x2 t2 = sp2[jp] * r, lq = t2 * (0.5f * LA8_SCALE);
                    const f32x2 a2 = {__builtin_amdgcn_exp2f(t2.x), __builtin_amdgcn_exp2f(t2.y)};
                    f32x2 w = a2 * -(BB8_SCALE * BB8_SCALE) + (BB8_SCALE * BB8_SCALE); w.x = fmaxf(w.x, 1e-30f); w.y = fmaxf(w.y, 1e-30f);
                    const f32x2 ag = w * (q * q); const f32x2 bv = (w * (f32x2){__builtin_amdgcn_rsqf(ag.x), __builtin_amdgcn_rsqf(ag.y)}) * uu[jp];
                    l2[2 * jp] = lq.x; l2[2 * jp + 1] = lq.y; bt[2 * jp] = __builtin_amdgcn_fmed3f(bv.x, -440.f, 440.f); bt[2 * jp + 1] = __builtin_amdgcn_fmed3f(bv.y, -440.f, 440.f); }
                u32x4 w; w.x = pk4_fp8(l2[0], bt[0], l2[1], bt[1]); w.y = pk4_fp8(l2[2], bt[2], l2[3], bt[3]); w.z = pk4_fp8(l2[4], bt[4], l2[5], bt[5]); w.w = pk4_fp8(l2[6], bt[6], l2[7], bt[7]);
                *(u32x4*)(lb + 2 * off) = w; } }
    }
};
struct EpiGatesL {
    static constexpr bool PERM = true;
    const PG8_LAS unsigned char* abase; unsigned char* LB[2]; const float* ga_b; const float* gx_b; const float* lam;
    typedef float f32x2 __attribute__((ext_vector_type(2)));
    struct Pre { f32x2 ba[4], bx[4], sp2[4]; };
    struct Raw { f32x4 ga[2], gx[2], lm[2]; };
    __device__ __forceinline__ void prelude_load(const Unit& u, int wc, int fq, Raw& raw) const {
        const int d = u.pn & 1, c0 = (u.pn >> 1) * 128 + wc * 32 + 8 * fq;
#pragma unroll
        for (int h = 0; h < 2; ++h) { raw.ga[h] = *(const f32x4*)(ga_b + d * 1024 + c0 + 4 * h); raw.gx[h] = *(const f32x4*)(gx_b + d * 1024 + c0 + 4 * h); raw.lm[h] = *(const f32x4*)(lam + d * 1024 + c0 + 4 * h); }
    }
    __device__ __forceinline__ void prelude_math(const Raw& raw, Pre& pre) const {
#pragma unroll
        for (int j = 0; j < 8; ++j) { pre.ba[j >> 1][j & 1] = -1.4426950408889634f * raw.ga[j >> 2][j & 3]; pre.bx[j >> 1][j & 1] = -1.4426950408889634f * raw.gx[j >> 2][j & 3]; const float l = raw.lm[j >> 2][j & 3];
            const float ex = __expf(-l); const float spv = (ex < 0.05f) ? ex * (1.0f - ex * (0.5f - ex * (0.33333334f - 0.25f * ex))) : __logf(1.0f + ex); const float sp = -8.0f * 1.4426950408889634f * spv;
            pre.sp2[j >> 1][j & 1] = 2.0f * sp; }
    }
    __device__ __forceinline__ void half(const f32x4 (&acc)[2][2][4][2], const Unit& u, const Pre& pre, const int ai, int wr, int wc, int fr, int fq) const {
        const int d = u.pn & 1, c0 = (u.pn >> 1) * 128 + wc * 32 + 8 * fq;
        const f32x2 (&ba)[4] = pre.ba; const f32x2 (&bx)[4] = pre.bx; const f32x2 (&sp2)[4] = pre.sp2;
        unsigned char* lb = d ? LB[1] : LB[0];
        {
            u32x4 uva[4];
#pragma unroll
            for (int m = 0; m < 4; ++m) uva[m] = *(const PG8_LAS u32x4*)(abase + (wc >> 1) * 2 * HTB + lds_byte(wr * 64 + fr, (wc & 1) * 32 + 8 * fq) + ai * HTB + m * 2048);
            __builtin_amdgcn_sched_barrier(0);
#pragma unroll
            for (int m = 0; m < 4; ++m) { const size_t off = (size_t)(u.pm * BM + ai * HALF + wr * 64 + m * 16 + fr) * 1024 + c0;
                const u32x4 uv = uva[m];
                const f32x2 uu[4] = {{__builtin_bit_cast(float, uv.x << 16), __builtin_bit_cast(float, uv.x & 0xffff0000u)}, {__builtin_bit_cast(float, uv.y << 16), __builtin_bit_cast(float, uv.y & 0xffff0000u)},
                                     {__builtin_bit_cast(float, uv.z << 16), __builtin_bit_cast(float, uv.z & 0xffff0000u)}, {__builtin_bit_cast(float, uv.w << 16), __builtin_bit_cast(float, uv.w & 0xffff0000u)}};
                float l2[8], bt[8];
#pragma unroll
                for (int jp = 0; jp < 4; ++jp) { const f32x2 aa = {acc[ai][0][m][jp >> 1][2 * (jp & 1)], acc[ai][0][m][jp >> 1][2 * (jp & 1) + 1]}, ax = {acc[ai][1][m][jp >> 1][2 * (jp & 1)], acc[ai][1][m][jp >> 1][2 * (jp & 1) + 1]};
                    const f32x2 za = aa + ba[jp], zx = ax + bx[jp];
                    const f32x2 da = (f32x2){__builtin_amdgcn_exp2f(za.x), __builtin_amdgcn_exp2f(za.y)} + 1.0f, q = (f32x2){__builtin_amdgcn_exp2f(zx.x), __builtin_amdgcn_exp2f(zx.y)} + 1.0f;
                    const f32x2 r = {__builtin_amdgcn_rcpf(da.x), __builtin_amdgcn_rcpf(da.y)};
                    const f32x2 t2 = sp2[jp] * r, lq = t2 * (0.5f * LA8_SCALE);
                    const f32x2 a2 = {__builtin_amdgcn_exp2f(t2.x), __builtin_amdgcn_exp2f(t2.y)};
                    f32x2 w = a2 * -(BB8_SCALE * BB8_SCALE) + (BB8_SCALE * BB8_SCALE); w.x = fmaxf(w.x, 1e-30f); w.y = fmaxf(w.y, 1e-30f);
                    const f32x2 ag = w * (q * q); const f32x2 bv = (w * (f32x2){__builtin_amdgcn_rsqf(ag.x), __builtin_amdgcn_rsqf(ag.y)}) * uu[jp];
                    l2[2 * jp] = lq.x; l2[2 * jp + 1] = lq.y; bt[2 * jp] = __builtin_amdgcn_fmed3f(bv.x, -440.f, 440.f); bt[2 * jp + 1] = __builtin_amdgcn_fmed3f(bv.y, -440.f, 440.f); }
                u32x4 w; w.x = pk4_fp8(l2[0], bt[0], l2[1], bt[1]); w.y = pk4_fp8(l2[2], bt[2], l2[3], bt[3]); w.z = pk4_fp8(l2[4], bt[4], l2[5], bt[5]); w.w = pk4_fp8(l2[6], bt[6], l2[7], bt[7]);
                *(u32x4*)(lb + 2 * off) = w; }
        }
    }
};

struct GatesFused { const bf16_t* U; const bf16_t* Wg; const float* cw; const float* cbv; unsigned char* LB[2]; const float* ga_b; const float* gx_b; const float* lam; };
__device__ __forceinline__ void gates_fused_phase(PG8_LAS unsigned char* lds, const GatesFused P, const int G, const int c, const int tid) {
    const int wid = __builtin_amdgcn_readfirstlane(tid >> 6), lane = tid & 63, wr = wid >> 2, wc = wid & 3, fr = lane & 15, fq = lane >> 4;
    unsigned voffB[2];
#pragma unroll
    for (int i = 0; i < 2; ++i) { int R, C; stage_rc(tid * 16 + i * 8192, R, C); const int Rb = (R & ~31) + perm32(R & 31); voffB[i] = (unsigned)(Rb * 256 + C * 2); }
    const unsigned ldsw = (unsigned)wid * 1024u;
    const int aoff = lds_byte(wr * 64 + fr, fq * 8), boff = lds_byte(wc * 32 + fr, fq * 8);
#define GF_SA(b, h) (((b) * 2 + (h)) * HTB)
#define GF_SB(b, h) ((4 + (b) * 2 + (h)) * HTB)
#define GF_STAGEB(un_) do { _Pragma("unroll") for (int b_ = 0; b_ < 2; ++b_) _Pragma("unroll") for (int h_ = 0; h_ < 2; ++h_) { \
        const char* gb_ = (const char*)P.Wg + ((size_t)((un_) * 256 + h_ * HALF) * 128 + b_ * 64) * 2; \
        _Pragma("unroll") for (int i_ = 0; i_ < 2; ++i_) __builtin_amdgcn_global_load_lds((const unsigned*)(gb_ + voffB[i_]), (PG8_LAS unsigned*)(lds + GF_SB(b_, h_) + ldsw + i_ * 8192), 16, 0, 0); } } while (0)
#define GF_MMA_ALL() do { _Pragma("unroll") for (int a_ = 0; a_ < 2; ++a_) _Pragma("unroll") for (int b_ = 0; b_ < 2; ++b_) _Pragma("unroll") for (int m_ = 0; m_ < 4; ++m_) _Pragma("unroll") for (int n_ = 0; n_ < 2; ++n_) acc[a_][b_][m_][n_] = (f32x4){0.f, 0.f, 0.f, 0.f}; \
        _Pragma("unroll") for (int kb_ = 0; kb_ < 2; ++kb_) { Frag2 B0[2], B1[2]; \
            _Pragma("unroll") for (int n_ = 0; n_ < 2; ++n_) _Pragma("unroll") for (int k_ = 0; k_ < 2; ++k_) { B0[n_][k_] = *(const PG8_LAS bf16x8*)(lds + GF_SB(kb_, 0) + boff + n_ * 2048 + k_ * 1024); B1[n_][k_] = *(const PG8_LAS bf16x8*)(lds + GF_SB(kb_, 1) + boff + n_ * 2048 + k_ * 1024); } \
            _Pragma("unroll") for (int a_ = 0; a_ < 2; ++a_) { Frag2 At[4]; \
                _Pragma("unroll") for (int m_ = 0; m_ < 4; ++m_) _Pragma("unroll") for (int k_ = 0; k_ < 2; ++k_) At[m_][k_] = *(const PG8_LAS bf16x8*)(lds + GF_SA(kb_, a_) + aoff + m_ * 2048 + k_ * 1024); \
                _Pragma("unroll") for (int m_ = 0; m_ < 4; ++m_) _Pragma("unroll") for (int n_ = 0; n_ < 2; ++n_) _Pragma("unroll") for (int k_ = 0; k_ < 2; ++k_) { \
                    acc[a_][0][m_][n_] = __builtin_amdgcn_mfma_f32_16x16x32_bf16(B0[n_][k_], At[m_][k_], acc[a_][0][m_][n_], 0, 0, 0); \
                    acc[a_][1][m_][n_] = __builtin_amdgcn_mfma_f32_16x16x32_bf16(B1[n_][k_], At[m_][k_], acc[a_][1][m_][n_], 0, 0, 0); } } } } while (0)
    const int npairs = (MT / 256) * 8;
    const int nfullp = (npairs / G) * G, rem = npairs - nfullp; const bool split = rem > 0 && 2 * rem <= G;
    const int nhs0 = 2 * (split ? nfullp / G : (c < npairs ? (npairs - c + G - 1) / G : 0)), nhs = nhs0 + ((split && c < 2 * rem) ? 1 : 0);
    if (nhs == 0) return;
#define GF_HS(hs_, L_, d_) do { if ((hs_) < nhs0) { L_ = c + ((hs_) >> 1) * G; d_ = (hs_) & 1; } else { L_ = nfullp + c % rem; d_ = c / rem; } } while (0)
    { int L0, d0; GF_HS(0, L0, d0); GF_STAGEB((L0 & 7) * 2 + d0); }
    const EpiGatesL E{lds, {P.LB[0], P.LB[1]}, P.ga_b, P.gx_b, P.lam};
    const int cg = tid & 15, run = tid >> 4;
    f32x4 acc[2][2][4][2];
    u32x4 win[11];
#pragma unroll
    for (int i = 0; i < 11; ++i) win[i] = (u32x4){0u, 0u, 0u, 0u};
#pragma nounroll
    for (int hs = 0; hs < nhs; ++hs) {
        int L, d; GF_HS(hs, L, d); const bool tail = hs >= nhs0; const int pm = L >> 3, cb = L & 7;
        if (d == 0 || tail) {
          const int c0 = cb * 128 + cg * 8, row0 = pm * 256 + run * 8;
          const int t0 = row0 < ML ? (row0 & 4095) : ((row0 - ML) & 255), T = row0 < ML ? 4096 : 256;
          if (hs == 0) {
#pragma unroll
            for (int i = 0; i < 11; ++i) { const int tt = t0 + i - 2; win[i] = (u32x4){0u, 0u, 0u, 0u};
                if (tt >= 0 && tt < T) win[i] = __builtin_nontemporal_load((const u32x4*)(P.U + (size_t)(row0 + i - 2) * 1024 + c0)); } }
          typedef float f32x2 __attribute__((ext_vector_type(2)));
          f32x2 w[4][4], cbb[4];
#pragma unroll
          for (int j = 0; j < 8; ++j) { cbb[j >> 1][j & 1] = P.cbv[c0 + j];
#pragma unroll
              for (int k = 0; k < 4; ++k) w[k][j >> 1][j & 1] = P.cw[k * 1024 + c0 + j]; }
#pragma unroll
          for (int i = 0; i < 8; ++i) { f32x2 a[4];
#pragma unroll
              for (int j = 0; j < 4; ++j) a[j] = cbb[j];
#pragma unroll
              for (int k = 0; k < 4; ++k) { const u32x4 uv = win[i + k];
                  a[0] += w[k][0] * (f32x2){bflo(uv.x), bfhi(uv.x)}; a[1] += w[k][1] * (f32x2){bflo(uv.y), bfhi(uv.y)};
                  a[2] += w[k][2] * (f32x2){bflo(uv.z), bfhi(uv.z)}; a[3] += w[k][3] * (f32x2){bflo(uv.w), bfhi(uv.w)}; }
              const u32x4 o = {pk2(a[0].x, a[0].y), pk2(a[1].x, a[1].y), pk2(a[2].x, a[2].y), pk2(a[3].x, a[3].y)};
              *(PG8_LAS u32x4*)(lds + GF_SA(cg >> 3, run >> 4) + lds_byte((run * 8) & 127, (cg & 7) * 8) + i * 64) = o; }
        }
#pragma unroll
        for (int i = 0; i < 11; ++i) win[i] = (u32x4){0u, 0u, 0u, 0u};
        asm volatile("s_waitcnt vmcnt(0) lgkmcnt(0)\n\ts_barrier" ::: "memory");
        Unit u; u.pm = pm; u.pn = cb * 2 + d; u.arow = pm * BM; u.acol = cb * 128; u.brow = u.pn * BM; u.x0 = 0; u.x1 = 0; u.x2 = 0; u.ord = 0; u.brow2 = 0; u.ksplit = 0;
        EpiGatesL::Raw raw; E.prelude_load(u, wc, fq, raw);
        GF_MMA_ALL();
        asm volatile("s_waitcnt lgkmcnt(0)\n\ts_barrier" ::: "memory");
        if (hs + 1 < nhs) { int Ln, dn; GF_HS(hs + 1, Ln, dn); GF_STAGEB((Ln & 7) * 2 + dn); }
        EpiGatesL::Pre pre; E.prelude_math(raw, pre);
        E.half(acc, u, pre, 0, wr, wc, fr, fq);
        if ((d == 1 || tail) && hs + 1 < nhs) {
            int Ln, dn; GF_HS(hs + 1, Ln, dn); const int rown = (Ln >> 3) * 256 + run * 8, cn = (Ln & 7) * 128 + cg * 8;
            const int tn0 = rown < ML ? (rown & 4095) : ((rown - ML) & 255), Tn = rown < ML ? 4096 : 256;
#pragma unroll
            for (int i = 0; i < 11; ++i) { const int tt = tn0 + i - 2; win[i] = (u32x4){0u, 0u, 0u, 0u};
                if (tt >= 0 && tt < Tn) win[i] = __builtin_nontemporal_load((const u32x4*)(P.U + (size_t)(rown + i - 2) * 1024 + cn)); } }
        E.half(acc, u, pre, 1, wr, wc, fr, fq);
        if (d == 1 || tail) asm volatile("s_waitcnt lgkmcnt(0)\n\ts_barrier" ::: "memory");
    }
    asm volatile("s_waitcnt vmcnt(0)" ::: "memory");
#undef GF_SA
#undef GF_SB
#undef GF_STAGEB
#undef GF_MMA_ALL
#undef GF_HS
}
template <bool BASE_BF16>
struct EpiResid {
    static constexpr bool PERM = true;
    const float* baseL; const float* baseC; bf16_t* XB; const float* gate; float ascale;
    __device__ __forceinline__ void operator()(const f32x4 (&acc)[2][2][4][2], const Unit& u, int wr, int wc, int fr, int fq) const {
        const int row0 = u.pm * BM; const bool isl = row0 < ML;
        const float* bs = isl ? baseL + (size_t)row0 * 1024 : baseC + (size_t)(row0 - ML) * 1024; bf16_t* os = XB + (size_t)row0 * 1024;
        const float* gv = gate + (isl ? (row0 >> 12) : 8) * 6144; const int col0 = u.pn * BM + wc * 32 + 8 * fq;
        f32x4 gg[2][2];
#pragma unroll
        for (int bj = 0; bj < 2; ++bj)
#pragma unroll
            for (int n = 0; n < 2; ++n) gg[bj][n] = *(const f32x4*)(gv + col0 + bj * HALF + n * 4) * ascale;
        constexpr int MB = BASE_BF16 ? 4 : 2;
#pragma unroll
        for (int ai = 0; ai < 2; ++ai)
#pragma unroll
            for (int m0 = 0; m0 < 4; m0 += MB) {
                u32x4 wb[MB][2]; f32x4 fb[MB][2][2];
#pragma unroll
                for (int mi = 0; mi < MB; ++mi) { const size_t off = (size_t)(ai * HALF + wr * 64 + (m0 + mi) * 16 + fr) * 1024 + col0;
#pragma unroll
                    for (int bj = 0; bj < 2; ++bj) {
                        if (BASE_BF16) wb[mi][bj] = *(const u32x4*)(os + off + bj * HALF);
                        else { fb[mi][bj][0] = *(const f32x4*)(bs + off + bj * HALF); fb[mi][bj][1] = *(const f32x4*)(bs + off + bj * HALF + 4); } } }
                __builtin_amdgcn_sched_barrier(0);
#pragma unroll
                for (int mi = 0; mi < MB; ++mi) { const int m = m0 + mi; const size_t off = (size_t)(ai * HALF + wr * 64 + m * 16 + fr) * 1024 + col0;
#pragma unroll
                    for (int bj = 0; bj < 2; ++bj) { f32x4 b0, b1;
                        if (BASE_BF16) { const u32x4 w = wb[mi][bj];
                            b0 = (f32x4){__builtin_bit_cast(float, w.x << 16), __builtin_bit_cast(float, w.x & 0xffff0000u), __builtin_bit_cast(float, w.y << 16), __builtin_bit_cast(float, w.y & 0xffff0000u)};
                            b1 = (f32x4){__builtin_bit_cast(float, w.z << 16), __builtin_bit_cast(float, w.z & 0xffff0000u), __builtin_bit_cast(float, w.w << 16), __builtin_bit_cast(float, w.w & 0xffff0000u)}; }
                        else { b0 = fb[mi][bj][0]; b1 = fb[mi][bj][1]; }
                        const f32x4 v0 = b0 + gg[bj][0] * acc[ai][bj][m][0], v1 = b1 + gg[bj][1] * acc[ai][bj][m][1];
                        u32x4 o; o.x = cvt_pk_bf16(v0[0], v0[1]); o.y = cvt_pk_bf16(v0[2], v0[3]); o.z = cvt_pk_bf16(v1[0], v1[1]); o.w = cvt_pk_bf16(v1[2], v1[3]);
                        *(u32x4*)(os + off + bj * HALF) = o; } }
                __builtin_amdgcn_sched_barrier(0); }
    }
};
struct EpiNull { static constexpr bool PERM = true;
    __device__ __forceinline__ void operator()(const f32x4 (&acc)[2][2][4][2], const Unit& u, int wr, int wc, int fr, int fq) const { } };
template <bool WT = false>
struct EpiMoe1 {
    static constexpr bool PERM = true;
    unsigned char* ACT; const PG8_LAS float* tabw;
    __device__ __forceinline__ void operator()(const f32x4 (&acc)[2][2][4][2], const Unit& u, int wr, int wc, int fr, int fq) const {
        const int colt = u.pn * 128 + wc * 32 + 8 * fq;
#pragma unroll
        for (int ai = 0; ai < 2; ++ai)
#pragma unroll
            for (int m = 0; m < 4; ++m) { const int rl = ai * HALF + wr * 64 + m * 16 + fr; unsigned char* rowp = ACT + (size_t)(u.pm * BM + rl) * 1024 + colt; float o[8];
                typedef float f32x2 __attribute__((ext_vector_type(2)));
                const float gw = tabw[u.ord * 256 + rl] * (ACT8_SCALE / (W8_SCALE * W8_SCALE));
#pragma unroll
                for (int jp = 0; jp < 4; ++jp) { const f32x2 a1 = {acc[ai][0][m][jp >> 1][2 * (jp & 1)], acc[ai][0][m][jp >> 1][2 * (jp & 1) + 1]}, a3 = {acc[ai][1][m][jp >> 1][2 * (jp & 1)], acc[ai][1][m][jp >> 1][2 * (jp & 1) + 1]};
                    const f32x2 x = a1 * (-1.4426950408889634f / W8_SCALE); const f32x2 d = (f32x2){__builtin_amdgcn_exp2f(x.x), __builtin_amdgcn_exp2f(x.y)} + 1.0f;
                    const f32x2 sg = (f32x2){__builtin_amdgcn_rcpf(d.x), __builtin_amdgcn_rcpf(d.y)} * gw; const f32x2 v = (a1 * a3) * sg;
                    o[2 * jp] = __builtin_amdgcn_fmed3f(v.x, -440.f, 440.f); o[2 * jp + 1] = __builtin_amdgcn_fmed3f(v.y, -440.f, 440.f); }
                typedef unsigned u32x2 __attribute__((ext_vector_type(2)));
                u32x2 w; w.x = pk4_fp8(o[0], o[1], o[2], o[3]); w.y = pk4_fp8(o[4], o[5], o[6], o[7]);
                if (WT) __hip_atomic_store((__attribute__((address_space(1))) unsigned long long*)rowp, ((unsigned long long)w.y << 32) | (unsigned long long)w.x, __ATOMIC_RELAXED, __HIP_MEMORY_SCOPE_AGENT);
                else *(u32x2*)rowp = w; }
    }
};
template <bool FINAL>
struct EpiMoe2 {
    static constexpr bool PERM = true;
    bf16_t* XB; float* out; const float* gfm; const PG8_LAS int* tab;
    __device__ __forceinline__ void operator()(const f32x4 (&acc)[2][2][4][2], const Unit& u, int wr, int wc, int fr, int fq) const {
        const int col0 = u.pn * BM + wc * 32 + 8 * fq; constexpr float sc = 1.0f / (W8_SCALE * ACT8_SCALE);
#pragma unroll
        for (int ai = 0; ai < 2; ++ai)
#pragma unroll
            for (int m0 = 0; m0 < 4; m0 += 2) {
                int tk[2]; u32x4 xw[2][2]; f32x4 gq[2][2][2];
#pragma unroll
                for (int mi = 0; mi < 2; ++mi) { const int t_ = tab[u.ord * 256 + ai * HALF + wr * 64 + (m0 + mi) * 16 + fr]; tk[mi] = t_; const int tok = t_ < 0 ? 0 : t_;
                    const float* gv = gfm + (tok < ML ? (tok >> 12) : 8) * 6144 + col0; const bf16_t* xp = XB + (size_t)tok * 1024 + col0;
#pragma unroll
                    for (int bj = 0; bj < 2; ++bj) { xw[mi][bj] = *(const u32x4*)(xp + bj * HALF); gq[mi][bj][0] = *(const f32x4*)(gv + bj * HALF); gq[mi][bj][1] = *(const f32x4*)(gv + bj * HALF + 4); } }
                __builtin_amdgcn_sched_barrier(0);
#pragma unroll
                for (int mi = 0; mi < 2; ++mi) { const int m = m0 + mi, tok = tk[mi];
                    if (tok >= 0) { bf16_t* xp = XB + (size_t)tok * 1024 + col0;
#pragma unroll
                        for (int bj = 0; bj < 2; ++bj) { const f32x4 g0 = gq[mi][bj][0] * sc, g1 = gq[mi][bj][1] * sc; const u32x4 w = xw[mi][bj];
                            const f32x4 b0 = {__builtin_bit_cast(float, w.x << 16), __builtin_bit_cast(float, w.x & 0xffff0000u), __builtin_bit_cast(float, w.y << 16), __builtin_bit_cast(float, w.y & 0xffff0000u)};
                            const f32x4 b1 = {__builtin_bit_cast(float, w.z << 16), __builtin_bit_cast(float, w.z & 0xffff0000u), __builtin_bit_cast(float, w.w << 16), __builtin_bit_cast(float, w.w & 0xffff0000u)};
                            const f32x4 v0 = b0 + g0 * acc[ai][bj][m][0], v1 = b1 + g1 * acc[ai][bj][m][1];
                            if (FINAL) { float* op = out + (size_t)tok * 1024 + col0 + bj * HALF; __builtin_nontemporal_store(v0, (f32x4*)op); __builtin_nontemporal_store(v1, (f32x4*)(op + 4)); }
                            else { u32x4 o; o.x = cvt_pk_bf16(v0[0], v0[1]); o.y = cvt_pk_bf16(v0[2], v0[3]); o.z = cvt_pk_bf16(v1[0], v1[1]); o.w = cvt_pk_bf16(v1[2], v1[3]); *(u32x4*)(xp + bj * HALF) = o; } } } }
                __builtin_amdgcn_sched_barrier(0); }
    }
};
struct EpiQKV {
    static constexpr bool PERM = true;
    unsigned char* Q; unsigned char* Kb; unsigned char* Vt; const float* qn; const float* kn; const PG8_LAS float* rope;
    __device__ __forceinline__ void operator()(const f32x4 (&acc)[2][2][4][2], const Unit& u, int wr, int wc, int fr, int fq) const {
        typedef unsigned u32x2 __attribute__((ext_vector_type(2)));
        const int row0 = u.pm * BM; const bool isl = row0 < ML;
        if (u.pn == 5) {
#pragma unroll
            for (int ai = 0; ai < 2; ++ai)
#pragma unroll
                for (int m = 0; m < 4; ++m) { const int row = row0 + ai * HALF + wr * 64 + m * 16 + fr;
                    const int b = isl ? (row >> 12) : ((row - ML) >> 8), key = isl ? CTXL + (row & 4095) : ((row - ML) & 255);
                    unsigned char* base = Vt + (size_t)b * 4 * 64 * KVL + (size_t)(key >> 6) * 64 + attn8::vpos(key & 63);
#pragma unroll
                    for (int bj = 0; bj < 2; ++bj)
#pragma unroll
                        for (int n = 0; n < 2; ++n)
#pragma unroll
                            for (int j = 0; j < 4; ++j) { const int col = bj * HALF + wc * 32 + 8 * fq + 4 * n + j; const float v = acc[ai][bj][m][n][j] * (attn8::VS / W8_SCALE);
                                base[(size_t)col * KVL] = (unsigned char)__builtin_amdgcn_cvt_pk_fp8_f32(v, v, 0, false); } }
            return;
        }
        const bool isq = u.pn < 4; const float* nw = isq ? qn : kn; const float sc = isq ? attn8::QS : attn8::KS;
        f32x4 w1[2], w2[2];
#pragma unroll
        for (int bj = 0; bj < 2; ++bj) { w1[bj] = *(const f32x4*)(nw + 32 * bj + 4 * fq); w2[bj] = *(const f32x4*)(nw + 32 * bj + 16 + 4 * fq); }
#pragma unroll
        for (int ai = 0; ai < 2; ++ai)
#pragma unroll
            for (int m = 0; m < 4; ++m) { const int row = row0 + ai * HALF + wr * 64 + m * 16 + fr;
                f32x4 a1[2], a2[2]; float ss = 0.f;
#pragma unroll
                for (int bj = 0; bj < 2; ++bj) { a1[bj] = acc[ai][bj][m][0] * (1.0f / W8_SCALE); a2[bj] = acc[ai][bj][m][1] * (1.0f / W8_SCALE);
                    ss += (a1[bj][0] * a1[bj][0] + a1[bj][1] * a1[bj][1]) + (a1[bj][2] * a1[bj][2] + a1[bj][3] * a1[bj][3]) + (a2[bj][0] * a2[bj][0] + a2[bj][1] * a2[bj][1]) + (a2[bj][2] * a2[bj][2] + a2[bj][3] * a2[bj][3]); }
                ss += __shfl_xor(ss, 16); ss += __shfl_xor(ss, 32);
                const float rstd = __builtin_amdgcn_rsqf(ss * (1.0f / 64.0f) + EPS) * sc;
                int dest;
                if (isl) { const int t = row & 4095; const int pos[2] = {t >> 6, t & 63};
#pragma unroll
                    for (int bj = 0; bj < 2; ++bj) { const f32x4 cs = *(const PG8_LAS f32x4*)(rope + pos[bj] * 16 + 4 * fq), sn = *(const PG8_LAS f32x4*)(rope + 1024 + pos[bj] * 16 + 4 * fq);
                        const f32x4 y1 = a1[bj] * w1[bj] * rstd, y2 = a2[bj] * w2[bj] * rstd;
                        a1[bj] = y1 * cs - y2 * sn; a2[bj] = y2 * cs + y1 * sn; }
                    dest = isq ? row : (row >> 12) * KVL + CTXL + t;
                } else {
#pragma unroll
                    for (int bj = 0; bj < 2; ++bj) { a1[bj] = a1[bj] * w1[bj] * rstd; a2[bj] = a2[bj] * w2[bj] * rstd; }
                    dest = ((row - ML) >> 8) * KVL + ((row - ML) & 255);
                }
                unsigned char* rowp = isq ? Q + (size_t)dest * 1024 + (u.pn * 4 + wc) * 64 + 8 * fq : Kb + (size_t)dest * 256 + wc * 64 + 8 * fq;
#pragma unroll
                for (int bj = 0; bj < 2; ++bj) { u32x2 w; w.x = pk4_fp8(a1[bj][0], a1[bj][1], a1[bj][2], a1[bj][3]); w.y = pk4_fp8(a2[bj][0], a2[bj][1], a2[bj][2], a2[bj][3]);
                    *(u32x2*)(rowp + bj * 32) = w; } }
    }
};
}
struct Frame {
    LAS unsigned char* lds;
    volatile LAS unsigned* MISC;
    gu32* ctl;
    int tid, lane, wave, vcu, G;
    unsigned char* ws; float* out;
    const float* in[26];
};
enum { I_X = 0, I_C, I_CTX, I_CCTX, I_ADAW, I_ADAB, I_NMIX, I_NFFN, I_LIN, I_LCW, I_LCB, I_GAW, I_GAB, I_GXW, I_GXB, I_LAM, I_LOUT, I_QKV, I_QN, I_KN, I_OW, I_RW, I_RB, I_W1, I_W3, I_W2 };

__device__ __forceinline__ float wave_sum(float v) {
#pragma unroll
    for (int o = 1; o < 64; o <<= 1) v += __shfl_xor(v, o);
    return v;
}
__device__ __forceinline__ int dl_perm(int s) { return 4 * (s >> 3) + (s & 3) + ((s & 4) ? 16 : 0); }

template <bool F8 = false>
__device__ __forceinline__ void tr_item(const float* src, int ldn, int k0, int scol0, void* dstv, int ldk, int drow0, bool rp, LAS float* scr, int lane, float sc = 1.0f) {
    float tv[32];
#pragma unroll
    for (int i = 0; i < 32; ++i) { const int kk = 2 * i + (lane >> 5); tv[i] = __builtin_nontemporal_load(src + (size_t)(k0 + kk) * ldn + scol0 + (lane & 31)); }
#pragma unroll
    for (int i = 0; i < 32; ++i) { const int kk = 2 * i + (lane >> 5); scr[kk * 33 + (lane & 31)] = tv[i]; }
    LDS_WAIT(); asm volatile("" ::: "memory");
    const int c = lane & 7;
#pragma unroll
    for (int j = 0; j < 4; ++j) { const int n = (lane >> 3) + 8 * j; const int sn = rp ? dl_perm(n) : n; const LAS float* s = scr + (8 * c) * 33 + sn;
        if constexpr (F8) { v2u o; o.x = pg8::pk4_fp8(32.0f * s[0 * 33], 32.0f * s[1 * 33], 32.0f * s[2 * 33], 32.0f * s[3 * 33]); o.y = pg8::pk4_fp8(32.0f * s[4 * 33], 32.0f * s[5 * 33], 32.0f * s[6 * 33], 32.0f * s[7 * 33]);
            *(GAS v2u*)((unsigned char*)dstv + (size_t)(drow0 + n) * ldk + k0 + 8 * c) = o; }
        else { bf16* dst = (bf16*)dstv; v4u o; o.x = pk2(sc * s[0 * 33], sc * s[1 * 33]); o.y = pk2(sc * s[2 * 33], sc * s[3 * 33]); o.z = pk2(sc * s[4 * 33], sc * s[5 * 33]); o.w = pk2(sc * s[6 * 33], sc * s[7 * 33]);
            *(GAS v4u*)(dst + (size_t)(drow0 + n) * ldk + k0 + 8 * c) = o; } }
    LDS_WAIT(); asm volatile("" ::: "memory");
}

constexpr int CV_IN = 1024, CV_G = 256, CV_OUT = 512, CV_13 = 8192, CV_2 = 4096, CV_QKV = 768, CV_O = 512;
constexpr int CV_A_END = CV_IN + CV_G + CV_OUT, CV_B_END = CV_A_END + CV_13 + CV_2, CV_END = CV_B_END + CV_QKV + CV_O + CV_13 + CV_2;
__device__ __forceinline__ void conv_items(Frame& F, int lo, int hi, int gwi, int nwg) {
    LAS float* scr = (LAS float*)(F.lds + RING_OFF + 59392 + F.wave * 8704);
    for (int it = lo + gwi; it < hi; it += nwg) {
        int r = it;
        if (r < CV_IN) { const int g = r >> 4, kb = r & 15; tr_item(F.in[I_LIN], 2048, kb * 64, g * 32, (bf16*)(F.ws + WS_W_IN), 1024, g * 32, false, scr, F.lane); continue; } r -= CV_IN;
        if (r < CV_G) { const int un = r >> 4, rem = r & 15, grp = rem >> 1, kb = rem & 1, n = un >> 1, d = un & 1;
            const float* src = (grp < 4 ? F.in[I_GAW] : F.in[I_GXW]) + (size_t)(d * 8 + n) * 16384;
            tr_item(src, 128, kb * 64, (grp & 3) * 32, (bf16*)(F.ws + WS_W_G), 128, un * 256 + grp * 32, false, scr, F.lane, -1.4426950408889634f); continue; } r -= CV_G;
        if (r < CV_OUT) { const int g = r >> 4, kb = r & 15; tr_item(F.in[I_LOUT], 1024, kb * 64, g * 32, (bf16*)(F.ws + WS_W_OUT), 1024, g * 32, false, scr, F.lane); continue; } r -= CV_OUT;
        int layer = 0;
        if (r >= CV_13 + CV_2) { r -= CV_13 + CV_2;
            if (r < CV_QKV) { const int g = r >> 4, kb = r & 15, pn = g >> 3, gi = g & 7; const bool rp = pn < 5;
                const int scol0 = rp ? pn * 256 + (gi & 3) * 64 + (gi >> 2) * 32 : 1280 + gi * 32;
                tr_item<true>(F.in[I_QKV], 1536, kb * 64, scol0, F.ws + WS_W_QKV, 1024, g * 32, rp, scr, F.lane); continue; } r -= CV_QKV;
            if (r < CV_O) { const int g = r >> 4, kb = r & 15; tr_item<true>(F.in[I_OW], 1024, kb * 64, g * 32, F.ws + WS_W_O, 1024, g * 32, false, scr, F.lane); continue; } r -= CV_O;
            layer = 1; }
        if (r < CV_13) { const int le = layer * 16 + (r >> 9), rem = r & 511, g = rem >> 4, kb = rem & 15, pn = g >> 3, gi = g & 7, bj = gi >> 2, sub = gi & 3;
            const float* src = (bj ? F.in[I_W3] : F.in[I_W1]) + (size_t)le * 1024 * 512;
            tr_item<true>(src, 512, kb * 64, pn * 128 + sub * 32, F.ws + WS_W13 + (size_t)le * 1024 * 1024, 1024, g * 32, false, scr, F.lane); continue; } r -= CV_13;
        { const int le = layer * 16 + (r >> 8), rem = r & 255, g = rem >> 3, kb = rem & 7;
            tr_item<true>(F.in[I_W2] + (size_t)le * 512 * 1024, 1024, kb * 64, g * 32, F.ws + WS_W2 + (size_t)le * 1024 * 512, 512, g * 32, false, scr, F.lane); }
    }
}
__device__ __forceinline__ void conv_tail(Frame& F, int b0, int lo, int hi, int me = -1) {
    if (me < 0) me = (int)blockIdx.x;
    if (b0 >= F.G) b0 = 0;
    if (me >= b0) conv_items(F, lo, hi, (me - b0) * NWAVES + F.wave, (F.G - b0) * NWAVES);
}
constexpr int CV_T10 = 3800, CV_T11 = 2200, CV_T13 = 5600, CV_T8C = 3000;

__device__ __forceinline__ void p0_prologue(Frame& F) {
    LAS float* scond = (LAS float*)(F.lds + RING_OFF);
    LAS float* red = (LAS float*)(F.lds + RING_OFF + 40960);
    float* mod = (float*)(F.ws + WS_MOD);
    bool did = false;
    for (int unit = blockIdx.x; unit < 192; unit += F.G) {
        if (!did) { for (int idx = F.tid; idx < 9 * 1024; idx += NWAVES * 64) { const int r = idx >> 10, k = idx & 1023; const float v = r < 8 ? F.in[I_C][r * 1024 + k] : F.in[I_CCTX][k]; scond[idx] = v * sigmoid_f(v); }
            __syncthreads(); did = true; }
        const int l = unit / 96, cg = unit % 96;
        const int ks = F.lane >> 4, cq = F.lane & 15;
        f32x4 acc[9];
#pragma unroll
        for (int r = 0; r < 9; ++r) acc[r] = (f32x4){0.f, 0.f, 0.f, 0.f};
        const float* wp = F.in[I_ADAW] + ((size_t)l * 1024 + F.wave * 128 + ks) * 6144 + cg * 64 + cq * 4;
#pragma unroll 1
        for (int k0 = 0; k0 < 32; k0 += 8) { f32x4 wv[8];
#pragma unroll
            for (int i = 0; i < 8; ++i) wv[i] = __builtin_nontemporal_load((const f32x4*)(wp + (size_t)(k0 + i) * 4 * 6144));
#pragma unroll
            for (int i = 0; i < 8; ++i) { const int k = F.wave * 128 + (k0 + i) * 4 + ks;
#pragma unroll
                for (int r = 0; r < 9; ++r) acc[r] += scond[r * 1024 + k] * wv[i]; } }
#pragma unroll
        for (int r = 0; r < 9; ++r) *(LAS f32x4*)(red + ((F.wave * 4 + ks) * 9 + r) * 64 + cq * 4) = acc[r];
        __syncthreads();
        for (int idx = F.tid; idx < 576; idx += NWAVES * 64) { const int r = idx >> 6, ln = idx & 63; float s = F.in[I_ADAB][l * 6144 + cg * 64 + ln];
#pragma unroll 8
            for (int w = 0; w < 32; ++w) s += red[(w * 9 + r) * 64 + ln];
            mod[(size_t)(l * 9 + r) * 6144 + cg * 64 + ln] = s; }
        __syncthreads();
    }
    __syncthreads();
    { const int rb0 = F.G >= 194 ? 192 : 0; const int gt = ((int)blockIdx.x - rb0) * (NWAVES * 64) + F.tid; if (gt >= 0 && gt < 1024) { const int pos = gt >> 4, i = gt & 15;
        double th = 1.0; for (int k = 0; k < i; ++k) th *= 0.56234132519034908;
        const double t2 = th * th; double sn = th, cs = 1.0, ts = th, tc = 1.0;
        for (int k = 1; k <= 12; ++k) { tc *= -t2 * (1.0 / (double)((2 * k - 1) * (2 * k))); cs += tc; ts *= -t2 * (1.0 / (double)((2 * k) * (2 * k + 1))); sn += ts; }
        double c = 1.0, s2 = 0.0; for (int k = 0; k < pos; ++k) { const double cn = c * cs - s2 * sn; s2 = s2 * cs + c * sn; c = cn; }
        float* rp = (float*)(F.ws + WS_ROPE); rp[gt] = (float)c; rp[1024 + gt] = (float)s2; } }
    conv_items(F, 0, CV_A_END, F.vcu * NWAVES + F.wave, F.G * NWAVES);
    conv_items(F, CV_B_END + CV_T10 + CV_T11 + CV_T13, CV_END, F.vcu * NWAVES + F.wave, F.G * NWAVES);
}

struct RowVec { f32x4 v[4]; };
__device__ __forceinline__ void load_modvec(Frame& F, int l, int mrow, int chunk_shift, const float* nw, RowVec& gsc, RowVec& sh) {
    const float* mod = (const float*)(F.ws + WS_MOD) + (size_t)(l * 9 + mrow) * 6144;
#pragma unroll
    for (int j = 0; j < 4; ++j) { const int col = 4 * F.lane + 256 * j; const f32x4 w = *(const f32x4*)(nw + col), sc = *(const f32x4*)(mod + (chunk_shift + 1) * 1024 + col);
        gsc.v[j] = w * (1.0f + sc); sh.v[j] = *(const f32x4*)(mod + chunk_shift * 1024 + col); }
}
__device__ __forceinline__ void store_bf16_row(bf16* dst, int lane, const RowVec& h) {
#pragma unroll
    for (int j = 0; j < 4; ++j) { v2u o; o.x = pk2(h.v[j][0], h.v[j][1]); o.y = pk2(h.v[j][2], h.v[j][3]); *(GAS v2u*)(dst + 4 * lane + 256 * j) = o; }
}
__device__ __forceinline__ void rms_mod(const RowVec& x, const RowVec& gsc, const RowVec& sh, RowVec& h) {
    float ss = 0.f;
#pragma unroll
    for (int j = 0; j < 4; ++j) ss += (x.v[j][0] * x.v[j][0] + x.v[j][1] * x.v[j][1]) + (x.v[j][2] * x.v[j][2] + x.v[j][3] * x.v[j][3]);
    ss = wave_sum(ss);
    const float rstd = __builtin_amdgcn_rsqf(ss * (1.0f / 1024.0f) + EPS);
#pragma unroll
    for (int j = 0; j < 4; ++j) h.v[j] = x.v[j] * rstd * gsc.v[j] + sh.v[j];
}

__device__ __forceinline__ void load_xrow(const float* xL, const float* xC, int row, int lane, RowVec& x) {
    const float* src = row < ML ? xL + (size_t)row * 1024 : xC + (size_t)(row - ML) * 1024;
#pragma unroll
    for (int j = 0; j < 4; ++j) x.v[j] = __builtin_nontemporal_load((const f32x4*)(src + 4 * lane + 256 * j));
}
__device__ __forceinline__ void load_xrow_bf(const bf16* XB, int row, int lane, RowVec& x) {
    const bf16* src = XB + (size_t)row * 1024;
#pragma unroll
    for (int j = 0; j < 4; ++j) { const v2u w = *(const GAS v2u*)(src + 4 * lane + 256 * j); x.v[j] = (f32x4){bflo(w.x), bfhi(w.x), bflo(w.y), bfhi(w.y)}; }
}
__device__ __forceinline__ void rows_modulate(Frame& F, const float* xL, const float* xC, int nrows, int l, int chunk_shift, const float* nw) {
    const int gwv = blockIdx.x * NWAVES + F.wave, NGW = F.G * NWAVES;
    const int r0 = (int)((long)gwv * nrows / NGW), r1 = (int)((long)(gwv + 1) * nrows / NGW);
    bf16* XN = (bf16*)(F.ws + WS_XN);
    int curb = -1; RowVec gsc, sh, xn;
    if (r0 < r1) load_xrow(xL, xC, r0, F.lane, xn);
    for (int row = r0; row < r1; ++row) {
        const int mrow = row < ML ? (row >> 12) : 8;
        if (mrow != curb) { load_modvec(F, l, mrow, chunk_shift, nw, gsc, sh); curb = mrow; }
        RowVec x = xn, h;
        if (row + 1 < r1) load_xrow(xL, xC, row + 1, F.lane, xn);
        rms_mod(x, gsc, sh, h);
        store_bf16_row(XN + (size_t)row * 1024, F.lane, h);
    }
}

__device__ __forceinline__ void rows_modulate_ho(Frame& F, const float* xL, const float* xC, int l, int chunk_shift, const float* nw, int nprod, bool fast, unsigned* hcnt) {
    const int w = blockIdx.x * NWAVES + F.wave, W = nprod * NWAVES;
    bf16* XN = (bf16*)(F.ws + WS_XN);
    int r, rstep, rend;
    if (fast) { const int g = w >> 8; r = pg8::in_gs(g) * 256 + (w & 255); rstep = 256; rend = pg8::in_gs(g + 1) * 256; } else { r = w; rstep = W; rend = MT; }
    int curb = -1, pp1 = -1, pp2 = -1; RowVec gsc, sh, xn;
    if (r < rend) load_xrow(xL, xC, r, F.lane, xn);
    for (; r < rend; r += rstep) {
        const int mrow = r < ML ? (r >> 12) : 8;
        if (mrow != curb) { load_modvec(F, l, mrow, chunk_shift, nw, gsc, sh); curb = mrow; }
        RowVec x = xn, h;
        if (r + rstep < rend) load_xrow(xL, xC, r + rstep, F.lane, xn);
        rms_mod(x, gsc, sh, h);
        asm volatile("" ::: "memory");
        if (pp2 >= 0 && F.lane == 0) pg8::ho_publish(hcnt, pp2);
        bf16* dst = XN + (size_t)r * 1024;
#pragma unroll
        for (int j = 0; j < 4; ++j) { const unsigned lo = pk2(h.v[j][0], h.v[j][1]), hi = pk2(h.v[j][2], h.v[j][3]);
            __hip_atomic_store((GAS unsigned long long*)(dst + 4 * F.lane + 256 * j), ((unsigned long long)hi << 32) | (unsigned long long)lo, __ATOMIC_RELAXED, __HIP_MEMORY_SCOPE_AGENT); }
        pp2 = pp1; pp1 = r >> 8;
    }
    asm volatile("s_waitcnt vmcnt(0)" ::: "memory");
    if (F.lane == 0) { if (pp2 >= 0) pg8::ho_publish(hcnt, pp2); if (pp1 >= 0) pg8::ho_publish(hcnt, pp1); }
}

__device__ __forceinline__ void route_topk(const float (&lg)[16], int& e0, int& e1, float& w0, float& w1);
__device__ __forceinline__ void route_row(const RowVec& h, const LAS float* rw, const float* rb, int lane, int& e0, int& e1, float& w0, float& w1) {
    f32x2 acc2[8];
#pragma unroll
    for (int e = 0; e < 8; ++e) acc2[e] = (f32x2){0.f, 0.f};
#pragma unroll
    for (int j = 0; j < 4; ++j)
#pragma unroll
        for (int i = 0; i < 4; ++i) { const int k = 4 * lane + 256 * j + i; const f32x2 hv2 = {h.v[j][i], h.v[j][i]}; const LAS f32x4* wr = (const LAS f32x4*)(rw + k * 16 + (k >> 2) * 4);
#pragma unroll
            for (int q = 0; q < 4; ++q) { const f32x4 w = wr[q]; acc2[2 * q] = acc2[2 * q] + hv2 * (f32x2){w[0], w[1]}; acc2[2 * q + 1] = acc2[2 * q + 1] + hv2 * (f32x2){w[2], w[3]}; } }
    float acc[16];
#pragma unroll
    for (int e = 0; e < 8; ++e) { acc[2 * e] = acc2[e][0]; acc[2 * e + 1] = acc2[e][1]; }
    float r8[8], r4[4], r2[2], r1v;
    { const bool hi = (lane & 32) != 0;
#pragma unroll
      for (int i = 0; i < 8; ++i) { const float send = hi ? acc[i] : acc[8 + i], keep = hi ? acc[8 + i] : acc[i]; r8[i] = keep + __shfl_xor(send, 32); } }
    { const bool hi = (lane & 16) != 0;
#pragma unroll
      for (int i = 0; i < 4; ++i) { const float send = hi ? r8[i] : r8[4 + i], keep = hi ? r8[4 + i] : r8[i]; r4[i] = keep + __shfl_xor(send, 16); } }
    { const bool hi = (lane & 8) != 0;
#pragma unroll
      for (int i = 0; i < 2; ++i) { const float send = hi ? r4[i] : r4[2 + i], keep = hi ? r4[2 + i] : r4[i]; r2[i] = keep + __shfl_xor(send, 8); } }
    { const bool hi = (lane & 4) != 0; const float send = hi ? r2[0] : r2[1], keep = hi ? r2[1] : r2[0]; r1v = keep + __shfl_xor(send, 4); }
    r1v += __shfl_xor(r1v, 2); r1v += __shfl_xor(r1v, 1);
    float lg[16];
#pragma unroll
    for (int e = 0; e < 16; ++e) lg[e] = __builtin_bit_cast(float, __builtin_amdgcn_readlane(__builtin_bit_cast(int, r1v), 4 * e)) + rb[e];
    route_topk(lg, e0, e1, w0, w1);
}
__device__ __forceinline__ void route_topk(const float (&lg)[16], int& e0, int& e1, float& w0, float& w1) {
    float mx = lg[0];
#pragma unroll
    for (int e = 1; e < 16; ++e) mx = fmaxf(mx, lg[e]);
    float p[16];
#pragma unroll
    for (int e = 0; e < 16; ++e) p[e] = __expf(lg[e] - mx);
    float gs[4];
#pragma unroll
    for (int g = 0; g < 4; ++g) { const float a = fmaxf(p[4 * g], p[4 * g + 1]), b = fminf(p[4 * g], p[4 * g + 1]), c = fmaxf(p[4 * g + 2], p[4 * g + 3]), d = fminf(p[4 * g + 2], p[4 * g + 3]);
        gs[g] = fmaxf(a, c) + fmaxf(fminf(a, c), fmaxf(b, d)); }
    int sel = 0; float best = gs[0];
#pragma unroll
    for (int g = 1; g < 4; ++g) if (gs[g] > best) { best = gs[g]; sel = g; }
    float q[4];
#pragma unroll
    for (int i = 0; i < 4; ++i) q[i] = sel == 0 ? p[i] : sel == 1 ? p[4 + i] : sel == 2 ? p[8 + i] : p[12 + i];
    int i1 = 0; float m1 = q[0];
#pragma unroll
    for (int i = 1; i < 4; ++i) if (q[i] > m1) { m1 = q[i]; i1 = i; }
    int i2 = -1; float m2 = -1.f;
#pragma unroll
    for (int i = 0; i < 4; ++i) if (i != i1 && q[i] > m2) { m2 = q[i]; i2 = i; }
    const float inv = __builtin_amdgcn_rcpf(m1 + m2);
    e0 = sel * 4 + i1; e1 = sel * 4 + i2; w0 = m1 * inv; w1 = m2 * inv;
}

__device__ __forceinline__ void split_bf16x2(float a, float b, unsigned& hi, unsigned& lo) {
    const unsigned ba = __builtin_bit_cast(unsigned, a), bb = __builtin_bit_cast(unsigned, b);
    hi = (ba >> 16) | (bb & 0xffff0000u);
    const float ra = a - __builtin_bit_cast(float, ba & 0xffff0000u), rb_ = b - __builtin_bit_cast(float, bb & 0xffff0000u);
    lo = (__builtin_bit_cast(unsigned, ra) >> 16) | (__builtin_bit_cast(unsigned, rb_) & 0xffff0000u);
}
__device__ __forceinline__ void rows_route(Frame& F, int nrows, int l) {
    const bf16* XB = (const bf16*)(F.ws + WS_XB);
    constexpr int HPB = 2056;
    LAS unsigned char* Wi = F.lds + RING_OFF;
    LAS unsigned char* Hi = F.lds + RING_OFF + 65536;
    LAS float* part = (LAS float*)(F.lds + TAB_OFF);
    LAS float* logit = (LAS float*)(F.lds + TAB_OFF + 8192);
    LAS unsigned char* pe = (LAS unsigned char*)(F.lds + TAB_OFF + 12800);
    LAS unsigned short* pr = (LAS unsigned short*)(F.lds + TAB_OFF + 13568);
    static_assert(TAB_OFF + 13568 + 1536 <= LDS_BYTES && 8192 + 64 * 17 * 4 <= 12800 && RING_OFF + 65536 + 2 * 16 * 2056 <= MISC_OFF, "router LDS map");
    const int NGW = F.G * NWAVES;
    const int b0 = (int)((long)(blockIdx.x * NWAVES) * nrows / NGW), b1 = (int)((long)(blockIdx.x * NWAVES + NWAVES) * nrows / NGW);
    unsigned char* XN8 = F.ws + WS_XN; v4u* route = (v4u*)(F.ws + WS_ROUTE);
    const float* nw = F.in[I_NFFN] + l * 1024; const float* rb = F.in[I_RB];
    const int ngroups = (b1 - b0 + 15) >> 4;
    int curb = -1; RowVec gsc, sh;
    v2u xr[2][4];
#define RR_LOAD(g_) do { _Pragma("unroll") for (int q = 0; q < 2; ++q) { const int row_ = b0 + 16 * (g_) + 2 * F.wave + q; const int rc_ = row_ < b1 ? row_ : b1 - 1; \
        _Pragma("unroll") for (int j = 0; j < 4; ++j) xr[q][j] = *(const GAS v2u*)(XB + (size_t)rc_ * 1024 + 4 * F.lane + 256 * j); } } while (0)
    RR_LOAD(0);
    const float rbv = rb[F.tid & 15];
    { const int r0_ = b0 + 2 * F.wave < b1 ? b0 + 2 * F.wave : b1 - 1; curb = r0_ < ML ? (r0_ >> 12) : 8; load_modvec(F, l, curb, 3, nw, gsc, sh); }
    { int t0_ = F.tid; asm volatile("" : "+v"(t0_));
      float wv[4][8];
#pragma unroll
      for (int it = 0; it < 4; ++it) { const int idx = t0_ + it * NWAVES * 64, sg = idx >> 6, ln = idx & 63; const float* src = F.in[I_RW] + (32 * sg + 8 * (ln >> 4)) * 16 + (ln & 15);
#pragma unroll
          for (int j = 0; j < 8; ++j) wv[it][j] = src[16 * j]; }
#pragma unroll
      for (int it = 0; it < 4; ++it) { const int idx = t0_ + it * NWAVES * 64; unsigned hh[4], ll[4];
#pragma unroll
          for (int j = 0; j < 4; ++j) split_bf16x2(wv[it][2 * j], wv[it][2 * j + 1], hh[j], ll[j]);
          *(LAS v4u*)(Wi + idx * 16) = (v4u){hh[0], hh[1], hh[2], hh[3]}; *(LAS v4u*)(Wi + 32768 + idx * 16) = (v4u){ll[0], ll[1], ll[2], ll[3]}; } }
    for (int g = 0; g < ngroups; ++g) {
#pragma unroll
        for (int q = 0; q < 2; ++q) { const int rr = 2 * F.wave + q, row = b0 + 16 * g + rr; const bool valid = row < b1;
            RowVec x, h;
#pragma unroll
            for (int j = 0; j < 4; ++j) x.v[j] = (f32x4){bflo(xr[q][j].x), bfhi(xr[q][j].x), bflo(xr[q][j].y), bfhi(xr[q][j].y)};
            const int mrow = (valid ? row : b1 - 1) < ML ? ((valid ? row : b1 - 1) >> 12) : 8;
            if (mrow != curb) { load_modvec(F, l, mrow, 3, nw, gsc, sh); curb = mrow; }
            rms_mod(x, gsc, sh, h);
            if (valid) { unsigned char* d8 = XN8 + (size_t)row * 1024;
#pragma unroll
                for (int j = 0; j < 4; ++j) *(GAS unsigned*)(d8 + 4 * F.lane + 256 * j) = pg8::pk4_fp8(h.v[j][0], h.v[j][1], h.v[j][2], h.v[j][3]); }
#pragma unroll
            for (int j = 0; j < 4; ++j) { const f32x4 hv = valid ? h.v[j] : (f32x4){0.f, 0.f, 0.f, 0.f};
                unsigned h0, h1, l0, l1; split_bf16x2(hv[0], hv[1], h0, l0); split_bf16x2(hv[2], hv[3], h1, l1);
                v2u ph; ph.x = h0; ph.y = h1; v2u pl; pl.x = l0; pl.y = l1;
                *(LAS v2u*)(Hi + rr * HPB + (4 * F.lane + 256 * j) * 2) = ph; *(LAS v2u*)(Hi + 16 * HPB + rr * HPB + (4 * F.lane + 256 * j) * 2) = pl; } }
        if (g + 1 < ngroups) RR_LOAD(g + 1);
        __syncthreads();
        { const int r = F.lane & 15, kq = F.lane >> 4; f32x4 ahh = {0.f, 0.f, 0.f, 0.f}, alh = {0.f, 0.f, 0.f, 0.f}, ahl = {0.f, 0.f, 0.f, 0.f};
          const LAS unsigned char* ap = Hi + r * HPB + (128 * F.wave + 8 * kq) * 2; const LAS unsigned char* bp = Wi + (4 * F.wave * 64 + F.lane) * 16;
#pragma unroll
          for (int s_ = 0; s_ < 4; ++s_) { const v2u xh0 = *(const LAS v2u*)(ap + 64 * s_), xh1 = *(const LAS v2u*)(ap + 64 * s_ + 8), xl0 = *(const LAS v2u*)(ap + 16 * HPB + 64 * s_), xl1 = *(const LAS v2u*)(ap + 16 * HPB + 64 * s_ + 8);
              const bf16x8 xh = __builtin_bit_cast(bf16x8, (v4u){xh0.x, xh0.y, xh1.x, xh1.y}), xl = __builtin_bit_cast(bf16x8, (v4u){xl0.x, xl0.y, xl1.x, xl1.y});
              const bf16x8 wh = *(const LAS bf16x8*)(bp + 1024 * s_), wl = *(const LAS bf16x8*)(bp + 32768 + 1024 * s_);
              ahh = __builtin_amdgcn_mfma_f32_16x16x32_bf16(xh, wh, ahh, 0, 0, 0); alh = __builtin_amdgcn_mfma_f32_16x16x32_bf16(xl, wh, alh, 0, 0, 0); ahl = __builtin_amdgcn_mfma_f32_16x16x32_bf16(xh, wl, ahl, 0, 0, 0); }
          const f32x4 acc = ahh + (alh + ahl);
#pragma unroll
          for (int i = 0; i < 4; ++i) part[(F.wave * 16 + 4 * kq + i) * 16 + r] = acc[i]; }
        __syncthreads();
        if (F.tid < 256) { float sacc = rbv;
#pragma unroll
            for (int w = 0; w < 8; ++w) sacc += part[w * 256 + F.tid];
            logit[((g & 3) * 16 + (F.tid >> 4)) * 17 + (F.tid & 15)] = sacc; }
        if ((g & 3) != 3 && g + 1 != ngroups) continue;
        __syncthreads();
        if (F.tid < 64) { const int gb = g & ~3, row = b0 + 16 * gb + F.tid;
            if (row < b1 && (F.tid >> 4) <= g - gb) { float lg[16];
#pragma unroll
                for (int e = 0; e < 16; ++e) lg[e] = logit[F.tid * 17 + e];
                int e0, e1; float w0, w1; route_topk(lg, e0, e1, w0, w1);
                const int a0 = e0 & 3, a1 = e1 & 3, lo = a0 < a1 ? a0 : a1, hi_ = a0 < a1 ? a1 : a0, pid = lo == 0 ? hi_ - 1 : lo == 1 ? hi_ + 1 : 5, gid = 6 * (e0 >> 2) + pid;
                const float wa = a0 < a1 ? w0 : w1, wb = a0 < a1 ? w1 : w0;
                v4u o; o.x = (unsigned)gid; o.y = __builtin_bit_cast(unsigned, wa); o.z = __builtin_bit_cast(unsigned, wb); o.w = 0u; route[row] = o;
                pe[row - b0] = (unsigned char)gid; } }
    }
#undef RR_LOAD
    __syncthreads();
    if (F.wave == 0) {
        const int nr = b1 - b0; int run[24];
#pragma unroll
        for (int j = 0; j < 24; ++j) run[j] = 0;
        for (int p0 = 0; p0 < nr; p0 += 64) { const int p = p0 + F.lane; const int e = p < nr ? (int)pe[p] : 255; int myr = 0;
#pragma unroll
            for (int j = 0; j < 24; ++j) { const unsigned long long m = __ballot(e == j); const int below = __popcll(m & ((1ull << F.lane) - 1ull));
                if (e == j) myr = run[j] + below; run[j] += __popcll(m); }
            if (p < nr) pr[p] = (unsigned short)myr; }
        int mycnt = 0;
#pragma unroll
        for (int j = 0; j < 24; ++j) mycnt = (F.lane == j) ? run[j] : mycnt;
        int basev = 0;
        if (F.lane < 24) basev = (int)__hip_atomic_fetch_add((unsigned*)(F.ctl + CW_CNT + 64 * l) + F.lane, (unsigned)mycnt, RLX_AGENT);
        int base[24];
#pragma unroll
        for (int j = 0; j < 24; ++j) base[j] = __builtin_amdgcn_readlane(basev, j);
        LDS_WAIT();
        int* ridx = (int*)(F.ws + WS_RIDX);
        for (int p0 = 0; p0 < nr; p0 += 64) { const int p = p0 + F.lane;
            if (p < nr) { const int e = (int)pe[p]; int bs = 0;
#pragma unroll
                for (int j = 0; j < 24; ++j) bs = (e == j) ? base[j] : bs;
                ridx[(size_t)e * MT + bs + (int)pr[p]] = b0 + p; } }
    }
    __syncthreads();
}

__device__ __forceinline__ void rows_modulate_xb(Frame& F, int nrows, int l) {
    const int gwv = blockIdx.x * NWAVES + F.wave, NGW = F.G * NWAVES;
    const int r0 = (int)((long)gwv * nrows / NGW), r1 = (int)((long)(gwv + 1) * nrows / NGW);
    const bf16* XB = (const bf16*)(F.ws + WS_XB); unsigned char* XN8 = F.ws + WS_XN; const float* nw = F.in[I_NMIX] + l * 1024;
    int curb = -1; RowVec gsc, sh, xn;
    if (r0 < r1) load_xrow_bf(XB, r0, F.lane, xn);
    for (int row = r0; row < r1; ++row) {
        const int mrow = row < ML ? (row >> 12) : 8;
        if (mrow != curb) { load_modvec(F, l, mrow, 0, nw, gsc, sh); curb = mrow; }
        RowVec x = xn, h;
        if (row + 1 < r1) load_xrow_bf(XB, row + 1, F.lane, xn);
        rms_mod(x, gsc, sh, h);
        unsigned char* d8 = XN8 + (size_t)row * 1024;
#pragma unroll
        for (int j = 0; j < 4; ++j) *(GAS unsigned*)(d8 + 4 * F.lane + 256 * j) = pg8::pk4_fp8(h.v[j][0], h.v[j][1], h.v[j][2], h.v[j][3]);
    }
}

__device__ __forceinline__ void rows_conv(Frame& F) {
    const bf16* U = (const bf16*)((unsigned char*)F.out + DO_U); bf16* UC = (bf16*)(F.ws + WS_XN);
    const int cg = F.tid & 127, rsub = F.tid >> 7, c0 = cg * 8;
    float w[4][8], cb[8];
#pragma unroll
    for (int j = 0; j < 8; ++j) { cb[j] = F.in[I_LCB][c0 + j];
#pragma unroll
        for (int k = 0; k < 4; ++k) w[k][j] = F.in[I_LCW][k * 1024 + c0 + j]; }
    for (int run = blockIdx.x * 4 + rsub; run < MT / 16; run += F.G * 4) {
        const int row0 = run * 16; const int t0 = row0 < ML ? (row0 & 4095) : ((row0 - ML) & 255), T = row0 < ML ? 4096 : 256;
        v4u win[19];
#pragma unroll
        for (int i = 0; i < 19; ++i) { const int tt = t0 + i - 2; win[i] = (v4u){0u, 0u, 0u, 0u};
            if (tt >= 0 && tt < T) win[i] = *(const GAS v4u*)(U + (size_t)(row0 + i - 2) * 1024 + c0); }
#pragma unroll
        for (int i = 0; i < 16; ++i) { float acc[8];
#pragma unroll
            for (int j = 0; j < 8; ++j) acc[j] = cb[j];
#pragma unroll
            for (int k = 0; k < 4; ++k) { const v4u uv = win[i + k];
                acc[0] += w[k][0] * bflo(uv.x); acc[1] += w[k][1] * bfhi(uv.x); acc[2] += w[k][2] * bflo(uv.y); acc[3] += w[k][3] * bfhi(uv.y);
                acc[4] += w[k][4] * bflo(uv.z); acc[5] += w[k][5] * bfhi(uv.z); acc[6] += w[k][6] * bflo(uv.w); acc[7] += w[k][7] * bfhi(uv.w); }
            v4u o; o.x = pk2(acc[0], acc[1]); o.y = pk2(acc[2], acc[3]); o.z = pk2(acc[4], acc[5]); o.w = pk2(acc[6], acc[7]);
            *(GAS v4u*)(UC + (size_t)(row0 + i) * 1024 + c0) = o; }
    }
}

__device__ __forceinline__ int scan_q(int d, int pc) { return d == 0 ? pc : (pc < 8 ? 7 - pc : 143 - pc); }
__device__ __forceinline__ int scan_row0(int b, int pc) { return pc < 8 ? ML + b * 256 + pc * 32 : b * 4096 + (pc - 8) * 32; }
__device__ __forceinline__ const unsigned char* scan_lb(Frame& F, int d) { return (const unsigned char*)(F.ws + (d ? WS_BB0 : WS_LA0)); }
#define LB_DEC(w, a0, b0, a1, b1) do { const f32x2 lo_ = __builtin_amdgcn_cvt_pk_f32_fp8((int)(w), false), hi_ = __builtin_amdgcn_cvt_pk_f32_fp8((int)(w), true); \
        a0 = fast_exp2(lo_[0] * (1.0f / pg8::LA8_SCALE)); b0 = lo_[1]; a1 = fast_exp2(hi_[0] * (1.0f / pg8::LA8_SCALE)); b1 = hi_[1]; } while (0)
__device__ __forceinline__ void scan_local(Frame& F) {
    f32x4* summ = (f32x4*)((unsigned char*)F.out + DO_SUMM);
    const int c2 = 2 * F.tid;
    for (int item = blockIdx.x; item < BATCH * NQ; item += F.G) {
        const int b = item / NQ, pc = item % NQ, row0 = scan_row0(b, pc);
#pragma unroll
        for (int d = 0; d < 2; ++d) {
            const unsigned char* lb = scan_lb(F, d) + ((size_t)row0 * 1024 + c2) * 2;
            float P0 = 1.f, P1 = 1.f, H0 = 0.f, H1 = 0.f; unsigned wav[32];
#pragma unroll
            for (int i = 0; i < 32; ++i) wav[i] = *(const GAS unsigned*)(lb + (size_t)i * 2048);
#pragma unroll
            for (int ii = 0; ii < 32; ++ii) { const int i = d ? 31 - ii : ii; float a0, b0, a1, b1; LB_DEC(wav[i], a0, b0, a1, b1);
                H0 = a0 * H0 + b0; H1 = a1 * H1 + b1; P0 *= a0; P1 *= a1; }
            summ[((size_t)((b * 2 + d) * NQ + scan_q(d, pc)) * 1024 + c2) >> 1] = (f32x4){P0, H0, P1, H1};
        }
    }
}
__device__ __forceinline__ void scan_carry(Frame& F) {
    const f32x2* summ = (const f32x2*)((unsigned char*)F.out + DO_SUMM); float* carry = (float*)((unsigned char*)F.out + DO_CARRY);
    LAS f32x2* comp = (LAS f32x2*)(F.lds + RING_OFF);
    for (int u = blockIdx.x; u < 256; u += F.G) {
        const int bd = u >> 4, c = (u & 15) * 64 + F.lane, q0 = F.wave * 17; f32x2 s[17];
#pragma unroll
        for (int k = 0; k < 17; ++k) s[k] = summ[(size_t)(bd * NQ + q0 + k) * 1024 + c];
        float Pc = 1.f, Hc = 0.f;
#pragma unroll
        for (int k = 0; k < 17; ++k) { Hc = s[k][0] * Hc + s[k][1]; Pc *= s[k][0]; }
        comp[F.wave * 64 + F.lane] = (f32x2){Pc, Hc};
        __syncthreads();
        float h = 0.f;
        for (int w = 0; w < F.wave; ++w) { const f32x2 cw = comp[w * 64 + F.lane]; h = cw[0] * h + cw[1]; }
#pragma unroll
        for (int k = 0; k < 17; ++k) { carry[(size_t)(bd * NQ + q0 + k) * 1024 + c] = h; h = s[k][0] * h + s[k][1]; }
        __syncthreads();
    }
}
__device__ __forceinline__ void scan_final(Frame& F) {
    const float* carry = (const float*)((unsigned char*)F.out + DO_CARRY); const bf16* Gb = (const bf16*)(F.ws + WS_G); bf16* YGb = (bf16*)(F.ws + WS_XN);
    const int c2 = 2 * F.tid;
    for (int item = blockIdx.x; item < BATCH * NQ; item += F.G) {
        const int b = item / NQ, pc = item % NQ, row0 = scan_row0(b, pc);
        float hf0[32], hf1[32];
        { const unsigned char* lb = scan_lb(F, 0) + ((size_t)row0 * 1024 + c2) * 2;
          const f32x2 cin = *(const f32x2*)(carry + (size_t)((b * 2 + 0) * NQ + scan_q(0, pc)) * 1024 + c2); float h0 = cin[0], h1 = cin[1];
          unsigned wav[32];
#pragma unroll
          for (int i = 0; i < 32; ++i) wav[i] = *(const GAS unsigned*)(lb + (size_t)i * 2048);
#pragma unroll
          for (int i = 0; i < 32; ++i) { float a0, b0, a1, b1; LB_DEC(wav[i], a0, b0, a1, b1);
              h0 = a0 * h0 + b0; h1 = a1 * h1 + b1; hf0[i] = h0; hf1[i] = h1; } }
        { const unsigned char* lb = scan_lb(F, 1) + ((size_t)row0 * 1024 + c2) * 2; const bf16* gp = Gb + (size_t)row0 * 1024 + c2; bf16* yp = YGb + (size_t)row0 * 1024 + c2;
          const f32x2 cin = *(const f32x2*)(carry + (size_t)((b * 2 + 1) * NQ + scan_q(1, pc)) * 1024 + c2); float h0 = cin[0], h1 = cin[1];
          unsigned wav[32], gv[32];
#pragma unroll
          for (int i = 0; i < 32; ++i) wav[i] = *(const GAS unsigned*)(lb + (size_t)i * 2048);
#pragma unroll
          for (int i = 0; i < 32; ++i) gv[i] = *(const GAS unsigned*)(gp + (size_t)i * 1024);
#pragma unroll
          for (int ii = 0; ii < 32; ++ii) { const int i = 31 - ii; float a0, b0, a1, b1; LB_DEC(wav[i], a0, b0, a1, b1);
              h0 = a0 * h0 + b0; h1 = a1 * h1 + b1;
              const unsigned g = gv[i];
              *(GAS unsigned*)(yp + (size_t)i * 1024) = pk2((hf0[i] + h0) * (bflo(g) * (1.0f / pg8::BB8_SCALE)), (hf1[i] + h1) * (bfhi(g) * (1.0f / pg8::BB8_SCALE))); } }
    }
}

__device__ __forceinline__ int scan_po_panel(int pos, bool reorder) { if (!reorder || pos >= 48) return pos; const int k = pos / 24, j = pos % 24; return 6 * (j & 7) + 3 * k + (j >> 3); }
__device__ __forceinline__ void scan_final_ho(Frame& F, int nprod, bool reorder, unsigned* hcnt) {
    const float* carry = (const float*)((unsigned char*)F.out + DO_CARRY); const bf16* Gb = (const bf16*)(F.ws + WS_G); bf16* YGb = (bf16*)(F.ws + WS_XN);
    const int c2 = 2 * F.tid; int pend = -1;
    for (int t = blockIdx.x; t < BATCH * NQ; t += nprod) {
        asm volatile("" ::: "memory");
        const int panel = scan_po_panel(t >> 3, reorder), b = panel < 128 ? (panel >> 4) : panel - 128, pc = (panel < 128 ? 8 + (panel & 15) * 8 : 0) + (t & 7), row0 = scan_row0(b, pc);
        float hf0[32], hf1[32];
        { const unsigned char* lb = scan_lb(F, 0) + ((size_t)row0 * 1024 + c2) * 2;
          const f32x2 cin = *(const f32x2*)(carry + (size_t)((b * 2 + 0) * NQ + scan_q(0, pc)) * 1024 + c2); float h0 = cin[0], h1 = cin[1];
          unsigned wav[32];
#pragma unroll
          for (int i = 0; i < 32; ++i) wav[i] = *(const GAS unsigned*)(lb + (size_t)i * 2048);
#pragma unroll
          for (int i = 0; i < 32; ++i) { float a0, b0, a1, b1; LB_DEC(wav[i], a0, b0, a1, b1);
              h0 = a0 * h0 + b0; h1 = a1 * h1 + b1; hf0[i] = h0; hf1[i] = h1; } }
        asm volatile("" ::: "memory");
        if (pend >= 0) { __syncthreads(); if (F.tid == 0) pg8::ho_publish(hcnt, pend); }
        { const unsigned char* lb = scan_lb(F, 1) + ((size_t)row0 * 1024 + c2) * 2; const bf16* gp = Gb + (size_t)row0 * 1024 + c2; bf16* yp = YGb + (size_t)row0 * 1024 + c2;
          const f32x2 cin = *(const f32x2*)(carry + (size_t)((b * 2 + 1) * NQ + scan_q(1, pc)) * 1024 + c2); float h0 = cin[0], h1 = cin[1];
          unsigned wav[32], gv[32];
#pragma unroll
          for (int i = 0; i < 32; ++i) wav[i] = *(const GAS unsigned*)(lb + (size_t)i * 2048);
#pragma unroll
          for (int i = 0; i < 32; ++i) gv[i] = *(const GAS unsigned*)(gp + (size_t)i * 1024);
#pragma unroll
          for (int ii = 0; ii < 32; ++ii) { const int i = 31 - ii; float a0, b0, a1, b1; LB_DEC(wav[i], a0, b0, a1, b1);
              h0 = a0 * h0 + b0; h1 = a1 * h1 + b1;
              const unsigned g = gv[i];
              __hip_atomic_store((GAS unsigned*)(yp + (size_t)i * 1024), pk2((hf0[i] + h0) * (bflo(g) * (1.0f / pg8::BB8_SCALE)), (hf1[i] + h1) * (bfhi(g) * (1.0f / pg8::BB8_SCALE))), __ATOMIC_RELAXED, __HIP_MEMORY_SCOPE_AGENT); } }
        pend = panel;
    }
    asm volatile("s_waitcnt vmcnt(0)" ::: "memory");
    __syncthreads();
    if (pend >= 0 && F.tid == 0) pg8::ho_publish(hcnt, pend);
}
#ifndef MK_N_LAUNCHES
#define MK_N_LAUNCHES 1
#endif
constexpr int NPHASE = 14;
#ifndef PH_STOP
#define PH_STOP 14
#endif
#ifndef PH_DUP
#define PH_DUP 0u
#endif
#define DUPN(k) (((PH_DUP >> (k)) & 1u) ? 2 : 1)
constexpr int N_LAUNCHES = MK_N_LAUNCHES;
struct Args { const float* in[26]; float* out; unsigned char* ws; int ph_lo, ph_hi; };

__global__ void __launch_bounds__(NWAVES * 64, 2) fwd_kernel(Args args) {
    extern __shared__ __attribute__((aligned(16))) unsigned char lds[];
    Frame F;
    F.lds = (LAS unsigned char*)lds;
    F.MISC = (volatile LAS unsigned*)(F.lds + MISC_OFF);
    F.tid = threadIdx.x; F.lane = F.tid & 63; F.wave = __builtin_amdgcn_readfirstlane(F.tid >> 6);
    F.G = gridDim.x; { const int bx = blockIdx.x; F.vcu = (F.G % 8 == 0) ? (bx % 8) * (F.G / 8) + bx / 8 : bx; }
    F.ws = args.ws; F.out = args.out; F.ctl = (gu32*)(args.ws + WS_CTL);
#pragma unroll
    for (int i = 0; i < 26; ++i) F.in[i] = args.in[i];
    for (int u = F.tid; u < (LDS_BYTES - LDSCTL_OFF) / 4; u += NWAVES * 64) ((LAS unsigned*)(F.lds + LDSCTL_OFF))[u] = 0u;
    __syncthreads();
    XcdBarrier bar; bar.bar = (unsigned*)(F.ctl + CW_BAR); bar.x = 0; bar.st = nullptr;
    if (N_LAUNCHES == 1) bar = xcd_barrier_post((unsigned*)(F.ctl + CW_BAR), F.MISC + 8);
#define GRID_BAR() do { if (N_LAUNCHES == 1) xcd_barrier(bar); } while (0)
    const int lo = args.ph_lo, hi = args.ph_hi;
#define IN(k) (lo <= (k) && (k) < hi)
#define BOTH(k) (IN(k) && IN((k) + 1))
    unsigned char* ws = args.ws;
    float* mod = (float*)(ws + WS_MOD);
    LAS unsigned char* ring = F.lds + RING_OFF;
    LAS int* tab = (LAS int*)(F.lds + TAB_OFF); LAS float* tabw = (LAS float*)(F.lds + TAB_OFF + TAB_UNITS * 1024);

#define PHASE(k, ...) do { if (IN(k)) { _Pragma("unroll") for (int rep_ = 0; rep_ < DUPN(k); ++rep_) { __VA_ARGS__; if (rep_ + 1 < DUPN(k)) GRID_BAR(); } if (BOTH(k)) GRID_BAR(); } } while (0)
    PHASE(0, p0_prologue(F));
    PHASE(1, {
        const int nearly = (F.G == 256) ? 96 : 0; unsigned* hc = (unsigned*)(F.ctl + CW_TILE + 12288);
        if ((int)blockIdx.x < F.G - nearly) rows_modulate_ho(F, F.in[I_X], F.in[I_CTX], 0, 0, F.in[I_NMIX], F.G - nearly, nearly != 0, hc);
        pg8::Gemm g{(const bf16*)(ws + WS_XN), (const bf16*)(ws + WS_W_IN), 1024, 1024, 1024, hc, 256u}; pg8::SchedIn S{F.G, (int)blockIdx.x, nearly};
        pg8::EpiInProj E{(bf16*)(ws + WS_G), (bf16*)((unsigned char*)F.out + DO_U)};
        pg8::gemm_phase<pg8::EpiInProj, pg8::SchedIn, false, 2, 2>(ring, g, S, E, tab);
        if (F.G == 256) conv_tail(F, 128, CV_A_END, CV_A_END + 5760, S.cl()); else conv_tail(F, 0, CV_A_END, CV_A_END + 5760); });
    PHASE(2, {
        const pg8::GatesFused GP{(const bf16*)((unsigned char*)F.out + DO_U), (const bf16*)(ws + WS_W_G), F.in[I_LCW], F.in[I_LCB], {ws + WS_LA0, ws + WS_BB0}, F.in[I_GAB], F.in[I_GXB], F.in[I_LAM]};
        pg8::gates_fused_phase(ring, GP, F.G, (int)blockIdx.x, F.tid);
        if (F.G == 256) conv_tail(F, 128, CV_A_END + 5760, CV_A_END + 8320); else conv_tail(F, 0, CV_A_END + 5760, CV_A_END + 8320); });
    PHASE(3, scan_local(F));
    PHASE(4, scan_carry(F));
    PHASE(5, {
        const int nearly = (F.G == 256) ? 96 : 0; unsigned* hc = (unsigned*)(F.ctl + CW_TILE + 8192);
        if ((int)blockIdx.x < F.G - nearly) scan_final_ho(F, F.G - nearly, nearly != 0, hc);
        pg8::Gemm g{(const bf16*)(ws + WS_XN), (const bf16*)(ws + WS_W_OUT), 1024, 1024, 1024, hc}; pg8::SchedOut S{F.G, (int)blockIdx.x, nearly};
        pg8::EpiResid<false> E{F.in[I_X], F.in[I_CTX], (bf16*)(ws + WS_XB), mod + 2 * 1024, 1.0f};
        pg8::gemm_phase<pg8::EpiResid<false>, pg8::SchedOut, false, 2, 2>(ring, g, S, E, tab);
        if (F.G == 256) conv_tail(F, 96, CV_A_END + 8320, CV_B_END + CV_T8C); else conv_tail(F, 0, CV_A_END + 8320, CV_B_END + CV_T8C); });
    PHASE(6, rows_route(F, MT, 0));
#define MOE_UP(l, HOM) do { pg8::SchedMoe<true> S; S.init((const unsigned*)(F.ctl + CW_CNT + 64 * (l)), F.G, F.vcu); const int* ridx = (const int*)(ws + WS_RIDX); const v4u* route_ = (const v4u*)(ws + WS_ROUTE); \
        { pg8::Unit u; for (int i = 0; i < TAB_UNITS && S.next(i, u); ++i) if (F.tid < 256) { const bool v_ = F.tid < u.x1; const int row_ = v_ ? ridx[(size_t)u.x0 * MT + u.x2 + F.tid] : 0; \
              tab[i * 256 + F.tid] = row_; float w_ = 0.f; if (v_) { const v4u rt_ = route_[row_]; const unsigned wy_ = rt_.y, wz_ = rt_.z; w_ = __uint_as_float(u.pn < 4 ? wy_ : wz_); } tabw[i * 256 + F.tid] = w_; } } \
        __syncthreads(); \
        pg8::Gemm g{ws + WS_XN, ws + WS_W13 + (size_t)(l) * 16 * 1024 * 1024, 1024, 1024, 1024, (unsigned*)(F.ctl + CW_TILE + 4096 * (l))}; pg8::EpiMoe1<(HOM) != 0> E{ws + WS_ACT, tabw}; \
        pg8::gemm_phase<pg8::EpiMoe1<(HOM) != 0>, pg8::SchedMoe<true>, true, 1, (HOM) ? 1 : 0>(ring, g, S, E, tab); \
        if ((l) == 0 && !(HOM)) conv_tail(F, S.total % F.G, CV_B_END, CV_B_END + CV_T10, F.vcu); } while (0)
#define MOE_DOWN(l, FINAL, HOM) do { pg8::SchedMoe<false> S; S.init((const unsigned*)(F.ctl + CW_CNT + 64 * (l)), F.G, F.vcu); if (HOM) S.c = (F.vcu + F.G - (2 * S.total) % F.G) % F.G;     const int* ridx = (const int*)(ws + WS_RIDX); \
        { pg8::Unit u; for (int i = 0; i < TAB_UNITS && S.next(i, u); ++i) if (F.tid < 256) tab[i * 256 + F.tid] = F.tid < u.x1 ? ridx[(size_t)u.x0 * MT + u.x2 + F.tid] : -1; } \
        __syncthreads(); \
        pg8::Gemm g{ws + WS_ACT, ws + WS_W2 + (size_t)(l) * 16 * 1024 * 512, 1024, 512, 1024, (unsigned*)(F.ctl + CW_TILE + 4096 * (l))}; pg8::EpiMoe2<FINAL> E{(bf16*)(ws + WS_XB), F.out, mod + (l) * 9 * 6144 + 5 * 1024, tab}; \
        pg8::gemm_phase<pg8::EpiMoe2<FINAL>, pg8::SchedMoe<false>, false, 1, (HOM) ? 2 : 0>(ring, g, S, E, tab); \
        if ((l) == 0 && !(HOM)) conv_tail(F, S.total % F.G, CV_B_END + CV_T10, CV_B_END + CV_T10 + CV_T11, F.vcu); \
        if ((l) == 0 && (HOM)) conv_tail(F, 0, CV_B_END + CV_T8C, CV_B_END + CV_T10 + CV_T11, F.vcu);     \
        } while (0)
    PHASE(7, { MOE_UP(0, 1); __syncthreads(); MOE_DOWN(0, false, 1); });
    PHASE(8, rows_modulate_xb(F, MT, 1));
    PHASE(9, {
        pg8::Gemm g{ws + WS_XN, ws + WS_W_QKV, 1024, 1024, 1024}; pg8::SchedQKV S{F.G, (int)blockIdx.x};
        { int t_ = F.tid; asm volatile("" : "+v"(t_));
          LAS f32x4* rl = (LAS f32x4*)tab; rl[t_] = ((const f32x4*)(ws + WS_ROPE))[t_]; __syncthreads(); }
        pg8::EpiQKV E{ws + WS_Q, ws + WS_K, ws + WS_V, F.in[I_QN], F.in[I_KN], (const LAS float*)tab};
        pg8::gemm_phase<pg8::EpiQKV, pg8::SchedQKV, false, 1>(ring, g, S, E, tab);
        conv_tail(F, F.G == 256 ? 16 : 0, CV_B_END + CV_T10 + CV_T11, CV_B_END + CV_T10 + CV_T11 + CV_T13); });
    PHASE(10, {
        static_assert(attn8::LDS_BYTES <= RING_BYTES, "attention LDS");
        const attn8::Tensors AT{ws + WS_Q, ws + WS_K, ws + WS_V, ws + WS_O};
        attn8::attn_phase((char*)lds + RING_OFF, AT, (int)F.G, (int)blockIdx.x); });
    PHASE(11, {
        pg8::Gemm g{ws + WS_O, ws + WS_W_O, 1024, 1024, 1024}; pg8::SchedDense S{ML / 256, 4, F.G, (int)blockIdx.x};
        pg8::EpiResid<true> E{nullptr, nullptr, (bf16*)(ws + WS_XB), mod + 9 * 6144 + 2 * 1024, 1.0f / (pg8::W8_SCALE * attn8::OS)};
        pg8::gemm_phase<pg8::EpiResid<true>, pg8::SchedDense, false, 1>(ring, g, S, E, tab); });
    PHASE(12, rows_route(F, ML, 1));
    PHASE(13, { MOE_UP(1, 1); __syncthreads(); MOE_DOWN(1, true, 1); });
#undef IN
#undef BOTH
}

extern "C" void kernel_launch(void* const* d_in, const int* in_sizes, int n_in, void* d_out, int out_size, void* d_ws, size_t ws_size, hipStream_t stream) {
    static int grid = 0;
    if (grid == 0) {
        if (n_in != 26 || in_sizes[0] != ML * D || out_size != ML * D || ws_size < WS_END) { fprintf(stderr, "kernel_launch: unexpected shapes (n_in %d, in0 %d, out %d, ws %zu); nothing launched\n", n_in, n_in > 0 ? in_sizes[0] : -1, out_size, ws_size); grid = -1; return; }
        int dev = 0, cus = 0, per_cu = 0;
        if (hipGetDevice(&dev) != hipSuccess || hipDeviceGetAttribute(&cus, hipDeviceAttributeMultiprocessorCount, dev) != hipSuccess) { grid = -1; return; }
        if (hipFuncSetAttribute((const void*)fwd_kernel, hipFuncAttributeMaxDynamicSharedMemorySize, LDS_BYTES) != hipSuccess) { fprintf(stderr, "kernel_launch: hipFuncSetAttribute failed\n"); grid = -1; return; }
        if (hipOccupancyMaxActiveBlocksPerMultiprocessor(&per_cu, (const void*)fwd_kernel, NWAVES * 64, LDS_BYTES) != hipSuccess || per_cu < 1)
            fprintf(stderr, "kernel_launch: note: occupancy query reports %d workgroups per CU\n", per_cu);
        (void)hipGetLastError();
        grid = cus < 256 ? cus : 256;
    }
    if (grid < 0) return;
    if (hipMemsetAsync((char*)d_ws + WS_CTL, 0, CTL_ZERO_BYTES, stream) != hipSuccess) { fprintf(stderr, "kernel_launch: memset failed\n"); return; }
    Args a{};
    for (int i = 0; i < 26; ++i) a.in[i] = (const float*)d_in[i];
    a.out = (float*)d_out; a.ws = (unsigned char*)d_ws;
    for (int li = 0; li < (N_LAUNCHES == 1 ? 1 : PH_STOP); ++li) {
        a.ph_lo = (N_LAUNCHES == 1) ? 0 : li; a.ph_hi = (N_LAUNCHES == 1) ? PH_STOP : li + 1;
        hipLaunchKernelGGL(fwd_kernel, dim3(grid), dim3(NWAVES * 64), LDS_BYTES, stream, a);
        const hipError_t le = hipPeekAtLastError();
        if (le != hipSuccess) { fprintf(stderr, "kernel_launch: launch %d failed: %s\n", li, hipGetErrorName(le)); break; }
    }
}
```
